# Optimizing an MI355X kernel written in HIP

```python
import jax, jax.numpy as jnp
from jax import lax
import numpy as np

D_MODEL = 2048
BATCH = 4
SEQ = 2048
DEPTH = 4
DEC_BATCH = 16
DEC_SEQ = 2048
PAST_LEN = 128

PLE_DIM = 256
HEAD_DIM = 128
A_HEADS = 6
A_KV_HEADS = 2
A_GROUP = A_HEADS // A_KV_HEADS
A_WINDOW = 128
A_BLOCK = 128
B_HEADS = 6
B_Q_LORA = 512
B_KV_LORA = 512
B_NOPE = 128
B_ROPE = 64
B_V = 128
B_QK = B_NOPE + B_ROPE
B_BLOCK = 128
ROPE_THETA = 10000.0
C_HEADS = 4
GRID_W = 64
NA_ROWS_MAX = 8
NA_COLS = 16
A_WIDTH = A_HEADS * HEAD_DIM
A_KV_WIDTH = A_KV_HEADS * HEAD_DIM
B_WIDTH = B_HEADS * B_V
C_WIDTH = C_HEADS * HEAD_DIM
MIX_WIDTH = A_WIDTH + B_WIDTH + C_WIDTH
IN_SPLITS = (A_WIDTH, A_KV_WIDTH, A_KV_WIDTH, A_WIDTH,
             B_Q_LORA, B_KV_LORA, B_ROPE, B_WIDTH,
             C_WIDTH, C_WIDTH, C_WIDTH, C_WIDTH)
IN_WIDTH = (2 * A_WIDTH + 2 * A_KV_WIDTH + B_Q_LORA + B_KV_LORA + B_ROPE + B_WIDTH + 4 * C_WIDTH)
EPS = 1e-6
NEG_INF = -1e30

kernel_name = "hymba_style_hybrid_encoder"


def _rmsnorm(x, g):
    xf = x.astype(jnp.float32)
    xf = xf * lax.rsqrt(jnp.mean(xf * xf, axis=-1, keepdims=True) + EPS)
    return (xf * g.astype(jnp.float32)).astype(x.dtype)


def _split(x, sizes):
    outs, off = [], 0
    for s in sizes:
        outs.append(x[..., off:off + s])
        off += s
    return outs


def _alibi_slopes(n):
    return jnp.exp2(-8.0 * jnp.arange(1, n + 1, dtype=jnp.float32) / n)


def _rope(x, pos):
    half = x.shape[-1] // 2
    inv = ROPE_THETA ** (-jnp.arange(half, dtype=jnp.float32) / half)
    ang = pos.astype(jnp.float32)[:, None] * inv[None, :]
    cos = jnp.cos(ang)[:, None, :].astype(x.dtype)
    sin = jnp.sin(ang)[:, None, :].astype(x.dtype)
    x1, x2 = x[..., :half], x[..., half:]
    return jnp.concatenate([x1 * cos - x2 * sin, x1 * sin + x2 * cos], axis=-1)


def _window_gqa(q, k, v, g_q, g_k, sink):
    B, L, _ = q.shape
    nb = L // A_BLOCK
    q = _rmsnorm(q.reshape(B, L, A_HEADS, HEAD_DIM), g_q)
    k = _rmsnorm(k.reshape(B, L, A_KV_HEADS, HEAD_DIM), g_k)
    v = v.reshape(B, L, A_KV_HEADS, HEAD_DIM)
    q = q.transpose(0, 2, 1, 3).reshape(B, A_KV_HEADS, A_GROUP, nb, A_BLOCK, HEAD_DIM)

    def band(t):
        t = jnp.pad(t.transpose(0, 2, 1, 3), ((0, 0), (0, 0), (A_BLOCK, A_BLOCK), (0, 0)))
        t = t.reshape(B, A_KV_HEADS, nb + 2, A_BLOCK, HEAD_DIM)
        return jnp.concatenate([t[:, :, :-2], t[:, :, 1:-1], t[:, :, 2:]], axis=3)

    kb, vb = band(k), band(v)
    logits = jnp.einsum('bkgnqd,bknsd->bkgnqs', q, kb).astype(jnp.float32) * (HEAD_DIM ** -0.5)
    qi = jnp.arange(A_BLOCK)
    si = jnp.arange(3 * A_BLOCK)
    delta = si[None, :] - A_BLOCK - qi[:, None]
    tk = jnp.arange(nb)[:, None] * A_BLOCK - A_BLOCK + si[None, :]
    valid = (jnp.abs(delta) <= A_WINDOW)[None] & ((tk >= 0) & (tk < L))[:, None, :]
    slopes = _alibi_slopes(A_HEADS).reshape(A_KV_HEADS, A_GROUP)
    logits = logits - slopes[:, :, None, None, None] * jnp.abs(delta).astype(jnp.float32)
    logits = jnp.where(valid, logits, NEG_INF)
    sink_f = sink.astype(jnp.float32).reshape(A_KV_HEADS, A_GROUP, 1, 1, 1)
    m = jnp.maximum(jnp.max(logits, axis=-1, keepdims=True), sink_f)
    e = jnp.exp(logits - m)
    probs = e / (jnp.sum(e, axis=-1, keepdims=True) + jnp.exp(sink_f - m))
    out = jnp.einsum('bkgnqs,bknsd->bkgnqd', probs.astype(vb.dtype), vb)
    return out.reshape(B, A_HEADS, L, HEAD_DIM).transpose(0, 2, 1, 3).reshape(B, L, A_WIDTH)


def _mla(cq, ckv, kr, g_cq, g_ckv, w_uq, w_ukv, g_q, g_k):
    B, L, _ = cq.shape
    nb = L // B_BLOCK
    pos = jnp.arange(L)
    q = (_rmsnorm(cq, g_cq) @ w_uq).reshape(B, L, B_HEADS, B_QK)
    kv = (_rmsnorm(ckv, g_ckv) @ w_ukv).reshape(B, L, B_HEADS, B_NOPE + B_V)
    k_nope, v = kv[..., :B_NOPE], kv[..., B_NOPE:]
    k = jnp.concatenate([k_nope, jnp.broadcast_to(kr[:, :, None, :], (B, L, B_HEADS, B_ROPE))], axis=-1)
    q = _rmsnorm(q, g_q)
    k = _rmsnorm(k, g_k)
    q = jnp.concatenate([q[..., :B_NOPE], _rope(q[..., B_NOPE:], pos)], axis=-1)
    k = jnp.concatenate([k[..., :B_NOPE], _rope(k[..., B_NOPE:], pos)], axis=-1)
    qb = q.transpose(0, 2, 1, 3).reshape(B, B_HEADS, nb, B_BLOCK, B_QK).transpose(2, 0, 1, 3, 4)
    k = k.transpose(0, 2, 1, 3)
    v = v.transpose(0, 2, 1, 3)
    scale = B_QK ** -0.5

    def block(qblk):
        s = jnp.einsum('bhqd,bhkd->bhqk', qblk, k).astype(jnp.float32) * scale
        p = jax.nn.softmax(s, axis=-1)
        return jnp.einsum('bhqk,bhkd->bhqd', p.astype(v.dtype), v)

    out = lax.map(block, qb)
    return out.transpose(1, 0, 3, 2, 4).reshape(B, L, B_WIDTH)


def _neighbourhood(q, k, v, g_q, g_k, rpb):
    B, L, _ = q.shape
    rows = L // GRID_W
    wr = min(NA_ROWS_MAX, rows)

    def grid(t):
        return t.reshape(B, rows, GRID_W, C_HEADS, HEAD_DIM).transpose(0, 3, 1, 2, 4)

    qg = grid(_rmsnorm(q.reshape(B, L, C_HEADS, HEAD_DIM), g_q))
    kg = grid(_rmsnorm(k.reshape(B, L, C_HEADS, HEAD_DIM), g_k))
    vg = grid(v)
    r = jnp.arange(rows)
    c = jnp.arange(GRID_W)
    rs = jnp.clip(r - wr // 2, 0, rows - wr)
    row_idx = rs[:, None] + jnp.arange(wr)[None, :]
    cs = jnp.clip(c - NA_COLS // 2, 0, GRID_W - NA_COLS)
    col_valid = (c[None, :] >= cs[:, None]) & (c[None, :] < cs[:, None] + NA_COLS)
    k_rows = kg[:, :, row_idx]
    v_rows = vg[:, :, row_idx]
    logits = jnp.einsum('bhrqd,bhrwcd->bhrqwc', qg, k_rows).astype(jnp.float32) * (HEAD_DIM ** -0.5)
    dr = row_idx - r[:, None]
    dc = c[None, :] - c[:, None]
    bias = rpb.astype(jnp.float32)[:, (dr + NA_ROWS_MAX - 1)[:, None, :, None],
                                   jnp.clip(dc + NA_COLS - 1, 0, 2 * NA_COLS - 2)[None, :, None, :]]
    logits = jnp.where(col_valid[:, None, :], logits + bias, NEG_INF)
    sh = logits.shape
    probs = jax.nn.softmax(logits.reshape(sh[:4] + (wr * GRID_W,)), axis=-1).reshape(sh)
    out = jnp.einsum('bhrqwc,bhrwcd->bhrqd', probs.astype(v_rows.dtype), v_rows)
    return out.transpose(0, 2, 3, 1, 4).reshape(B, L, C_WIDTH)


def _trunk(x, p, W):
    h = x
    for l in range(DEPTH):
        u = _rmsnorm(h, W['norm_in'][l])
        (aq, ak, av, az, bcq, bckv, bkr, bz, cq, ck, cv, cz) = _split(u @ W['w_in'][l], IN_SPLITS)
        ya = _window_gqa(aq, ak, av, W['a_q_norm'][l], W['a_k_norm'][l], W['a_sink'][l]) * jax.nn.silu(az)
        yb = _mla(bcq, bckv, bkr, W['b_cq_norm'][l], W['b_ckv_norm'][l], W['b_w_uq'][l], W['b_w_ukv'][l],
                  W['b_q_norm'][l], W['b_k_norm'][l]) * jax.nn.silu(bz)
        yc = _neighbourhood(cq, ck, cv, W['c_q_norm'][l], W['c_k_norm'][l], W['c_rpb'][l]) * jax.nn.silu(cz)
        h = h + jnp.concatenate([ya, yb, yc], axis=-1) @ W['w_out'][l]
        gate = jax.nn.sigmoid(_rmsnorm(h, W['ple_norm'][l]) @ W['w_ple_gate'][l])
        h = h + gate * _rmsnorm(p[l] @ W['w_ple_proj'][l], W['ple_post_norm'][l])
    return h


def setup_inputs(seed: int = 0) -> dict:
    key = jax.random.key(seed)
    ks = jax.random.split(key, 24)
    f32 = jnp.float32

    def nrm(k, shape, scale):
        return jax.random.normal(k, shape, f32) * scale

    def gain(k, shape):
        return 1.0 + 0.05 * jax.random.normal(k, shape, f32)

    return {
        'x_prompt': nrm(ks[0], (BATCH, SEQ, D_MODEL), 1.0),
        'x_sample': nrm(ks[1], (DEC_BATCH, DEC_SEQ, D_MODEL), 1.0),
        'p_prompt': nrm(ks[2], (DEPTH, BATCH, SEQ, PLE_DIM), 1.0),
        'p_sample': nrm(ks[3], (DEPTH, DEC_BATCH, DEC_SEQ, PLE_DIM), 1.0),
        'norm_in': gain(ks[4], (DEPTH, D_MODEL)),
        'w_in': nrm(ks[5], (DEPTH, D_MODEL, IN_WIDTH), D_MODEL ** -0.5),
        'a_q_norm': gain(ks[6], (DEPTH, HEAD_DIM)),
        'a_k_norm': gain(ks[7], (DEPTH, HEAD_DIM)),
        'a_sink': nrm(ks[8], (DEPTH, A_HEADS), 0.5),
        'b_cq_norm': gain(ks[9], (DEPTH, B_Q_LORA)),
        'b_ckv_norm': gain(ks[10], (DEPTH, B_KV_LORA)),
        'b_w_uq': nrm(ks[11], (DEPTH, B_Q_LORA, B_HEADS * B_QK), B_Q_LORA ** -0.5),
        'b_w_ukv': nrm(ks[12], (DEPTH, B_KV_LORA, B_HEADS * (B_NOPE + B_V)), B_KV_LORA ** -0.5),
        'b_q_norm': gain(ks[13], (DEPTH, B_QK)),
        'b_k_norm': gain(ks[14], (DEPTH, B_QK)),
        'c_q_norm': gain(ks[15], (DEPTH, HEAD_DIM)),
        'c_k_norm': gain(ks[16], (DEPTH, HEAD_DIM)),
        'c_rpb': nrm(ks[17], (DEPTH, C_HEADS, 2 * NA_ROWS_MAX - 1, 2 * NA_COLS - 1), 0.1),
        'w_out': nrm(ks[18], (DEPTH, MIX_WIDTH, D_MODEL), MIX_WIDTH ** -0.5),
        'ple_norm': gain(ks[19], (DEPTH, D_MODEL)),
        'w_ple_gate': nrm(ks[20], (DEPTH, D_MODEL, D_MODEL), D_MODEL ** -0.5),
        'w_ple_proj': nrm(ks[21], (DEPTH, PLE_DIM, D_MODEL), PLE_DIM ** -0.5),
        'ple_post_norm': gain(ks[22], (DEPTH, D_MODEL)),
    }


def reference(x_prompt, x_sample, p_prompt, p_sample, norm_in, w_in, a_q_norm, a_k_norm, a_sink,
              b_cq_norm, b_ckv_norm, b_w_uq, b_w_ukv, b_q_norm, b_k_norm, c_q_norm, c_k_norm, c_rpb,
              w_out, ple_norm, w_ple_gate, w_ple_proj, ple_post_norm):
    W = {
        'norm_in': norm_in, 'w_in': w_in,
        'a_q_norm': a_q_norm, 'a_k_norm': a_k_norm, 'a_sink': a_sink,
        'b_cq_norm': b_cq_norm, 'b_ckv_norm': b_ckv_norm, 'b_w_uq': b_w_uq, 'b_w_ukv': b_w_ukv,
        'b_q_norm': b_q_norm, 'b_k_norm': b_k_norm,
        'c_q_norm': c_q_norm, 'c_k_norm': c_k_norm, 'c_rpb': c_rpb,
        'w_out': w_out, 'ple_norm': ple_norm, 'w_ple_gate': w_ple_gate,
        'w_ple_proj': w_ple_proj, 'ple_post_norm': ple_post_norm,
    }
    y_prompt = _trunk(x_prompt, p_prompt, W)
    y_sample = _trunk(x_sample, p_sample, W)
    return (y_prompt, y_sample)
```

```cpp
#include <hip/hip_runtime.h>
#include <math.h>

constexpr int SEQ = 2048, DM = 2048, INW = 5952, NSEQ = 20, TTOT = NSEQ * SEQ;
constexpr int CH = 8192;
constexpr int O_AQ = 0, O_AK = 768, O_AV = 1024, O_AZ = 1280, O_BCQ = 2048, O_BCKV = 2560, O_BKR = 3072, O_BZ = 3136,
              O_CQ = 3904, O_CK = 4416, O_CV = 4928, O_CZ = 5440;

__device__ __forceinline__ float wave_sum(float v) {
#pragma unroll
    for (int o = 32; o >= 1; o >>= 1) v += __shfl_xor(v, o);
    return v;
}

__global__ void k_rms(const float* in, int ldi, const float* g, float* out, int ldo, int rows, int nheads, int n) {
    int w = (blockIdx.x * blockDim.x + threadIdx.x) >> 6, lane = threadIdx.x & 63;
    if (w >= rows * nheads) return;
    int r = w / nheads, hh = w % nheads;
    const float* p = in + (size_t)r * ldi + hh * n;
    float* q = out + (size_t)r * ldo + hh * n;
    float s = 0.f;
    for (int c = lane; c < n; c += 64) { float v = p[c]; s += v * v; }
    s = wave_sum(s);
    float rr = 1.0f / sqrtf(s / (float)n + 1e-6f);
    for (int c = lane; c < n; c += 64) q[c] = p[c] * rr * g[c];
}

__global__ void k_add_rms(float* h, const float* tmp, const float* g, float* u, int rows) {
    int w = (blockIdx.x * blockDim.x + threadIdx.x) >> 6, lane = threadIdx.x & 63;
    if (w >= rows) return;
    float* p = h + (size_t)w * DM; const float* t = tmp + (size_t)w * DM; float* q = u + (size_t)w * DM;
    float s = 0.f;
    for (int c = lane; c < DM; c += 64) { float v = p[c] + t[c]; p[c] = v; s += v * v; }
    s = wave_sum(s);
    float rr = 1.0f / sqrtf(s / (float)DM + 1e-6f);
    for (int c = lane; c < DM; c += 64) q[c] = p[c] * rr * g[c];
}

__global__ void k_final(float* h, const float* G, const float* PP, const float* g, int rows) {
    int w = (blockIdx.x * blockDim.x + threadIdx.x) >> 6, lane = threadIdx.x & 63;
    if (w >= rows) return;
    float* p = h + (size_t)w * DM; const float* gg = G + (size_t)w * DM; const float* pp = PP + (size_t)w * DM;
    float s = 0.f;
    for (int c = lane; c < DM; c += 64) { float v = pp[c]; s += v * v; }
    s = wave_sum(s);
    float rr = 1.0f / sqrtf(s / (float)DM + 1e-6f);
    for (int c = lane; c < DM; c += 64) { float sg = 1.0f / (1.0f + expf(-gg[c])); p[c] = p[c] + sg * (pp[c] * rr * g[c]); }
}

__global__ __launch_bounds__(256) void k_gemm_f32(const float* A, int lda, const float* B, int ldb, float* C, int ldc, int K) {
    __shared__ float As[16][132];
    __shared__ float Bs[16][64];
    int tid = threadIdx.x, tx = tid & 15, ty = tid >> 4;
    int m0 = blockIdx.y * 128, n0 = blockIdx.x * 64;
    float acc[8][4];
#pragma unroll
    for (int i = 0; i < 8; i++)
#pragma unroll
        for (int j = 0; j < 4; j++) acc[i][j] = 0.f;
    for (int k0 = 0; k0 < K; k0 += 16) {
#pragma unroll
        for (int i = 0; i < 2; i++) {
            int idx = tid + i * 256; int m = idx >> 2, kq = (idx & 3) * 4;
            float4 v = *(const float4*)(A + (size_t)(m0 + m) * lda + k0 + kq);
            As[kq][m] = v.x; As[kq + 1][m] = v.y; As[kq + 2][m] = v.z; As[kq + 3][m] = v.w;
        }
        { int k = tid >> 4, nq = (tid & 15) * 4; float4 v = *(const float4*)(B + (size_t)(k0 + k) * ldb + n0 + nq); *(float4*)&Bs[k][nq] = v; }
        __syncthreads();
#pragma unroll
        for (int k = 0; k < 16; k++) {
            float4 a0 = *(const float4*)&As[k][ty * 8], a1 = *(const float4*)&As[k][ty * 8 + 4];
            float4 b = *(const float4*)&Bs[k][tx * 4];
            float a[8] = {a0.x, a0.y, a0.z, a0.w, a1.x, a1.y, a1.z, a1.w};
            float bb[4] = {b.x, b.y, b.z, b.w};
#pragma unroll
            for (int i = 0; i < 8; i++)
#pragma unroll
                for (int j = 0; j < 4; j++) acc[i][j] += a[i] * bb[j];
        }
        __syncthreads();
    }
#pragma unroll
    for (int i = 0; i < 8; i++) {
        float4 v = {acc[i][0], acc[i][1], acc[i][2], acc[i][3]};
        *(float4*)(C + (size_t)(m0 + ty * 8 + i) * ldc + n0 + tx * 4) = v;
    }
}

__global__ void k_rope_tab(float2* tab) {
    int i = blockIdx.x * blockDim.x + threadIdx.x;
    if (i >= SEQ * 32) return;
    int pos = i >> 5, j = i & 31;
    double inv = pow(10000.0, -(double)j / 32.0);
    double ang = (double)pos * inv;
    tab[i] = make_float2((float)cos(ang), (float)sin(ang));
}

__global__ void k_mla_prep(float* QB, const float* KVB, const float* PROJ, float* KB, const float* gq, const float* gk, const float2* tab, int rows) {
    int w = (blockIdx.x * blockDim.x + threadIdx.x) >> 6, lane = threadIdx.x & 63;
    if (w >= rows * 6) return;
    int t = w / 6, h = w % 6; int pos = t % SEQ;
    float2 cs = tab[pos * 32 + (lane & 31)];
    {
        float* q = QB + (size_t)t * 1152 + h * 192;
        float v0 = q[lane], v1 = q[64 + lane], v2 = q[128 + lane];
        float s = wave_sum(v0 * v0 + v1 * v1 + v2 * v2);
        float rr = 1.0f / sqrtf(s / 192.0f + 1e-6f);
        v0 *= rr * gq[lane]; v1 *= rr * gq[64 + lane]; v2 *= rr * gq[128 + lane];
        float pr = __shfl_xor(v2, 32);
        float o = (lane < 32) ? (v2 * cs.x - pr * cs.y) : (pr * cs.y + v2 * cs.x);
        q[lane] = v0; q[64 + lane] = v1; q[128 + lane] = o;
    }
    {
        const float* kn = KVB + (size_t)t * 1536 + h * 256;
        float v0 = kn[lane], v1 = kn[64 + lane], v2 = PROJ[(size_t)t * INW + O_BKR + lane];
        float s = wave_sum(v0 * v0 + v1 * v1 + v2 * v2);
        float rr = 1.0f / sqrtf(s / 192.0f + 1e-6f);
        v0 *= rr * gk[lane]; v1 *= rr * gk[64 + lane]; v2 *= rr * gk[128 + lane];
        float pr = __shfl_xor(v2, 32);
        float o = (lane < 32) ? (v2 * cs.x - pr * cs.y) : (pr * cs.y + v2 * cs.x);
        float* k = KB + (size_t)t * 1152 + h * 192;
        k[lane] = v0; k[64 + lane] = v1; k[128 + lane] = o;
    }
}

template <int MODE, int DQK>
__global__ __launch_bounds__(256) void k_attn(const float* Q, int ldq, const float* Kp, int ldk, const float* Vp, int ldv,
                                              const float* Z, int ldz, float* Y, int ldy, const float* extra) {
    __shared__ float Qs[64][65];
    __shared__ float Ks[32][65];
    __shared__ float Vs[32][128];
    __shared__ float Ps[64][33];
    int tid = threadIdx.x, tx = tid & 15, ty = tid >> 4;
    int qt = blockIdx.x, h = blockIdx.y;
    int t0 = qt * 64, pos0 = t0 % SEQ, sb = t0 - pos0;
    const float *Qh, *Kh, *Vh;
    float scale, slope = 0.f;
    if (MODE == 0) { Qh = Q + h * 128; Kh = Kp + (h / 3) * 128; Vh = Vp + (h / 3) * 128; scale = 0.08838834764831845f; slope = exp2f(-8.0f * (float)(h + 1) / 6.0f); }
    else if (MODE == 1) { Qh = Q + h * 192; Kh = Kp + h * 192; Vh = Vp + h * 256 + 128; scale = 0.07216878364870323f; }
    else { Qh = Q + h * 128; Kh = Kp + h * 128; Vh = Vp + h * 128; scale = 0.08838834764831845f; }
    int klo, khi;
    if (MODE == 0) { klo = max(0, pos0 - 128); khi = min(SEQ, pos0 + 192); }
    else if (MODE == 1) { klo = 0; khi = SEQ; }
    else { int r = pos0 >> 6; int rs = min(max(r - 4, 0), 24); klo = rs * 64; khi = klo + 512; }
    float m[4], l[4], O[4][8];
#pragma unroll
    for (int i = 0; i < 4; i++) { m[i] = -1e30f; l[i] = 0.f;
#pragma unroll
        for (int c = 0; c < 8; c++) O[i][c] = 0.f; }
    for (int kb = klo; kb < khi; kb += 32) {
        float S[4][2];
#pragma unroll
        for (int i = 0; i < 4; i++) { S[i][0] = 0.f; S[i][1] = 0.f; }
        for (int dc = 0; dc < DQK; dc += 64) {
            for (int i = tid; i < 64 * 64; i += 256) { int r = i >> 6, d = i & 63; Qs[r][d] = Qh[(size_t)(t0 + r) * ldq + dc + d]; }
            for (int i = tid; i < 32 * 64; i += 256) { int r = i >> 6, d = i & 63; Ks[r][d] = Kh[(size_t)(sb + kb + r) * ldk + dc + d]; }
            __syncthreads();
            for (int d = 0; d < 64; d++) {
                float k0 = Ks[tx * 2][d], k1 = Ks[tx * 2 + 1][d];
#pragma unroll
                for (int i = 0; i < 4; i++) { float q = Qs[ty * 4 + i][d]; S[i][0] += q * k0; S[i][1] += q * k1; }
            }
            __syncthreads();
        }
        for (int i = tid; i < 32 * 128; i += 256) { int r = i >> 7, c = i & 127; Vs[r][c] = Vh[(size_t)(sb + kb + r) * ldv + c]; }
#pragma unroll
        for (int i = 0; i < 4; i++) {
            int qi = ty * 4 + i, qpos = pos0 + qi;
#pragma unroll
            for (int j = 0; j < 2; j++) {
                int kpos = kb + tx * 2 + j;
                float s = S[i][j] * scale; bool valid = true;
                if (MODE == 0) { int dl = abs(kpos - qpos); valid = dl <= 128; s -= slope * (float)dl; }
                if (MODE == 2) {
                    int c = qpos & 63, r = qpos >> 6, kc = kpos & 63, kr = kpos >> 6;
                    int cs = min(max(c - 8, 0), 48); valid = (kc >= cs) && (kc < cs + 16);
                    int dcl = min(max(kc - c + 15, 0), 30);
                    s += extra[h * 15 * 31 + (kr - r + 7) * 31 + dcl];
                }
                S[i][j] = valid ? s : -1e30f;
            }
            float mx = fmaxf(S[i][0], S[i][1]);
            mx = fmaxf(mx, __shfl_xor(mx, 1)); mx = fmaxf(mx, __shfl_xor(mx, 2)); mx = fmaxf(mx, __shfl_xor(mx, 4)); mx = fmaxf(mx, __shfl_xor(mx, 8));
            float mn = fmaxf(m[i], mx);
            float alpha = expf(m[i] - mn);
            float p0 = (S[i][0] > -1e29f) ? expf(S[i][0] - mn) : 0.f;
            float p1 = (S[i][1] > -1e29f) ? expf(S[i][1] - mn) : 0.f;
            float rs = p0 + p1;
            rs += __shfl_xor(rs, 1); rs += __shfl_xor(rs, 2); rs += __shfl_xor(rs, 4); rs += __shfl_xor(rs, 8);
            l[i] = l[i] * alpha + rs; m[i] = mn;
#pragma unroll
            for (int c = 0; c < 8; c++) O[i][c] *= alpha;
            Ps[qi][tx * 2] = p0; Ps[qi][tx * 2 + 1] = p1;
        }
        __syncthreads();
        for (int k = 0; k < 32; k++) {
            float4 va = *(const float4*)&Vs[k][tx * 8], vb = *(const float4*)&Vs[k][tx * 8 + 4];
#pragma unroll
            for (int i = 0; i < 4; i++) {
                float p = Ps[ty * 4 + i][k];
                O[i][0] += p * va.x; O[i][1] += p * va.y; O[i][2] += p * va.z; O[i][3] += p * va.w;
                O[i][4] += p * vb.x; O[i][5] += p * vb.y; O[i][6] += p * vb.z; O[i][7] += p * vb.w;
            }
        }
        __syncthreads();
    }
#pragma unroll
    for (int i = 0; i < 4; i++) {
        int qi = ty * 4 + i;
        float f;
        if (MODE == 0) { float sk = extra[h]; float mf = fmaxf(m[i], sk); float a = expf(m[i] - mf); f = a / (l[i] * a + expf(sk - mf)); }
        else f = 1.0f / l[i];
        const float* z = Z + (size_t)(t0 + qi) * ldz + h * 128 + tx * 8;
        float* y = Y + (size_t)(t0 + qi) * ldy + h * 128 + tx * 8;
#pragma unroll
        for (int c = 0; c < 8; c++) { float zz = z[c]; float sl = zz / (1.0f + expf(-zz)); y[c] = O[i][c] * f * sl; }
    }
}

extern "C" void kernel_launch(void* const* d_in, const int* in_sizes, int n_in, void* d_out, int out_size, void* d_ws, size_t ws_size,
                              hipStream_t stream) {
    const float* x_prompt = (const float*)d_in[0]; const float* x_sample = (const float*)d_in[1];
    const float* p_prompt = (const float*)d_in[2]; const float* p_sample = (const float*)d_in[3];
    const float* norm_in = (const float*)d_in[4]; const float* w_in = (const float*)d_in[5];
    const float* a_q_norm = (const float*)d_in[6]; const float* a_k_norm = (const float*)d_in[7]; const float* a_sink = (const float*)d_in[8];
    const float* b_cq_norm = (const float*)d_in[9]; const float* b_ckv_norm = (const float*)d_in[10];
    const float* b_w_uq = (const float*)d_in[11]; const float* b_w_ukv = (const float*)d_in[12];
    const float* b_q_norm = (const float*)d_in[13]; const float* b_k_norm = (const float*)d_in[14];
    const float* c_q_norm = (const float*)d_in[15]; const float* c_k_norm = (const float*)d_in[16]; const float* c_rpb = (const float*)d_in[17];
    const float* w_out = (const float*)d_in[18]; const float* ple_norm = (const float*)d_in[19]; const float* w_gate = (const float*)d_in[20];
    const float* w_proj = (const float*)d_in[21]; const float* post_norm = (const float*)d_in[22];
    float* h = (float*)d_out;
    float* ws = (float*)d_ws;
    float* U = ws; ws += (size_t)CH * DM;
    float* PROJ = ws; ws += (size_t)CH * INW;
    float* QB = ws; ws += (size_t)CH * 1152;
    float* KVB = ws; ws += (size_t)CH * 1536;
    float* KB = ws; ws += (size_t)CH * 1152;
    float* Y = ws; ws += (size_t)CH * DM;
    float* TMP = ws; ws += (size_t)CH * DM;
    float* G = ws; ws += (size_t)CH * DM;
    float* PP = ws; ws += (size_t)CH * DM;
    float2* tab = (float2*)ws;

    hipMemcpyAsync(h, x_prompt, (size_t)8192 * DM * 4, hipMemcpyDeviceToDevice, stream);
    hipMemcpyAsync(h + (size_t)8192 * DM, x_sample, (size_t)32768 * DM * 4, hipMemcpyDeviceToDevice, stream);
    k_rope_tab<<<SEQ * 32 / 256, 256, 0, stream>>>(tab);
    const int RB = CH * 64 / 256;
    for (int l = 0; l < 4; l++) {
        for (int c = 0; c < 5; c++) {
            float* hc = h + (size_t)c * CH * DM;
            const float* pc = (c == 0) ? p_prompt + (size_t)l * 8192 * 256 : p_sample + ((size_t)l * 32768 + (size_t)(c - 1) * CH) * 256;
            k_rms<<<RB, 256, 0, stream>>>(hc, DM, norm_in + l * DM, U, DM, CH, 1, DM);
            k_gemm_f32<<<dim3(INW / 64, CH / 128), 256, 0, stream>>>(U, DM, w_in + (size_t)l * DM * INW, INW, PROJ, INW, DM);
            k_rms<<<RB * 6, 256, 0, stream>>>(PROJ + O_AQ, INW, a_q_norm + l * 128, PROJ + O_AQ, INW, CH, 6, 128);
            k_rms<<<RB * 2, 256, 0, stream>>>(PROJ + O_AK, INW, a_k_norm + l * 128, PROJ + O_AK, INW, CH, 2, 128);
            k_rms<<<RB * 4, 256, 0, stream>>>(PROJ + O_CQ, INW, c_q_norm + l * 128, PROJ + O_CQ, INW, CH, 4, 128);
            k_rms<<<RB * 4, 256, 0, stream>>>(PROJ + O_CK, INW, c_k_norm + l * 128, PROJ + O_CK, INW, CH, 4, 128);
            k_rms<<<RB, 256, 0, stream>>>(PROJ + O_BCQ, INW, b_cq_norm + l * 512, PROJ + O_BCQ, INW, CH, 1, 512);
            k_rms<<<RB, 256, 0, stream>>>(PROJ + O_BCKV, INW, b_ckv_norm + l * 512, PROJ + O_BCKV, INW, CH, 1, 512);
            k_gemm_f32<<<dim3(1152 / 64, CH / 128), 256, 0, stream>>>(PROJ + O_BCQ, INW, b_w_uq + (size_t)l * 512 * 1152, 1152, QB, 1152, 512);
            k_gemm_f32<<<dim3(1536 / 64, CH / 128), 256, 0, stream>>>(PROJ + O_BCKV, INW, b_w_ukv + (size_t)l * 512 * 1536, 1536, KVB, 1536, 512);
            k_mla_prep<<<RB * 6, 256, 0, stream>>>(QB, KVB, PROJ, KB, b_q_norm + l * 192, b_k_norm + l * 192, tab, CH);
            k_attn<0, 128><<<dim3(CH / 64, 6), 256, 0, stream>>>(PROJ + O_AQ, INW, PROJ + O_AK, INW, PROJ + O_AV, INW, PROJ + O_AZ, INW, Y, DM, a_sink + l * 6);
            k_attn<1, 192><<<dim3(CH / 64, 6), 256, 0, stream>>>(QB, 1152, KB, 1152, KVB, 1536, PROJ + O_BZ, INW, Y + 768, DM, nullptr);
            k_attn<2, 128><<<dim3(CH / 64, 4), 256, 0, stream>>>(PROJ + O_CQ, INW, PROJ + O_CK, INW, PROJ + O_CV, INW, PROJ + O_CZ, INW, Y + 1536, DM, c_rpb + (size_t)l * 4 * 15 * 31);
            k_gemm_f32<<<dim3(DM / 64, CH / 128), 256, 0, stream>>>(Y, DM, w_out + (size_t)l * DM * DM, DM, TMP, DM, DM);
            k_add_rms<<<RB, 256, 0, stream>>>(hc, TMP, ple_norm + l * DM, U, CH);
            k_gemm_f32<<<dim3(DM / 64, CH / 128), 256, 0, stream>>>(U, DM, w_gate + (size_t)l * DM * DM, DM, G, DM, DM);
            k_gemm_f32<<<dim3(DM / 64, CH / 128), 256, 0, stream>>>(pc, 256, w_proj + (size_t)l * 256 * DM, DM, PP, DM, 256);
            k_final<<<RB, 256, 0, stream>>>(hc, G, PP, post_norm + l * DM, CH);
        }
    }
}
```

```cpp
#include <hip/hip_runtime.h>
#include <hip/hip_cooperative_groups.h>
#include <cstdio>
#include <math.h>
namespace cg = cooperative_groups;

#define LAS __attribute__((address_space(3)))
typedef unsigned short bf16_t;
typedef short bf16x8 __attribute__((ext_vector_type(8)));
typedef float f32x4 __attribute__((ext_vector_type(4)));
typedef unsigned u32x4 __attribute__((ext_vector_type(4)));
typedef unsigned u32x2 __attribute__((ext_vector_type(2)));

constexpr int SEQ = 2048, DM = 2048, INW = 5952, TTOT = 40960, NP = 6144;
constexpr int O_AQ = 0, O_AK = 768, O_AV = 1024, O_AZ = 1280, O_BCQ = 2048, O_BCKV = 2560, O_BKR = 3072, O_BZ = 3136, O_CQ = 3904, O_CK = 4416, O_CV = 4928, O_CZ = 5440;
constexpr int C_AQ = 0, C_AK = 768, C_AV = 1024, C_BCQ = 1280, C_BCKV = 1792, C_CQ = 2304, C_CK = 2816, C_CV = 3328, C_Z = 3840, C_KR = 5888;
constexpr float LOG2E = 1.4426950408889634f;
constexpr float QS_A = 0.08838834764831845f * LOG2E;
constexpr float QS_B = 0.07216878364870323f * LOG2E;
constexpr size_t SZ_WIN = (size_t)NP * 2048 * 2, SZ_WU = (size_t)1536 * 512 * 2, SZ_WSQ = (size_t)2048 * 2048 * 2, SZ_WPROJ = (size_t)2048 * 256 * 2;
constexpr size_t OFF_WIN = 0, OFF_WUQ = OFF_WIN + 4 * SZ_WIN, OFF_WUKV = OFF_WUQ + 4 * SZ_WU, OFF_WOUT = OFF_WUKV + 4 * SZ_WU, OFF_WGATE = OFF_WOUT + 4 * SZ_WSQ,
                 OFF_WPROJ = OFF_WGATE + 4 * SZ_WSQ, OFF_HBB = OFF_WPROJ + 4 * SZ_WPROJ, OFF_PB = OFF_HBB + (size_t)TTOT * DM * 2,
                 OFF_PROJ = OFF_PB + (size_t)4 * TTOT * 256 * 2, OFF_QB = OFF_PROJ + (size_t)32768 * NP * 2, OFF_KB = OFF_QB + (size_t)32768 * 1152 * 2,
                 OFF_VB = OFF_KB + (size_t)32768 * 1152 * 2, OFF_SS = OFF_VB + (size_t)32768 * 768 * 2, OFF_TAB = OFF_SS + (size_t)6 * 4 * TTOT * 4,
                 OFF_GT = OFF_TAB + (size_t)SEQ * 32 * 8, WS_END = OFF_GT + 4 * 4 * 128 * 4;
constexpr int LDS_STAGE = 131072, LDS_BYTES = LDS_STAGE + 8192;

struct Params {
    const float *x_prompt, *x_sample, *p_prompt, *p_sample, *norm_in, *w_in, *a_q_norm, *a_k_norm, *a_sink, *b_cq_norm, *b_ckv_norm, *b_w_uq, *b_w_ukv,
        *b_q_norm, *b_k_norm, *c_q_norm, *c_k_norm, *c_rpb, *w_out, *ple_norm, *w_gate, *w_proj, *post_norm;
    float* h;
    unsigned char* ws;
};

__device__ __forceinline__ unsigned cvt_pk_bf16(float lo, float hi) { unsigned r; asm volatile("v_cvt_pk_bf16_f32 %0, %1, %2" : "=v"(r) : "v"(lo), "v"(hi)); return r; }
__device__ __forceinline__ float bf2f(unsigned short b) { return __uint_as_float(((unsigned)b) << 16); }
__device__ __forceinline__ float bflo(unsigned w) { return __uint_as_float(w << 16); }
__device__ __forceinline__ float bfhi(unsigned w) { return __uint_as_float(w & 0xffff0000u); }
__device__ __forceinline__ float wave_sum(float v) {
#pragma unroll
    for (int o = 32; o >= 1; o >>= 1) v += __shfl_xor(v, o);
    return v;
}

namespace pg8 {
constexpr int BM = 256, BK = 64, HALF = 128, HTB = HALF * BK * 2, STAGE_BYTES = 8 * HTB, NXCD = 8, WGM = 8;
__device__ __forceinline__ int lds_byte(int r, int c) { const int st = (r >> 4) * 2 + (c >> 5), rr = r & 15, cc = c & 31, ob = rr * 64 + cc * 2; return st * 1024 + (ob ^ (((ob >> 9) & 1) << 5)); }
__device__ __forceinline__ void stage_rc(int b, int& R, int& C) { const int st = b / 1024, sb = b % 1024, swz = sb ^ (((sb >> 9) & 1) << 5); R = (st >> 1) * 16 + swz / 64; C = (st & 1) * 32 + (swz % 64) / 2; }
__device__ __forceinline__ int perm32(int rho) { const int n = rho >> 4, i = rho & 15; return 8 * (i >> 2) + 4 * n + (i & 3); }
struct Unit { int pm, pn; };
struct Gemm { const bf16_t* A; const bf16_t* Bt; int lda, M, N, K; };
struct StaticOrder {
    int nM, nN, nwg, G, c;
    __device__ void init(int M, int N, int G_, int c_) { nM = M / BM; nN = N / BM; nwg = nM * nN; G = G_; c = c_; }
    __device__ bool next(int i, Unit& u) const {
        const long L = (long)i * G + c; if (L >= nwg) return false;
        int wgid = (int)L; { const int q = nwg / NXCD, r = nwg % NXCD, xcd = wgid % NXCD, off = wgid / NXCD; wgid = (xcd < r ? xcd * (q + 1) : r * (q + 1) + (xcd - r) * q) + off; }
        const int nig = WGM * nN, gid = wgid / nig, fm = gid * WGM, gsz = (nM - fm) < WGM ? (nM - fm) : WGM;
        u.pm = fm + ((wgid % nig) % gsz); u.pn = (wgid % nig) / gsz; return true;
    }
};

template <class Epi>
__device__ __forceinline__ void gemm_phase(LAS unsigned char* lds, const Gemm g, const StaticOrder& S, const Epi& E) {
    int tid = threadIdx.x; asm volatile("" : "+v"(tid));
    const int wid = __builtin_amdgcn_readfirstlane(tid >> 6), lane = tid & 63, wr = wid >> 2, wc = wid & 3, fr = lane & 15, fq = lane >> 4;
    const int K = g.K, nt = K / BK;
    unsigned voffA[2], voffB[2];
#pragma unroll
    for (int i = 0; i < 2; ++i) { int R, C; stage_rc(tid * 16 + i * 8192, R, C); const int Rb = Epi::PERM ? ((R & ~31) + perm32(R & 31)) : R;
        voffA[i] = (unsigned)(R * g.lda + C) * 2u; voffB[i] = (unsigned)(Rb * K + C) * 2u; }
    const size_t kstep = (size_t)(BK * 2);
    const size_t hstepA = (size_t)HALF * g.lda * 2, hstepB = (size_t)HALF * K * 2;
    const size_t tstepA = 2 * hstepA, tstepB = 2 * hstepB;
    const unsigned ldsw = (unsigned)wid * 1024u;
    const int aoff = lds_byte(wr * 64 + fr, fq * 8), boff = lds_byte(wc * 32 + fr, fq * 8);
#define PG8_SA(b, h) (((b) * 2 + (h)) * HTB)
#define PG8_SB(b, h) ((4 + (b) * 2 + (h)) * HTB)
#define PG8_STAGE(bufoff, gbase, voff) do { _Pragma("unroll") for (int _i = 0; _i < 2; ++_i) \
        __builtin_amdgcn_global_load_lds((const unsigned*)((const char*)(gbase) + (voff)[_i]), (LAS unsigned*)(lds + (bufoff) + ldsw + _i * 8192), 16, 0, 0); } while (0)
#define PG8_LDA(dst, b, h) do { _Pragma("unroll") for (int m = 0; m < 4; ++m) _Pragma("unroll") for (int k = 0; k < 2; ++k) dst[m][k] = *(const LAS bf16x8*)(lds + PG8_SA(b, h) + aoff + m * 2048 + k * 1024); } while (0)
#define PG8_LDB(dst, b, h) do { _Pragma("unroll") for (int n = 0; n < 2; ++n) _Pragma("unroll") for (int k = 0; k < 2; ++k) dst[n][k] = *(const LAS bf16x8*)(lds + PG8_SB(b, h) + boff + n * 2048 + k * 1024); } while (0)
#define PG8_MMA(ai, bj, At, Bt) do { __builtin_amdgcn_s_setprio(1); _Pragma("unroll") for (int m = 0; m < 4; ++m) _Pragma("unroll") for (int n = 0; n < 2; ++n) _Pragma("unroll") for (int k = 0; k < 2; ++k) \
        acc[ai][bj][m][n] = __builtin_amdgcn_mfma_f32_16x16x32_bf16(Bt[n][k], At[m][k], acc[ai][bj][m][n], 0, 0, 0); __builtin_amdgcn_s_setprio(0); } while (0)
#define PG8_WAIT_V(n) asm volatile("s_waitcnt vmcnt(" #n ")" ::: "memory")
#define PG8_WAIT_L(n) asm volatile("s_waitcnt lgkmcnt(" #n ")" ::: "memory")
#define PG8_BAR __builtin_amdgcn_s_barrier()
#define PG8_SCHED __builtin_amdgcn_sched_barrier(0)
    Unit cur, nxt; int ui = 0;
    if (!S.next(0, cur)) return;
    f32x4 acc[2][2][4][2];
#pragma unroll
    for (int a = 0; a < 2; ++a)
#pragma unroll
        for (int b = 0; b < 2; ++b)
#pragma unroll
            for (int m = 0; m < 4; ++m)
#pragma unroll
                for (int n = 0; n < 2; ++n) acc[a][b][m][n] = (f32x4){0.f, 0.f, 0.f, 0.f};
    bf16x8 At[4][2], B0[2][2], B1[2][2];
    const char* cA = (const char*)g.A + (size_t)cur.pm * tstepA; const char* cB = (const char*)g.Bt + (size_t)cur.pn * tstepB;
    PG8_STAGE(PG8_SB(0, 0), cB, voffB); PG8_STAGE(PG8_SA(0, 0), cA, voffA); PG8_STAGE(PG8_SB(0, 1), cB + hstepB, voffB); PG8_STAGE(PG8_SA(0, 1), cA + hstepA, voffA);
    if (wr == 1) PG8_BAR;
    PG8_WAIT_V(4); PG8_BAR;
    PG8_STAGE(PG8_SB(1, 0), cB + kstep, voffB); PG8_STAGE(PG8_SA(1, 0), cA + kstep, voffA); PG8_STAGE(PG8_SB(1, 1), cB + hstepB + kstep, voffB);
    PG8_WAIT_V(6); PG8_BAR;
    for (;;) {
        const bool has_next = S.next(ui + 1, nxt);
        const char* nA = has_next ? (const char*)g.A + (size_t)nxt.pm * tstepA : cA; const char* nB = has_next ? (const char*)g.Bt + (size_t)nxt.pn * tstepB : cB;
        for (int t = 0; t < nt; t += 2) {
            const bool last = (t == nt - 2);
            const char* a1 = cA + (size_t)(t + 1) * kstep;
            const char* a2 = last ? nA : cA + (size_t)(t + 2) * kstep; const char* b2 = last ? nB : cB + (size_t)(t + 2) * kstep;
            const char* a3 = a2 + kstep; const char* b3 = b2 + kstep;
            PG8_LDB(B0, 0, 0); PG8_SCHED; PG8_LDA(At, 0, 0); PG8_STAGE(PG8_SA(1, 1), a1 + hstepA, voffA);
            PG8_WAIT_L(8); PG8_BAR; PG8_WAIT_L(0); PG8_MMA(0, 0, At, B0); PG8_BAR; PG8_SCHED;
            PG8_LDB(B1, 0, 1); PG8_STAGE(PG8_SB(0, 0), b2, voffB);
            PG8_BAR; PG8_WAIT_L(0); PG8_MMA(0, 1, At, B1); PG8_BAR;
            PG8_LDA(At, 0, 1); PG8_STAGE(PG8_SA(0, 0), a2, voffA);
            PG8_BAR; PG8_WAIT_L(0); PG8_MMA(1, 0, At, B0); PG8_BAR; PG8_SCHED;
            PG8_STAGE(PG8_SB(0, 1), b2 + hstepB, voffB);
            PG8_WAIT_V(6); PG8_BAR; PG8_MMA(1, 1, At, B1); PG8_BAR;
            PG8_LDB(B0, 1, 0); PG8_SCHED; PG8_LDA(At, 1, 0); PG8_STAGE(PG8_SA(0, 1), a2 + hstepA, voffA);
            PG8_WAIT_L(8); PG8_BAR; PG8_WAIT_L(0); PG8_MMA(0, 0, At, B0); PG8_BAR; PG8_SCHED;
            PG8_LDB(B1, 1, 1); PG8_STAGE(PG8_SB(1, 0), b3, voffB);
            PG8_BAR; PG8_WAIT_L(0); PG8_MMA(0, 1, At, B1); PG8_BAR;
            PG8_LDA(At, 1, 1); PG8_STAGE(PG8_SA(1, 0), a3, voffA);
            PG8_BAR; PG8_WAIT_L(0); PG8_MMA(1, 0, At, B0); PG8_BAR; PG8_SCHED;
            PG8_STAGE(PG8_SB(1, 1), b3 + hstepB, voffB);
            PG8_WAIT_V(6); PG8_BAR; PG8_MMA(1, 1, At, B1); PG8_BAR;
        }
        E(acc, cur, wr, wc, fr, fq);
        if (!has_next) break;
#pragma unroll
        for (int a = 0; a < 2; ++a)
#pragma unroll
            for (int b = 0; b < 2; ++b)
#pragma unroll
                for (int m = 0; m < 4; ++m)
#pragma unroll
                    for (int n = 0; n < 2; ++n) acc[a][b][m][n] = (f32x4){0.f, 0.f, 0.f, 0.f};
        cur = nxt; cA = nA; cB = nB; ++ui;
    }
    PG8_WAIT_V(0);
    if (wr == 0) PG8_BAR;
    PG8_BAR;
#undef PG8_SA
#undef PG8_SB
#undef PG8_STAGE
#undef PG8_LDA
#undef PG8_LDB
#undef PG8_MMA
#undef PG8_WAIT_V
#undef PG8_WAIT_L
#undef PG8_BAR
#undef PG8_SCHED
}
}
using pg8::Unit;
typedef f32x4 AccT[2][2][4][2];

#define EPI_BAR() do { asm volatile("s_waitcnt lgkmcnt(0)" ::: "memory"); __builtin_amdgcn_s_barrier(); asm volatile("" ::: "memory"); } while (0)
__device__ __forceinline__ float sq4(const f32x4 v) { return (v[0] * v[0] + v[1] * v[1]) + (v[2] * v[2] + v[3] * v[3]); }
__device__ __forceinline__ float red_fq(float s) { s += __shfl_xor(s, 16); s += __shfl_xor(s, 32); return s; }
__device__ __forceinline__ u32x4 pack8(const f32x4 a, const f32x4 b) { u32x4 w; w.x = cvt_pk_bf16(a[0], a[1]); w.y = cvt_pk_bf16(a[2], a[3]); w.z = cvt_pk_bf16(b[0], b[1]); w.w = cvt_pk_bf16(b[2], b[3]); return w; }

struct EpiProj {
    static constexpr bool PERM = true;
    bf16_t* PROJ; const float* ssh; float *ss_cq, *ss_kr;
    const float *gt, *g_kr; const float2* tab; LAS float* TABL;
    __device__ __forceinline__ void operator()(AccT& acc, const Unit& u, int wr, int wc, int fr, int fq) const {
        asm volatile("" : "+v"(fr), "+v"(fq));
        const int lrow0 = wr * 64 + fr, row0 = u.pm * 256 + lrow0, pn = u.pn;
        float rs[2][4];
#pragma unroll
        for (int ai = 0; ai < 2; ++ai)
#pragma unroll
            for (int m = 0; m < 4; ++m) rs[ai][m] = __builtin_amdgcn_rsqf(ssh[row0 + ai * 128 + m * 16] * (1.0f / 2048.0f) + 1e-6f);
        bf16_t* const outp = PROJ + (size_t)row0 * NP + pn * 256 + wc * 32 + 8 * fq;
        const bool is_norm = (pn <= 3) || (pn >= 9 && pn <= 12);
        if (is_norm) {
            const float* g = gt + ((pn <= 2) ? 0 : (pn == 3) ? 128 : (pn <= 10) ? 256 : 384);
            const float qs = (pn <= 2 || pn == 9 || pn == 10) ? QS_A : 1.0f;
#pragma unroll
            for (int ai = 0; ai < 2; ++ai)
#pragma unroll
                for (int m = 0; m < 4; ++m)
#pragma unroll
                    for (int bj = 0; bj < 2; ++bj) { float s = red_fq(sq4(acc[ai][bj][m][0]) + sq4(acc[ai][bj][m][1]));
                        if (fq == 0) TABL[((lrow0 + ai * 128 + m * 16) * 2 + bj) * 4 + wc] = s; asm volatile("" ::: "memory"); }
            EPI_BAR();
            const f32x4 g0 = *(const f32x4*)(g + 32 * wc + 8 * fq) * qs, g1 = *(const f32x4*)(g + 32 * wc + 8 * fq + 4) * qs;
#pragma unroll
            for (int ai = 0; ai < 2; ++ai)
#pragma unroll
                for (int m = 0; m < 4; ++m)
#pragma unroll
                    for (int bj = 0; bj < 2; ++bj) { const f32x4 t = *(const LAS f32x4*)&TABL[((lrow0 + ai * 128 + m * 16) * 2 + bj) * 4];
                        const float r2 = rs[ai][m] * rs[ai][m];
                        const float rn = rs[ai][m] * __builtin_amdgcn_rsqf(((t[0] + t[1]) + (t[2] + t[3])) * r2 * (1.0f / 128.0f) + 1e-6f);
                        *(u32x4*)(outp + (size_t)(ai * 128 + m * 16) * NP + bj * 128) = pack8(acc[ai][bj][m][0] * rn * g0, acc[ai][bj][m][1] * rn * g1);
                        asm volatile("" ::: "memory"); }
        } else if (pn >= 5 && pn <= 8) {
            float* ss = ss_cq + ((pn <= 6) ? 0 : 4 * TTOT);
#pragma unroll
            for (int ai = 0; ai < 2; ++ai)
#pragma unroll
                for (int m = 0; m < 4; ++m) { const float r = rs[ai][m];
                    float s = red_fq((sq4(acc[ai][0][m][0]) + sq4(acc[ai][0][m][1])) + (sq4(acc[ai][1][m][0]) + sq4(acc[ai][1][m][1]))) * (r * r);
                    if (fq == 0) unsafeAtomicAdd(ss + row0 + ai * 128 + m * 16, s);
#pragma unroll
                    for (int bj = 0; bj < 2; ++bj) *(u32x4*)(outp + (size_t)(ai * 128 + m * 16) * NP + bj * 128) = pack8(acc[ai][bj][m][0] * r, acc[ai][bj][m][1] * r);
                    asm volatile("" ::: "memory"); }
        } else if (pn >= 15 && pn <= 22) {
#pragma unroll
            for (int ai = 0; ai < 2; ++ai)
#pragma unroll
                for (int m = 0; m < 4; ++m) { const float r = rs[ai][m];
#pragma unroll
                    for (int bj = 0; bj < 2; ++bj) { f32x4 o0, o1;
#pragma unroll
                        for (int j = 0; j < 4; ++j) { const float v0 = acc[ai][bj][m][0][j] * r, v1 = acc[ai][bj][m][1][j] * r;
                            o0[j] = v0 * __builtin_amdgcn_rcpf(1.0f + __expf(-v0)); o1[j] = v1 * __builtin_amdgcn_rcpf(1.0f + __expf(-v1)); }
                        *(u32x4*)(outp + (size_t)(ai * 128 + m * 16) * NP + bj * 128) = pack8(o0, o1); }
                    asm volatile("" ::: "memory"); }
        } else if (pn == 23) {
            if (wc < 2) {
                const int gI = wc * 4 + fq;
                const f32x4 gk1 = *(const f32x4*)(g_kr + 4 * gI), gk2 = *(const f32x4*)(g_kr + 32 + 4 * gI);
#pragma unroll
                for (int ai = 0; ai < 2; ++ai)
#pragma unroll
                    for (int m = 0; m < 4; ++m) { const int row = row0 + ai * 128 + m * 16; const float r = rs[ai][m];
                        float s = red_fq(sq4(acc[ai][0][m][0]) + sq4(acc[ai][0][m][1])) * (r * r);
                        if (fq == 0) unsafeAtomicAdd(ss_kr + row, s);
                        const f32x4 x1 = acc[ai][0][m][0] * gk1 * r, x2 = acc[ai][0][m][1] * gk2 * r; f32x4 o1, o2;
                        const float2* tp = tab + (row & (SEQ - 1)) * 32 + 4 * gI;
#pragma unroll
                        for (int j = 0; j < 4; ++j) { const float2 cs = tp[j]; o1[j] = x1[j] * cs.x - x2[j] * cs.y; o2[j] = x1[j] * cs.y + x2[j] * cs.x; }
                        *(u32x4*)(PROJ + (size_t)row * NP + C_KR + 8 * gI) = pack8(o1, o2); asm volatile("" ::: "memory"); }
            }
        } else {
#pragma unroll
            for (int ai = 0; ai < 2; ++ai)
#pragma unroll
                for (int m = 0; m < 4; ++m) { const float r = rs[ai][m];
#pragma unroll
                    for (int bj = 0; bj < 2; ++bj) *(u32x4*)(outp + (size_t)(ai * 128 + m * 16) * NP + bj * 128) = pack8(acc[ai][bj][m][0] * r, acc[ai][bj][m][1] * r);
                    asm volatile("" ::: "memory"); }
        }
    }
};

struct EpiUQ {
    static constexpr bool PERM = true;
    bf16_t* QB; const float* ss_cq; const float* gq; const float2* tab; LAS float* TABL;
    __device__ __forceinline__ void operator()(AccT& acc, const Unit& u, int wr, int wc, int fr, int fq) const {
        asm volatile("" : "+v"(fr), "+v"(fq));
        const int lrow0 = wr * 64 + fr, row0 = u.pm * 256 + lrow0, h = u.pn;
#pragma unroll
        for (int ai = 0; ai < 2; ++ai)
#pragma unroll
            for (int m = 0; m < 4; ++m) { const float rs = __builtin_amdgcn_rsqf(ss_cq[row0 + ai * 128 + m * 16] * (1.0f / 512.0f) + 1e-6f);
#pragma unroll
                for (int bj = 0; bj < 2; ++bj) { acc[ai][bj][m][0] *= rs; acc[ai][bj][m][1] *= rs;
                    float s = red_fq(sq4(acc[ai][bj][m][0]) + sq4(acc[ai][bj][m][1]));
                    if (fq == 0) TABL[((lrow0 + ai * 128 + m * 16) * 2 + bj) * 4 + wc] = s; } asm volatile("" ::: "memory"); }
        EPI_BAR();
        const int gI = (wc & 1) * 4 + fq;
        const f32x4 g00 = *(const f32x4*)(gq + 32 * wc + 8 * fq), g01 = *(const f32x4*)(gq + 32 * wc + 8 * fq + 4);
        const f32x4 g10 = *(const f32x4*)(gq + 128 + 4 * gI), g11 = *(const f32x4*)(gq + 160 + 4 * gI);
#pragma unroll
        for (int ai = 0; ai < 2; ++ai)
#pragma unroll
            for (int m = 0; m < 4; ++m) { const int lrow = lrow0 + ai * 128 + m * 16, row = u.pm * 256 + lrow;
                const f32x4 t0 = *(const LAS f32x4*)&TABL[lrow * 8], t1 = *(const LAS f32x4*)&TABL[lrow * 8 + 4];
                const float rq = QS_B * __builtin_amdgcn_rsqf((((t0[0] + t0[1]) + (t0[2] + t0[3])) + ((t1[0] + t1[1]) + (t1[2] + t1[3]))) * (1.0f / 192.0f) + 1e-6f);
                bf16_t* rowp = QB + (size_t)row * 1152 + h * 192 + 32 * wc + 8 * fq;
                *(u32x4*)rowp = pack8(acc[ai][0][m][0] * rq * g00, acc[ai][0][m][1] * rq * g01);
                if (wc < 2) {
                    const f32x4 x1 = acc[ai][1][m][0] * rq * g10, x2 = acc[ai][1][m][1] * rq * g11; f32x4 o1, o2;
                    const float2* tp = tab + (row & (SEQ - 1)) * 32 + 4 * gI;
#pragma unroll
                    for (int j = 0; j < 4; ++j) { const float2 cs = tp[j]; o1[j] = x1[j] * cs.x - x2[j] * cs.y; o2[j] = x1[j] * cs.y + x2[j] * cs.x; }
                    *(u32x4*)(rowp + 128) = pack8(o1, o2);
                } asm volatile("" ::: "memory"); }
    }
};

struct EpiUKV {
    static constexpr bool PERM = true;
    bf16_t *KB, *VB; const bf16_t* PROJ; const float *ss_ckv, *ss_kr; const float* gk; LAS float* TABL;
    __device__ __forceinline__ void operator()(AccT& acc, const Unit& u, int wr, int wc, int fr, int fq) const {
        asm volatile("" : "+v"(fr), "+v"(fq));
        const int lrow0 = wr * 64 + fr, row0 = u.pm * 256 + lrow0, h = u.pn;
#pragma unroll
        for (int ai = 0; ai < 2; ++ai)
#pragma unroll
            for (int m = 0; m < 4; ++m) { const float rs = __builtin_amdgcn_rsqf(ss_ckv[row0 + ai * 128 + m * 16] * (1.0f / 512.0f) + 1e-6f);
#pragma unroll
                for (int bj = 0; bj < 2; ++bj) { acc[ai][bj][m][0] *= rs; acc[ai][bj][m][1] *= rs; }
                float s = red_fq(sq4(acc[ai][0][m][0]) + sq4(acc[ai][0][m][1]));
                if (fq == 0) TABL[(lrow0 + ai * 128 + m * 16) * 4 + wc] = s; asm volatile("" ::: "memory"); }
        EPI_BAR();
        const f32x4 g0 = *(const f32x4*)(gk + 32 * wc + 8 * fq), g1 = *(const f32x4*)(gk + 32 * wc + 8 * fq + 4);
        const int i4 = (wc * 4 + fq) * 4;
#pragma unroll
        for (int ai = 0; ai < 2; ++ai)
#pragma unroll
            for (int m = 0; m < 4; ++m) { const int lrow = lrow0 + ai * 128 + m * 16, row = u.pm * 256 + lrow;
                const f32x4 t = *(const LAS f32x4*)&TABL[lrow * 4];
                const float rk = __builtin_amdgcn_rsqf((((t[0] + t[1]) + (t[2] + t[3])) + ss_kr[row]) * (1.0f / 192.0f) + 1e-6f);
                bf16_t* kp = KB + (size_t)row * 1152 + h * 192;
                *(u32x4*)(kp + 32 * wc + 8 * fq) = pack8(acc[ai][0][m][0] * rk * g0, acc[ai][0][m][1] * rk * g1);
                *(u32x4*)(VB + (size_t)row * 768 + h * 128 + 32 * wc + 8 * fq) = pack8(acc[ai][1][m][0], acc[ai][1][m][1]);
                const u32x2 rr = *(const u32x2*)(PROJ + (size_t)row * NP + C_KR + i4);
                u32x2 o; o.x = cvt_pk_bf16(bflo(rr.x) * rk, bfhi(rr.x) * rk); o.y = cvt_pk_bf16(bflo(rr.y) * rk, bfhi(rr.y) * rk);
                *(u32x2*)(kp + 128 + i4) = o; asm volatile("" ::: "memory"); }
    }
};

struct EpiOut {
    static constexpr bool PERM = false;
    const float* hin; float* hout; bf16_t* hbA; float* ss_h2;
    __device__ __forceinline__ void operator()(AccT& acc, const Unit& u, int wr, int wc, int fr, int fq) const {
        asm volatile("" : "+v"(fr), "+v"(fq));
        const int row0 = u.pm * 256 + wr * 64 + fr, col0 = u.pn * 256 + wc * 32 + 4 * fq;
#pragma unroll
        for (int ai = 0; ai < 2; ++ai)
#pragma unroll
            for (int m = 0; m < 4; ++m) { const int row = row0 + ai * 128 + m * 16; const size_t off = (size_t)row * DM + col0; float s = 0.f;
#pragma unroll
                for (int bj = 0; bj < 2; ++bj)
#pragma unroll
                    for (int n = 0; n < 2; ++n) { const f32x4 hv = *(const f32x4*)(hin + off + bj * 128 + n * 16); const f32x4 o = hv + acc[ai][bj][m][n];
                        *(f32x4*)(hout + off + bj * 128 + n * 16) = o; u32x2 w; w.x = cvt_pk_bf16(o[0], o[1]); w.y = cvt_pk_bf16(o[2], o[3]);
                        *(u32x2*)(hbA + off + bj * 128 + n * 16) = w; s += sq4(o); }
                s = red_fq(s); if (fq == 0) unsafeAtomicAdd(ss_h2 + row, s); asm volatile("" ::: "memory"); }
    }
};
struct EpiPP {
    static constexpr bool PERM = true;
    bf16_t* PROJ; float* ss_pp;
    __device__ __forceinline__ void operator()(AccT& acc, const Unit& u, int wr, int wc, int fr, int fq) const {
        asm volatile("" : "+v"(fr), "+v"(fq));
        const int row0 = u.pm * 256 + wr * 64 + fr;
#pragma unroll
        for (int ai = 0; ai < 2; ++ai)
#pragma unroll
            for (int m = 0; m < 4; ++m) { const int row = row0 + ai * 128 + m * 16; bf16_t* rowp = PROJ + (size_t)row * NP + u.pn * 256 + wc * 32 + 8 * fq; float s = 0.f;
#pragma unroll
                for (int bj = 0; bj < 2; ++bj) { *(u32x4*)(rowp + bj * 128) = pack8(acc[ai][bj][m][0], acc[ai][bj][m][1]); s += sq4(acc[ai][bj][m][0]) + sq4(acc[ai][bj][m][1]); }
                s = red_fq(s); if (fq == 0) unsafeAtomicAdd(ss_pp + row, s); asm volatile("" ::: "memory"); }
    }
};
struct EpiGate {
    static constexpr bool PERM = false;
    float* h; bf16_t* hbB; const bf16_t* PROJ; const float *ss_h2, *ss_pp, *g_post; float* ss_next;
    __device__ __forceinline__ void operator()(AccT& acc, const Unit& u, int wr, int wc, int fr, int fq) const {
        asm volatile("" : "+v"(fr), "+v"(fq));
        const int row0 = u.pm * 256 + wr * 64 + fr, col0 = u.pn * 256 + wc * 32 + 4 * fq;
#pragma unroll
        for (int ai = 0; ai < 2; ++ai)
#pragma unroll
            for (int m = 0; m < 4; ++m) { const int row = row0 + ai * 128 + m * 16; const size_t off = (size_t)row * DM + col0;
                const float rs2 = __builtin_amdgcn_rsqf(ss_h2[row] * (1.0f / 2048.0f) + 1e-6f), rpp = __builtin_amdgcn_rsqf(ss_pp[row] * (1.0f / 2048.0f) + 1e-6f); float s = 0.f;
#pragma unroll
                for (int bj = 0; bj < 2; ++bj)
#pragma unroll
                    for (int n = 0; n < 2; ++n) { const int c = col0 + bj * 128 + n * 16; const f32x4 hv = *(const f32x4*)(h + off + bj * 128 + n * 16);
                        const f32x4 gp = *(const f32x4*)(g_post + c); const u32x2 pw = *(const u32x2*)(PROJ + (size_t)row * NP + c);
                        const f32x4 pp = {bflo(pw.x), bfhi(pw.x), bflo(pw.y), bfhi(pw.y)}; f32x4 o;
#pragma unroll
                        for (int j = 0; j < 4; ++j) { const float gate = __builtin_amdgcn_rcpf(1.0f + __expf(-rs2 * acc[ai][bj][m][n][j])); o[j] = hv[j] + gate * (pp[j] * rpp * gp[j]); }
                        *(f32x4*)(h + off + bj * 128 + n * 16) = o; u32x2 w; w.x = cvt_pk_bf16(o[0], o[1]); w.y = cvt_pk_bf16(o[2], o[3]);
                        *(u32x2*)(hbB + off + bj * 128 + n * 16) = w; s += sq4(o); }
                if (ss_next) { s = red_fq(s); if (fq == 0) unsafeAtomicAdd(ss_next + row, s); } asm volatile("" ::: "memory"); }
    }
};

template <int MODE> __device__ __forceinline__ int srccol(int n) {
    if (MODE == 0) return n;
    if (MODE == 1) {
        if (n < 768) return O_AQ + n;
        if (n < 1024) return O_AK + (n - 768);
        if (n < 1280) return O_AV + (n - 1024);
        if (n < 1792) return O_BCQ + (n - 1280);
        if (n < 2304) return O_BCKV + (n - 1792);
        if (n < 2816) return O_CQ + (n - 2304);
        if (n < 3328) return O_CK + (n - 2816);
        if (n < 3840) return O_CV + (n - 3328);
        if (n < 4608) return O_AZ + (n - 3840);
        if (n < 5376) return O_BZ + (n - 4608);
        if (n < 5888) return O_CZ + (n - 5376);
        if (n < 5952) { const int i = n - 5888, g = i >> 3, e = i & 7; return O_BKR + (e < 4 ? 4 * g + e : 32 + 4 * g + (e - 4)); }
        return -1;
    }
    const int hh = n >> 8, c = n & 255;
    if (c < 128) return hh * 192 + c;
    if (c < 192) { const int i = c - 128, g = i >> 3, e = i & 7; return hh * 192 + 128 + (e < 4 ? 4 * g + e : 32 + 4 * g + (e - 4)); }
    return -1;
}
template <int MODE> __device__ void cvt_weight(const float* src, int ldsrc, int K, int Nout, const float* gain, bf16_t* dst, float* tile) {
    const int ntn = Nout / 64, ntk = K / 64;
    for (int t = blockIdx.x; t < ntn * ntk; t += gridDim.x) {
        const int tn = t / ntk, tk = t % ntk, n0 = tn * 64, k0 = tk * 64;
#pragma unroll
        for (int i = 0; i < 8; ++i) { const int idx = threadIdx.x + i * 512, kk = idx >> 6, nn = idx & 63; const int sc = srccol<MODE>(n0 + nn);
            float v = sc >= 0 ? src[(size_t)(k0 + kk) * ldsrc + sc] : 0.f; if (gain) v *= gain[k0 + kk]; tile[kk * 65 + nn] = v; }
        __syncthreads();
#pragma unroll
        for (int i = 0; i < 4; ++i) { const int idx = threadIdx.x + i * 512, nn = idx >> 5, kp = (idx & 31) * 2;
            *(unsigned*)(dst + (size_t)(n0 + nn) * K + k0 + kp) = cvt_pk_bf16(tile[kp * 65 + nn], tile[(kp + 1) * 65 + nn]); }
        __syncthreads();
    }
}

template <int MODE, int DQK>
__device__ void attn_naive_unit(const bf16_t* Qh, int ldq, const bf16_t* Kh, int ldk, const bf16_t* Vh, int ldv, bf16_t* Yh, int ldy, int t0, int h, const float* extra, float* lds) {
    float* Qs = lds;
    float* Ks = Qs + 128 * 65;
    float* Vs = Ks + 32 * 65;
    float* Ps = Vs + 32 * 128;
    int tid = threadIdx.x; asm volatile("" : "+v"(tid));
    const int tx = tid & 15, ty = tid >> 4;
    const int pos0 = t0 & (SEQ - 1), sb = t0 - pos0;
    float slope = 0.f;
    if (MODE == 0) slope = exp2f(-8.0f * (float)(h + 1) / 6.0f) * LOG2E;
    int klo, khi;
    if (MODE == 0) { klo = max(0, pos0 - 128); khi = min(SEQ, pos0 + 256); }
    else if (MODE == 1) { klo = 0; khi = SEQ; }
    else { const int r0 = pos0 >> 6; klo = min(max(r0 - 4, 0), 24) * 64; khi = (min(max(r0 + 1 - 4, 0), 24) + 8) * 64; }
    float m[4], l[4], O[4][8];
#pragma unroll
    for (int i = 0; i < 4; i++) { m[i] = -1e30f; l[i] = 0.f;
#pragma unroll
        for (int c = 0; c < 8; c++) O[i][c] = 0.f; }
    for (int kb = klo; kb < khi; kb += 32) {
        float S[4][2];
#pragma unroll
        for (int i = 0; i < 4; i++) { S[i][0] = 0.f; S[i][1] = 0.f; }
        for (int dc = 0; dc < DQK; dc += 64) {
            for (int i = tid; i < 128 * 64; i += 512) { const int r = i >> 6, d = i & 63; Qs[r * 65 + d] = bf2f(Qh[(size_t)(t0 + r) * ldq + dc + d]); }
            for (int i = tid; i < 32 * 64; i += 512) { const int r = i >> 6, d = i & 63; Ks[r * 65 + d] = bf2f(Kh[(size_t)(sb + kb + r) * ldk + dc + d]); }
            __syncthreads();
            for (int d = 0; d < 64; d++) {
                const float k0 = Ks[(tx * 2) * 65 + d], k1 = Ks[(tx * 2 + 1) * 65 + d];
#pragma unroll
                for (int i = 0; i < 4; i++) { const float q = Qs[(ty * 4 + i) * 65 + d]; S[i][0] += q * k0; S[i][1] += q * k1; }
            }
            __syncthreads();
        }
        for (int i = tid; i < 32 * 128; i += 512) { const int r = i >> 7, c = i & 127; Vs[r * 128 + c] = bf2f(Vh[(size_t)(sb + kb + r) * ldv + c]); }
#pragma unroll
        for (int i = 0; i < 4; i++) {
            const int qi = ty * 4 + i, qpos = pos0 + qi;
#pragma unroll
            for (int j = 0; j < 2; j++) {
                const int kpos = kb + tx * 2 + j;
                float s = S[i][j]; bool valid = true;
                if (MODE == 0) { const int dl = abs(kpos - qpos); valid = dl <= 128; s -= slope * (float)dl; }
                if (MODE == 2) {
                    const int c = qpos & 63, r = qpos >> 6, kc = kpos & 63, kr = kpos >> 6;
                    const int rs = min(max(r - 4, 0), 24), cs = min(max(c - 8, 0), 48);
                    valid = (kr >= rs) && (kr < rs + 8) && (kc >= cs) && (kc < cs + 16);
                    const int dcl = min(max(kc - c + 15, 0), 30), drl = min(max(kr - r + 7, 0), 14);
                    s += extra[h * 15 * 31 + drl * 31 + dcl] * LOG2E;
                }
                S[i][j] = valid ? s : -1e30f;
            }
            float mx = fmaxf(S[i][0], S[i][1]);
            mx = fmaxf(mx, __shfl_xor(mx, 1)); mx = fmaxf(mx, __shfl_xor(mx, 2)); mx = fmaxf(mx, __shfl_xor(mx, 4)); mx = fmaxf(mx, __shfl_xor(mx, 8));
            const float mn = fmaxf(m[i], mx), alpha = exp2f(m[i] - mn);
            const float p0 = (S[i][0] > -1e29f) ? exp2f(S[i][0] - mn) : 0.f, p1 = (S[i][1] > -1e29f) ? exp2f(S[i][1] - mn) : 0.f;
            float rsum = p0 + p1;
            rsum += __shfl_xor(rsum, 1); rsum += __shfl_xor(rsum, 2); rsum += __shfl_xor(rsum, 4); rsum += __shfl_xor(rsum, 8);
            l[i] = l[i] * alpha + rsum; m[i] = mn;
#pragma unroll
            for (int c = 0; c < 8; c++) O[i][c] *= alpha;
            Ps[qi * 33 + tx * 2] = p0; Ps[qi * 33 + tx * 2 + 1] = p1;
        }
        __syncthreads();
        for (int k = 0; k < 32; k++) {
            const f32x4 va = *(const f32x4*)&Vs[k * 128 + tx * 8], vb = *(const f32x4*)&Vs[k * 128 + tx * 8 + 4];
#pragma unroll
            for (int i = 0; i < 4; i++) { const float p = Ps[(ty * 4 + i) * 33 + k];
#pragma unroll
                for (int c = 0; c < 4; c++) { O[i][c] += p * va[c]; O[i][4 + c] += p * vb[c]; } }
        }
        __syncthreads();
    }
#pragma unroll
    for (int i = 0; i < 4; i++) {
        const int qi = ty * 4 + i; float f;
        if (MODE == 0) { const float sk = extra[h] * LOG2E, mf = fmaxf(m[i], sk), a = exp2f(m[i] - mf); f = a / (l[i] * a + exp2f(sk - mf)); }
        else f = 1.0f / l[i];
        bf16_t* y = Yh + (size_t)(t0 + qi) * ldy + tx * 8;
        const u32x4 sg = *(const u32x4*)y; u32x4 o;
        o.x = cvt_pk_bf16(O[i][0] * f * bflo(sg.x), O[i][1] * f * bfhi(sg.x)); o.y = cvt_pk_bf16(O[i][2] * f * bflo(sg.y), O[i][3] * f * bfhi(sg.y));
        o.z = cvt_pk_bf16(O[i][4] * f * bflo(sg.z), O[i][5] * f * bfhi(sg.z)); o.w = cvt_pk_bf16(O[i][6] * f * bflo(sg.w), O[i][7] * f * bfhi(sg.w));
        *(u32x4*)y = o;
    }
}

__global__ __launch_bounds__(512, 2) void hymba_fwd(Params p) {
    extern __shared__ __attribute__((aligned(16))) unsigned char shm[];
    cg::grid_group grid = cg::this_grid();
    LAS unsigned char* lds = (LAS unsigned char*)shm;
    LAS float* TABL = (LAS float*)(lds + LDS_STAGE);
    float* ldsf = (float*)shm;
    unsigned char* ws = p.ws;
    bf16_t* HBB = (bf16_t*)(ws + OFF_HBB); bf16_t* PB = (bf16_t*)(ws + OFF_PB); bf16_t* PROJ = (bf16_t*)(ws + OFF_PROJ);
    bf16_t* QB = (bf16_t*)(ws + OFF_QB); bf16_t* KB = (bf16_t*)(ws + OFF_KB); bf16_t* VB = (bf16_t*)(ws + OFF_VB); bf16_t* HBA = QB;
    float* SS = (float*)(ws + OFF_SS); float2* tab = (float2*)(ws + OFF_TAB); float* GT = (float*)(ws + OFF_GT);
#define SSP(kind, l) (SS + ((size_t)(kind) * 4 + (l)) * TTOT)
    const int tid = threadIdx.x, gthreads = gridDim.x * 512, gtid = blockIdx.x * 512 + tid;

    for (int l = 0; l < 4; ++l) {
        cvt_weight<1>(p.w_in + (size_t)l * DM * INW, INW, DM, NP, p.norm_in + l * DM, (bf16_t*)(ws + OFF_WIN + l * SZ_WIN), ldsf);
        cvt_weight<2>(p.b_w_uq + (size_t)l * 512 * 1152, 1152, 512, 1536, p.b_cq_norm + l * 512, (bf16_t*)(ws + OFF_WUQ + l * SZ_WU), ldsf);
        cvt_weight<0>(p.b_w_ukv + (size_t)l * 512 * 1536, 1536, 512, 1536, p.b_ckv_norm + l * 512, (bf16_t*)(ws + OFF_WUKV + l * SZ_WU), ldsf);
        cvt_weight<0>(p.w_out + (size_t)l * DM * DM, DM, DM, DM, nullptr, (bf16_t*)(ws + OFF_WOUT + l * SZ_WSQ), ldsf);
        cvt_weight<0>(p.w_gate + (size_t)l * DM * DM, DM, DM, DM, p.ple_norm + l * DM, (bf16_t*)(ws + OFF_WGATE + l * SZ_WSQ), ldsf);
        cvt_weight<0>(p.w_proj + (size_t)l * 256 * DM, DM, 256, DM, nullptr, (bf16_t*)(ws + OFF_WPROJ + l * SZ_WPROJ), ldsf);
    }
    for (int i = gtid; i < 5 * 4 * TTOT; i += gthreads) { const int kind = 1 + i / (4 * TTOT), rem = i % (4 * TTOT); SS[(size_t)kind * 4 * TTOT + rem] = 0.f; }
    for (int i = gtid; i < 3 * TTOT; i += gthreads) SS[TTOT + i] = 0.f;
    if (gtid < 2048) { const int l = gtid >> 9, w = (gtid >> 7) & 3, d = gtid & 127; float v;
        if (w == 0) v = p.a_q_norm[l * 128 + d]; else if (w == 1) v = p.a_k_norm[l * 128 + d]; else if (w == 2) v = p.c_q_norm[l * 128 + d]; else v = p.c_k_norm[l * 128 + d];
        GT[gtid] = v; }
    for (int i = gtid; i < SEQ * 32; i += gthreads) { const int pos = i >> 5, j = i & 31; const double ang = (double)pos * pow(10000.0, -(double)j / 32.0); tab[i] = make_float2((float)cos(ang), (float)sin(ang)); }
    {
        const int gw = gtid >> 6, nw = gthreads >> 6, lane = tid & 63;
        for (int row = gw; row < TTOT; row += nw) {
            const float* src = row < 8192 ? p.x_prompt + (size_t)row * DM : p.x_sample + (size_t)(row - 8192) * DM; float s = 0.f;
#pragma unroll
            for (int i = 0; i < 4; ++i) { const int c = (i * 64 + lane) * 8; const f32x4 a = *(const f32x4*)(src + c), b = *(const f32x4*)(src + c + 4);
                s += sq4(a) + sq4(b); *(u32x4*)(HBB + (size_t)row * DM + c) = pack8(a, b); }
            s = wave_sum(s); if (lane == 0) SSP(0, 0)[row] = s;
        }
        for (size_t i = gtid; i < (size_t)4 * TTOT * 256 / 8; i += gthreads) { const size_t e = i * 8; const int l = (int)(e / ((size_t)TTOT * 256)); const size_t r = e % ((size_t)TTOT * 256);
            const int t = (int)(r >> 8), c = (int)(r & 255);
            const float* src = t < 8192 ? p.p_prompt + ((size_t)l * 8192 + t) * 256 + c : p.p_sample + ((size_t)l * 32768 + (t - 8192)) * 256 + c;
            *(u32x4*)(PB + e) = pack8(*(const f32x4*)src, *(const f32x4*)(src + 4)); }
    }
    grid.sync();

    for (int l = 0; l < 4; ++l) {
        for (int ch = 0; ch < 2; ++ch) {
            const int r0 = ch ? 8192 : 0, TC = ch ? 32768 : 8192;
            pg8::StaticOrder S;
            {
                pg8::Gemm g{HBB + (size_t)r0 * DM, (const bf16_t*)(ws + OFF_WIN + l * SZ_WIN), DM, TC, NP, DM};
                EpiProj E{PROJ, SSP(0, l) + r0, SSP(3, l) + r0, SSP(5, l) + r0, GT + l * 512, p.b_k_norm + l * 192 + 128, tab, TABL};
                S.init(TC, NP, gridDim.x, blockIdx.x); pg8::gemm_phase(lds, g, S, E);
            }
            grid.sync();
            {
                pg8::Gemm g{PROJ + C_BCQ, (const bf16_t*)(ws + OFF_WUQ + l * SZ_WU), NP, TC, 1536, 512};
                EpiUQ E{QB, SSP(3, l) + r0, p.b_q_norm + l * 192, tab, TABL};
                S.init(TC, 1536, gridDim.x, blockIdx.x); pg8::gemm_phase(lds, g, S, E);
            }
            {
                pg8::Gemm g{PROJ + C_BCKV, (const bf16_t*)(ws + OFF_WUKV + l * SZ_WU), NP, TC, 1536, 512};
                EpiUKV E{KB, VB, PROJ, SSP(4, l) + r0, SSP(5, l) + r0, p.b_k_norm + l * 192, TABL};
                S.init(TC, 1536, gridDim.x, blockIdx.x); pg8::gemm_phase(lds, g, S, E);
            }
            grid.sync();
            {
                const int nqt = TC / 128, nB = nqt * 6, nA = nqt * 6, nC = nqt * 4;
                for (int uI = blockIdx.x; uI < nB + nA + nC; uI += gridDim.x) {
                    if (uI < nB) { const int h = uI % 6, t0 = (uI / 6) * 128;
                        attn_naive_unit<1, 192>(QB + h * 192, 1152, KB + h * 192, 1152, VB + h * 128, 768, PROJ + C_Z + 768 + h * 128, NP, t0, h, nullptr, ldsf); }
                    else if (uI < nB + nA) { const int v = uI - nB, h = v % 6, t0 = (v / 6) * 128;
                        attn_naive_unit<0, 128>(PROJ + C_AQ + h * 128, NP, PROJ + C_AK + (h / 3) * 128, NP, PROJ + C_AV + (h / 3) * 128, NP, PROJ + C_Z + h * 128, NP, t0, h, p.a_sink + l * 6, ldsf); }
                    else { const int v = uI - nB - nA, h = v % 4, t0 = (v / 4) * 128;
                        attn_naive_unit<2, 128>(PROJ + C_CQ + h * 128, NP, PROJ + C_CK + h * 128, NP, PROJ + C_CV + h * 128, NP, PROJ + C_Z + 1536 + h * 128, NP, t0, h, p.c_rpb + (size_t)l * 4 * 15 * 31, ldsf); }
                }
            }
            grid.sync();
            {
                const float* hin = (l == 0) ? (ch ? p.x_sample : p.x_prompt) : p.h + (size_t)r0 * DM;
                pg8::Gemm g{PROJ + C_Z, (const bf16_t*)(ws + OFF_WOUT + l * SZ_WSQ), NP, TC, DM, DM};
                EpiOut E{hin, p.h + (size_t)r0 * DM, HBA, SSP(1, l) + r0};
                S.init(TC, DM, gridDim.x, blockIdx.x); pg8::gemm_phase(lds, g, S, E);
            }
            {
                pg8::Gemm g{PB + ((size_t)l * TTOT + r0) * 256, (const bf16_t*)(ws + OFF_WPROJ + l * SZ_WPROJ), 256, TC, DM, 256};
                EpiPP E{PROJ, SSP(2, l) + r0};
                S.init(TC, DM, gridDim.x, blockIdx.x); pg8::gemm_phase(lds, g, S, E);
            }
            grid.sync();
            {
                pg8::Gemm g{HBA, (const bf16_t*)(ws + OFF_WGATE + l * SZ_WSQ), DM, TC, DM, DM};
                EpiGate E{p.h + (size_t)r0 * DM, HBB + (size_t)r0 * DM, PROJ, SSP(1, l) + r0, SSP(2, l) + r0, p.post_norm + l * DM, (l < 3) ? SSP(0, l + 1) + r0 : nullptr};
                S.init(TC, DM, gridDim.x, blockIdx.x); pg8::gemm_phase(lds, g, S, E);
            }
            grid.sync();
        }
    }
}

extern "C" void kernel_launch(void* const* d_in, const int* in_sizes, int n_in, void* d_out, int out_size, void* d_ws, size_t ws_size, hipStream_t stream) {
    static int grid_blocks = 0;
    if (grid_blocks == 0) {
        if (n_in != 23 || ws_size < WS_END) { fprintf(stderr, "kernel_launch: need 23 inputs and %zu bytes of workspace (got %d, %zu)\n", (size_t)WS_END, n_in, ws_size); grid_blocks = -1; return; }
        int dev = 0, cus = 0, per_cu = 0;
        if (hipGetDevice(&dev) != hipSuccess || hipDeviceGetAttribute(&cus, hipDeviceAttributeMultiprocessorCount, dev) != hipSuccess) { grid_blocks = -1; return; }
        if (hipFuncSetAttribute((const void*)hymba_fwd, hipFuncAttributeMaxDynamicSharedMemorySize, LDS_BYTES) != hipSuccess) { fprintf(stderr, "kernel_launch: hipFuncSetAttribute failed\n"); grid_blocks = -1; return; }
        if (hipOccupancyMaxActiveBlocksPerMultiprocessor(&per_cu, (const void*)hymba_fwd, 512, LDS_BYTES) != hipSuccess || per_cu < 1) { fprintf(stderr, "kernel_launch: occupancy query failed (%d)\n", per_cu); (void)hipGetLastError(); per_cu = 1; }
        grid_blocks = cus * per_cu;
    }
    if (grid_blocks < 0) return;
    Params p{};
    const float** pf = (const float**)&p;
    for (int i = 0; i < 23; ++i) pf[i] = (const float*)d_in[i];
    p.h = (float*)d_out; p.ws = (unsigned char*)d_ws;
    void* args[] = {&p};
    hipError_t e = hipLaunchCooperativeKernel((const void*)hymba_fwd, dim3(grid_blocks), dim3(512), args, LDS_BYTES, stream);
    if (e != hipSuccess) fprintf(stderr, "cooperative launch failed: %s (grid %d)\n", hipGetErrorString(e), grid_blocks);
}
```

```cpp
#include <hip/hip_runtime.h>
#include <hip/hip_cooperative_groups.h>
#include <cstdio>
#include <math.h>
namespace cg = cooperative_groups;

#define LAS __attribute__((address_space(3)))
typedef unsigned short bf16_t;
typedef short bf16x8 __attribute__((ext_vector_type(8)));
typedef float f32x4 __attribute__((ext_vector_type(4)));
typedef unsigned u32x4 __attribute__((ext_vector_type(4)));
typedef unsigned u32x2 __attribute__((ext_vector_type(2)));

constexpr int SEQ = 2048, DM = 2048, INW = 5952, TTOT = 40960, NP = 6144;
constexpr int O_AQ = 0, O_AK = 768, O_AV = 1024, O_AZ = 1280, O_BCQ = 2048, O_BCKV = 2560, O_BKR = 3072, O_BZ = 3136, O_CQ = 3904, O_CK = 4416, O_CV = 4928, O_CZ = 5440;
constexpr int C_AQ = 0, C_AK = 768, C_AV = 1024, C_BCQ = 1280, C_BCKV = 1792, C_CQ = 2304, C_CK = 2816, C_CV = 3328, C_Z = 3840, C_KR = 5888;
constexpr float LOG2E = 1.4426950408889634f;
constexpr float QS_A = 0.08838834764831845f * LOG2E;
constexpr float QS_B = 0.07216878364870323f * LOG2E;
constexpr size_t SZ_WIN = (size_t)NP * 2048 * 2, SZ_WU = (size_t)1536 * 512 * 2, SZ_WSQ = (size_t)2048 * 2048 * 2, SZ_WPROJ = (size_t)2048 * 256 * 2;
constexpr size_t OFF_WIN = 0, OFF_WUQ = OFF_WIN + 4 * SZ_WIN, OFF_WUKV = OFF_WUQ + 4 * SZ_WU, OFF_WOUT = OFF_WUKV + 4 * SZ_WU, OFF_WGATE = OFF_WOUT + 4 * SZ_WSQ,
                 OFF_WPROJ = OFF_WGATE + 4 * SZ_WSQ, OFF_HBB = OFF_WPROJ + 4 * SZ_WPROJ, OFF_PB = OFF_HBB + (size_t)TTOT * DM * 2,
                 OFF_PROJ = OFF_PB + (size_t)4 * TTOT * 256 * 2, OFF_QB = OFF_PROJ + (size_t)32768 * NP * 2, OFF_KB = OFF_QB + (size_t)32768 * 1152 * 2,
                 OFF_VB = OFF_KB + (size_t)32768 * 1152 * 2, OFF_SS = OFF_VB + (size_t)32768 * 768 * 2, OFF_TAB = OFF_SS + (size_t)6 * 4 * TTOT * 4,
                 OFF_GT = OFF_TAB + (size_t)SEQ * 32 * 8, OFF_CTR = OFF_GT + 4 * 4 * 128 * 4, WS_END = OFF_CTR + 256;
constexpr int LDS_STAGE = 131072, LDS_BYTES = LDS_STAGE + 8192;

struct Params {
    const float *x_prompt, *x_sample, *p_prompt, *p_sample, *norm_in, *w_in, *a_q_norm, *a_k_norm, *a_sink, *b_cq_norm, *b_ckv_norm, *b_w_uq, *b_w_ukv,
        *b_q_norm, *b_k_norm, *c_q_norm, *c_k_norm, *c_rpb, *w_out, *ple_norm, *w_gate, *w_proj, *post_norm;
    float* h;
    unsigned char* ws;
};

__device__ __forceinline__ unsigned cvt_pk_bf16(float lo, float hi) { unsigned r; asm volatile("v_cvt_pk_bf16_f32 %0, %1, %2" : "=v"(r) : "v"(lo), "v"(hi)); return r; }
__device__ __forceinline__ float bf2f(unsigned short b) { return __uint_as_float(((unsigned)b) << 16); }
__device__ __forceinline__ float bflo(unsigned w) { return __uint_as_float(w << 16); }
__device__ __forceinline__ float bfhi(unsigned w) { return __uint_as_float(w & 0xffff0000u); }
__device__ __forceinline__ float wave_sum(float v) {
#pragma unroll
    for (int o = 32; o >= 1; o >>= 1) v += __shfl_xor(v, o);
    return v;
}

namespace pg8 {
constexpr int BM = 256, BK = 64, HALF = 128, HTB = HALF * BK * 2, STAGE_BYTES = 8 * HTB, NXCD = 8, WGM = 8;
__device__ __forceinline__ int lds_byte(int r, int c) { const int st = (r >> 4) * 2 + (c >> 5), rr = r & 15, cc = c & 31, ob = rr * 64 + cc * 2; return st * 1024 + (ob ^ (((ob >> 9) & 1) << 5)); }
__device__ __forceinline__ void stage_rc(int b, int& R, int& C) { const int st = b / 1024, sb = b % 1024, swz = sb ^ (((sb >> 9) & 1) << 5); R = (st >> 1) * 16 + swz / 64; C = (st & 1) * 32 + (swz % 64) / 2; }
__device__ __forceinline__ int perm32(int rho) { const int n = rho >> 4, i = rho & 15; return 8 * (i >> 2) + 4 * n + (i & 3); }
struct Unit { int pm, pn; };
struct Gemm { const bf16_t* A; const bf16_t* Bt; int lda, M, N, K; };
struct StaticOrder {
    int nM, nN, nwg, G, c;
    __device__ void init(int M, int N, int G_, int c_) { nM = M / BM; nN = N / BM; nwg = nM * nN; G = G_; c = c_; }
    __device__ bool next(int i, Unit& u) const {
        const long L = (long)i * G + c; if (L >= nwg) return false;
        int wgid = (int)L; { const int q = nwg / NXCD, r = nwg % NXCD, xcd = wgid % NXCD, off = wgid / NXCD; wgid = (xcd < r ? xcd * (q + 1) : r * (q + 1) + (xcd - r) * q) + off; }
        const int nig = WGM * nN, gid = wgid / nig, fm = gid * WGM, gsz = (nM - fm) < WGM ? (nM - fm) : WGM;
        u.pm = fm + ((wgid % nig) % gsz); u.pn = (wgid % nig) / gsz; return true;
    }
};

template <class Epi>
__device__ __forceinline__ void gemm_phase(LAS unsigned char* lds, const Gemm g, const StaticOrder& S, const Epi& E) {
    int tid = threadIdx.x; asm volatile("" : "+v"(tid));
    const int wid = __builtin_amdgcn_readfirstlane(tid >> 6), lane = tid & 63, wr = wid >> 2, wc = wid & 3, fr = lane & 15, fq = lane >> 4;
    const int K = g.K, nt = K / BK;
    unsigned voffA[2], voffB[2];
#pragma unroll
    for (int i = 0; i < 2; ++i) { int R, C; stage_rc(tid * 16 + i * 8192, R, C); const int Rb = Epi::PERM ? ((R & ~31) + perm32(R & 31)) : R;
        voffA[i] = (unsigned)(R * g.lda + C) * 2u; voffB[i] = (unsigned)(Rb * K + C) * 2u; }
    const size_t kstep = (size_t)(BK * 2);
    const size_t hstepA = (size_t)HALF * g.lda * 2, hstepB = (size_t)HALF * K * 2;
    const size_t tstepA = 2 * hstepA, tstepB = 2 * hstepB;
    const unsigned ldsw = (unsigned)wid * 1024u;
    const int aoff = lds_byte(wr * 64 + fr, fq * 8), boff = lds_byte(wc * 32 + fr, fq * 8);
#define PG8_SA(b, h) (((b) * 2 + (h)) * HTB)
#define PG8_SB(b, h) ((4 + (b) * 2 + (h)) * HTB)
#define PG8_STAGE(bufoff, gbase, voff) do { _Pragma("unroll") for (int _i = 0; _i < 2; ++_i) \
        __builtin_amdgcn_global_load_lds((const unsigned*)((const char*)(gbase) + (voff)[_i]), (LAS unsigned*)(lds + (bufoff) + ldsw + _i * 8192), 16, 0, 0); } while (0)
#define PG8_LDA(dst, b, h) do { _Pragma("unroll") for (int m = 0; m < 4; ++m) _Pragma("unroll") for (int k = 0; k < 2; ++k) dst[m][k] = *(const LAS bf16x8*)(lds + PG8_SA(b, h) + aoff + m * 2048 + k * 1024); } while (0)
#define PG8_LDB(dst, b, h) do { _Pragma("unroll") for (int n = 0; n < 2; ++n) _Pragma("unroll") for (int k = 0; k < 2; ++k) dst[n][k] = *(const LAS bf16x8*)(lds + PG8_SB(b, h) + boff + n * 2048 + k * 1024); } while (0)
#define PG8_MMA(ai, bj, At, Bt) do { __builtin_amdgcn_s_setprio(1); _Pragma("unroll") for (int m = 0; m < 4; ++m) _Pragma("unroll") for (int n = 0; n < 2; ++n) _Pragma("unroll") for (int k = 0; k < 2; ++k) \
        acc[ai][bj][m][n] = __builtin_amdgcn_mfma_f32_16x16x32_bf16(Bt[n][k], At[m][k], acc[ai][bj][m][n], 0, 0, 0); __builtin_amdgcn_s_setprio(0); } while (0)
#define PG8_WAIT_V(n) asm volatile("s_waitcnt vmcnt(" #n ")" ::: "memory")
#define PG8_WAIT_L(n) asm volatile("s_waitcnt lgkmcnt(" #n ")" ::: "memory")
#define PG8_BAR __builtin_amdgcn_s_barrier()
#define PG8_SCHED __builtin_amdgcn_sched_barrier(0)
    Unit cur, nxt; int ui = 0;
    if (!S.next(0, cur)) return;
    f32x4 acc[2][2][4][2];
#pragma unroll
    for (int a = 0; a < 2; ++a)
#pragma unroll
        for (int b = 0; b < 2; ++b)
#pragma unroll
            for (int m = 0; m < 4; ++m)
#pragma unroll
                for (int n = 0; n < 2; ++n) acc[a][b][m][n] = (f32x4){0.f, 0.f, 0.f, 0.f};
    bf16x8 At[4][2], B0[2][2], B1[2][2];
    const char* cA = (const char*)g.A + (size_t)cur.pm * tstepA; const char* cB = (const char*)g.Bt + (size_t)cur.pn * tstepB;
    PG8_STAGE(PG8_SB(0, 0), cB, voffB); PG8_STAGE(PG8_SA(0, 0), cA, voffA); PG8_STAGE(PG8_SB(0, 1), cB + hstepB, voffB); PG8_STAGE(PG8_SA(0, 1), cA + hstepA, voffA);
    if (wr == 1) PG8_BAR;
    PG8_WAIT_V(4); PG8_BAR;
    PG8_STAGE(PG8_SB(1, 0), cB + kstep, voffB); PG8_STAGE(PG8_SA(1, 0), cA + kstep, voffA); PG8_STAGE(PG8_SB(1, 1), cB + hstepB + kstep, voffB);
    PG8_WAIT_V(6); PG8_BAR;
    for (;;) {
        const bool has_next = S.next(ui + 1, nxt);
        const char* nA = has_next ? (const char*)g.A + (size_t)nxt.pm * tstepA : cA; const char* nB = has_next ? (const char*)g.Bt + (size_t)nxt.pn * tstepB : cB;
        for (int t = 0; t < nt; t += 2) {
            const bool last = (t == nt - 2);
            const char* a1 = cA + (size_t)(t + 1) * kstep;
            const char* a2 = last ? nA : cA + (size_t)(t + 2) * kstep; const char* b2 = last ? nB : cB + (size_t)(t + 2) * kstep;
            const char* a3 = a2 + kstep; const char* b3 = b2 + kstep;
            PG8_LDB(B0, 0, 0); PG8_SCHED; PG8_LDA(At, 0, 0); PG8_STAGE(PG8_SA(1, 1), a1 + hstepA, voffA);
            PG8_WAIT_L(8); PG8_BAR; PG8_WAIT_L(0); PG8_MMA(0, 0, At, B0); PG8_BAR; PG8_SCHED;
            PG8_LDB(B1, 0, 1); PG8_STAGE(PG8_SB(0, 0), b2, voffB);
            PG8_BAR; PG8_WAIT_L(0); PG8_MMA(0, 1, At, B1); PG8_BAR;
            PG8_LDA(At, 0, 1); PG8_STAGE(PG8_SA(0, 0), a2, voffA);
            PG8_BAR; PG8_WAIT_L(0); PG8_MMA(1, 0, At, B0); PG8_BAR; PG8_SCHED;
            PG8_STAGE(PG8_SB(0, 1), b2 + hstepB, voffB);
            PG8_WAIT_V(6); PG8_BAR; PG8_MMA(1, 1, At, B1); PG8_BAR;
            PG8_LDB(B0, 1, 0); PG8_SCHED; PG8_LDA(At, 1, 0); PG8_STAGE(PG8_SA(0, 1), a2 + hstepA, voffA);
            PG8_WAIT_L(8); PG8_BAR; PG8_WAIT_L(0); PG8_MMA(0, 0, At, B0); PG8_BAR; PG8_SCHED;
            PG8_LDB(B1, 1, 1); PG8_STAGE(PG8_SB(1, 0), b3, voffB);
            PG8_BAR; PG8_WAIT_L(0); PG8_MMA(0, 1, At, B1); PG8_BAR;
            PG8_LDA(At, 1, 1); PG8_STAGE(PG8_SA(1, 0), a3, voffA);
            PG8_BAR; PG8_WAIT_L(0); PG8_MMA(1, 0, At, B0); PG8_BAR; PG8_SCHED;
            PG8_STAGE(PG8_SB(1, 1), b3 + hstepB, voffB);
            PG8_WAIT_V(6); PG8_BAR; PG8_MMA(1, 1, At, B1); PG8_BAR;
        }
        E(acc, cur, wr, wc, fr, fq);
        if (!has_next) break;
#pragma unroll
        for (int a = 0; a < 2; ++a)
#pragma unroll
            for (int b = 0; b < 2; ++b)
#pragma unroll
                for (int m = 0; m < 4; ++m)
#pragma unroll
                    for (int n = 0; n < 2; ++n) acc[a][b][m][n] = (f32x4){0.f, 0.f, 0.f, 0.f};
        cur = nxt; cA = nA; cB = nB; ++ui;
    }
    PG8_WAIT_V(0);
    if (wr == 0) PG8_BAR;
    PG8_BAR;
#undef PG8_SA
#undef PG8_SB
#undef PG8_STAGE
#undef PG8_LDA
#undef PG8_LDB
#undef PG8_MMA
#undef PG8_WAIT_V
#undef PG8_WAIT_L
#undef PG8_BAR
#undef PG8_SCHED
}
}
using pg8::Unit;
typedef f32x4 AccT[2][2][4][2];

#define EPI_BAR() do { asm volatile("s_waitcnt lgkmcnt(0)" ::: "memory"); __builtin_amdgcn_s_barrier(); asm volatile("" ::: "memory"); } while (0)
__device__ __forceinline__ float sq4(const f32x4 v) { return (v[0] * v[0] + v[1] * v[1]) + (v[2] * v[2] + v[3] * v[3]); }
__device__ __forceinline__ float red_fq(float s) { s += __shfl_xor(s, 16); s += __shfl_xor(s, 32); return s; }
__device__ __forceinline__ u32x4 pack8(const f32x4 a, const f32x4 b) { u32x4 w; w.x = cvt_pk_bf16(a[0], a[1]); w.y = cvt_pk_bf16(a[2], a[3]); w.z = cvt_pk_bf16(b[0], b[1]); w.w = cvt_pk_bf16(b[2], b[3]); return w; }

struct EpiProj {
    static constexpr bool PERM = true;
    bf16_t* PROJ; const float* ssh; float *ss_cq, *ss_kr;
    const float *gt, *g_kr; const float2* tab; LAS float* TABL;
    __device__ __forceinline__ void operator()(AccT& acc, const Unit& u, int wr, int wc, int fr, int fq) const {
        asm volatile("" : "+v"(fr), "+v"(fq));
        const int lrow0 = wr * 64 + fr, row0 = u.pm * 256 + lrow0, pn = u.pn;
        float rs[2][4];
#pragma unroll
        for (int ai = 0; ai < 2; ++ai)
#pragma unroll
            for (int m = 0; m < 4; ++m) rs[ai][m] = __builtin_amdgcn_rsqf(ssh[row0 + ai * 128 + m * 16] * (1.0f / 2048.0f) + 1e-6f);
        bf16_t* const outp = PROJ + (size_t)row0 * NP + pn * 256 + wc * 32 + 8 * fq;
        const bool is_norm = (pn <= 3) || (pn >= 9 && pn <= 12);
        if (is_norm) {
            const float* g = gt + ((pn <= 2) ? 0 : (pn == 3) ? 128 : (pn <= 10) ? 256 : 384);
            const float qs = (pn <= 2 || pn == 9 || pn == 10) ? QS_A : 1.0f;
#pragma unroll
            for (int ai = 0; ai < 2; ++ai)
#pragma unroll
                for (int m = 0; m < 4; ++m)
#pragma unroll
                    for (int bj = 0; bj < 2; ++bj) { float s = red_fq(sq4(acc[ai][bj][m][0]) + sq4(acc[ai][bj][m][1]));
                        if (fq == 0) TABL[((lrow0 + ai * 128 + m * 16) * 2 + bj) * 4 + wc] = s; asm volatile("" ::: "memory"); }
            EPI_BAR();
            const f32x4 g0 = *(const f32x4*)(g + 32 * wc + 8 * fq) * qs, g1 = *(const f32x4*)(g + 32 * wc + 8 * fq + 4) * qs;
#pragma unroll
            for (int ai = 0; ai < 2; ++ai)
#pragma unroll
                for (int m = 0; m < 4; ++m)
#pragma unroll
                    for (int bj = 0; bj < 2; ++bj) { const f32x4 t = *(const LAS f32x4*)&TABL[((lrow0 + ai * 128 + m * 16) * 2 + bj) * 4];
                        const float r2 = rs[ai][m] * rs[ai][m];
                        const float rn = rs[ai][m] * __builtin_amdgcn_rsqf(((t[0] + t[1]) + (t[2] + t[3])) * r2 * (1.0f / 128.0f) + 1e-6f);
                        *(u32x4*)(outp + (size_t)(ai * 128 + m * 16) * NP + bj * 128) = pack8(acc[ai][bj][m][0] * rn * g0, acc[ai][bj][m][1] * rn * g1);
                        asm volatile("" ::: "memory"); }
        } else if (pn >= 5 && pn <= 8) {
            float* ss = ss_cq + ((pn <= 6) ? 0 : 4 * TTOT);
#pragma unroll
            for (int ai = 0; ai < 2; ++ai)
#pragma unroll
                for (int m = 0; m < 4; ++m) { const float r = rs[ai][m];
                    float s = red_fq((sq4(acc[ai][0][m][0]) + sq4(acc[ai][0][m][1])) + (sq4(acc[ai][1][m][0]) + sq4(acc[ai][1][m][1]))) * (r * r);
                    if (fq == 0) unsafeAtomicAdd(ss + row0 + ai * 128 + m * 16, s);
#pragma unroll
                    for (int bj = 0; bj < 2; ++bj) *(u32x4*)(outp + (size_t)(ai * 128 + m * 16) * NP + bj * 128) = pack8(acc[ai][bj][m][0] * r, acc[ai][bj][m][1] * r);
                    asm volatile("" ::: "memory"); }
        } else if (pn >= 15 && pn <= 22) {
#pragma unroll
            for (int ai = 0; ai < 2; ++ai)
#pragma unroll
                for (int m = 0; m < 4; ++m) { const float r = rs[ai][m];
#pragma unroll
                    for (int bj = 0; bj < 2; ++bj) { f32x4 o0, o1;
#pragma unroll
                        for (int j = 0; j < 4; ++j) { const float v0 = acc[ai][bj][m][0][j] * r, v1 = acc[ai][bj][m][1][j] * r;
                            o0[j] = v0 * __builtin_amdgcn_rcpf(1.0f + __expf(-v0)); o1[j] = v1 * __builtin_amdgcn_rcpf(1.0f + __expf(-v1)); }
                        *(u32x4*)(outp + (size_t)(ai * 128 + m * 16) * NP + bj * 128) = pack8(o0, o1); }
                    asm volatile("" ::: "memory"); }
        } else if (pn == 23) {
            if (wc < 2) {
                const int gI = wc * 4 + fq;
                const f32x4 gk1 = *(const f32x4*)(g_kr + 4 * gI), gk2 = *(const f32x4*)(g_kr + 32 + 4 * gI);
#pragma unroll
                for (int ai = 0; ai < 2; ++ai)
#pragma unroll
                    for (int m = 0; m < 4; ++m) { const int row = row0 + ai * 128 + m * 16; const float r = rs[ai][m];
                        float s = red_fq(sq4(acc[ai][0][m][0]) + sq4(acc[ai][0][m][1])) * (r * r);
                        if (fq == 0) unsafeAtomicAdd(ss_kr + row, s);
                        const f32x4 x1 = acc[ai][0][m][0] * gk1 * r, x2 = acc[ai][0][m][1] * gk2 * r; f32x4 o1, o2;
                        const float2* tp = tab + (row & (SEQ - 1)) * 32 + 4 * gI;
#pragma unroll
                        for (int j = 0; j < 4; ++j) { const float2 cs = tp[j]; o1[j] = x1[j] * cs.x - x2[j] * cs.y; o2[j] = x1[j] * cs.y + x2[j] * cs.x; }
                        *(u32x4*)(PROJ + (size_t)row * NP + C_KR + 8 * gI) = pack8(o1, o2); asm volatile("" ::: "memory"); }
            }
        } else {
#pragma unroll
            for (int ai = 0; ai < 2; ++ai)
#pragma unroll
                for (int m = 0; m < 4; ++m) { const float r = rs[ai][m];
#pragma unroll
                    for (int bj = 0; bj < 2; ++bj) *(u32x4*)(outp + (size_t)(ai * 128 + m * 16) * NP + bj * 128) = pack8(acc[ai][bj][m][0] * r, acc[ai][bj][m][1] * r);
                    asm volatile("" ::: "memory"); }
        }
    }
};

struct EpiUQ {
    static constexpr bool PERM = true;
    bf16_t* QB; const float* ss_cq; const float* gq; const float2* tab; LAS float* TABL;
    __device__ __forceinline__ void operator()(AccT& acc, const Unit& u, int wr, int wc, int fr, int fq) const {
        asm volatile("" : "+v"(fr), "+v"(fq));
        const int lrow0 = wr * 64 + fr, row0 = u.pm * 256 + lrow0, h = u.pn;
#pragma unroll
        for (int ai = 0; ai < 2; ++ai)
#pragma unroll
            for (int m = 0; m < 4; ++m) { const float rs = __builtin_amdgcn_rsqf(ss_cq[row0 + ai * 128 + m * 16] * (1.0f / 512.0f) + 1e-6f);
#pragma unroll
                for (int bj = 0; bj < 2; ++bj) { acc[ai][bj][m][0] *= rs; acc[ai][bj][m][1] *= rs;
                    float s = red_fq(sq4(acc[ai][bj][m][0]) + sq4(acc[ai][bj][m][1]));
                    if (fq == 0) TABL[((lrow0 + ai * 128 + m * 16) * 2 + bj) * 4 + wc] = s; } asm volatile("" ::: "memory"); }
        EPI_BAR();
        const int gI = (wc & 1) * 4 + fq;
        const f32x4 g00 = *(const f32x4*)(gq + 32 * wc + 8 * fq), g01 = *(const f32x4*)(gq + 32 * wc + 8 * fq + 4);
        const f32x4 g10 = *(const f32x4*)(gq + 128 + 4 * gI), g11 = *(const f32x4*)(gq + 160 + 4 * gI);
#pragma unroll
        for (int ai = 0; ai < 2; ++ai)
#pragma unroll
            for (int m = 0; m < 4; ++m) { const int lrow = lrow0 + ai * 128 + m * 16, row = u.pm * 256 + lrow;
                const f32x4 t0 = *(const LAS f32x4*)&TABL[lrow * 8], t1 = *(const LAS f32x4*)&TABL[lrow * 8 + 4];
                const float rq = QS_B * __builtin_amdgcn_rsqf((((t0[0] + t0[1]) + (t0[2] + t0[3])) + ((t1[0] + t1[1]) + (t1[2] + t1[3]))) * (1.0f / 192.0f) + 1e-6f);
                bf16_t* rowp = QB + (size_t)row * 1152 + h * 192 + 32 * wc + 8 * fq;
                *(u32x4*)rowp = pack8(acc[ai][0][m][0] * rq * g00, acc[ai][0][m][1] * rq * g01);
                if (wc < 2) {
                    const f32x4 x1 = acc[ai][1][m][0] * rq * g10, x2 = acc[ai][1][m][1] * rq * g11; f32x4 o1, o2;
                    const float2* tp = tab + (row & (SEQ - 1)) * 32 + 4 * gI;
#pragma unroll
                    for (int j = 0; j < 4; ++j) { const float2 cs = tp[j]; o1[j] = x1[j] * cs.x - x2[j] * cs.y; o2[j] = x1[j] * cs.y + x2[j] * cs.x; }
                    *(u32x4*)(rowp + 128) = pack8(o1, o2);
                } asm volatile("" ::: "memory"); }
    }
};

struct EpiUKV {
    static constexpr bool PERM = true;
    bf16_t *KB, *VB; const bf16_t* PROJ; const float *ss_ckv, *ss_kr; const float* gk; LAS float* TABL;
    __device__ __forceinline__ void operator()(AccT& acc, const Unit& u, int wr, int wc, int fr, int fq) const {
        asm volatile("" : "+v"(fr), "+v"(fq));
        const int lrow0 = wr * 64 + fr, row0 = u.pm * 256 + lrow0, h = u.pn;
#pragma unroll
        for (int ai = 0; ai < 2; ++ai)
#pragma unroll
            for (int m = 0; m < 4; ++m) { const float rs = __builtin_amdgcn_rsqf(ss_ckv[row0 + ai * 128 + m * 16] * (1.0f / 512.0f) + 1e-6f);
#pragma unroll
                for (int bj = 0; bj < 2; ++bj) { acc[ai][bj][m][0] *= rs; acc[ai][bj][m][1] *= rs; }
                float s = red_fq(sq4(acc[ai][0][m][0]) + sq4(acc[ai][0][m][1]));
                if (fq == 0) TABL[(lrow0 + ai * 128 + m * 16) * 4 + wc] = s; asm volatile("" ::: "memory"); }
        EPI_BAR();
        const f32x4 g0 = *(const f32x4*)(gk + 32 * wc + 8 * fq), g1 = *(const f32x4*)(gk + 32 * wc + 8 * fq + 4);
        const int i4 = (wc * 4 + fq) * 4;
#pragma unroll
        for (int ai = 0; ai < 2; ++ai)
#pragma unroll
            for (int m = 0; m < 4; ++m) { const int lrow = lrow0 + ai * 128 + m * 16, row = u.pm * 256 + lrow;
                const f32x4 t = *(const LAS f32x4*)&TABL[lrow * 4];
                const float rk = __builtin_amdgcn_rsqf((((t[0] + t[1]) + (t[2] + t[3])) + ss_kr[row]) * (1.0f / 192.0f) + 1e-6f);
                bf16_t* kp = KB + (size_t)row * 1152 + h * 192;
                *(u32x4*)(kp + 32 * wc + 8 * fq) = pack8(acc[ai][0][m][0] * rk * g0, acc[ai][0][m][1] * rk * g1);
                *(u32x4*)(VB + (size_t)row * 768 + h * 128 + 32 * wc + 8 * fq) = pack8(acc[ai][1][m][0], acc[ai][1][m][1]);
                const u32x2 rr = *(const u32x2*)(PROJ + (size_t)row * NP + C_KR + i4);
                u32x2 o; o.x = cvt_pk_bf16(bflo(rr.x) * rk, bfhi(rr.x) * rk); o.y = cvt_pk_bf16(bflo(rr.y) * rk, bfhi(rr.y) * rk);
                *(u32x2*)(kp + 128 + i4) = o; asm volatile("" ::: "memory"); }
    }
};

struct EpiOut {
    static constexpr bool PERM = false;
    const float* hin; float* hout; bf16_t* hbA; float* ss_h2;
    __device__ __forceinline__ void operator()(AccT& acc, const Unit& u, int wr, int wc, int fr, int fq) const {
        asm volatile("" : "+v"(fr), "+v"(fq));
        const int row0 = u.pm * 256 + wr * 64 + fr, col0 = u.pn * 256 + wc * 32 + 4 * fq;
#pragma unroll
        for (int ai = 0; ai < 2; ++ai)
#pragma unroll
            for (int m = 0; m < 4; ++m) { const int row = row0 + ai * 128 + m * 16; const size_t off = (size_t)row * DM + col0; float s = 0.f;
#pragma unroll
                for (int bj = 0; bj < 2; ++bj)
#pragma unroll
                    for (int n = 0; n < 2; ++n) { const f32x4 hv = *(const f32x4*)(hin + off + bj * 128 + n * 16); const f32x4 o = hv + acc[ai][bj][m][n];
                        *(f32x4*)(hout + off + bj * 128 + n * 16) = o; u32x2 w; w.x = cvt_pk_bf16(o[0], o[1]); w.y = cvt_pk_bf16(o[2], o[3]);
                        *(u32x2*)(hbA + off + bj * 128 + n * 16) = w; s += sq4(o); }
                s = red_fq(s); if (fq == 0) unsafeAtomicAdd(ss_h2 + row, s); asm volatile("" ::: "memory"); }
    }
};
struct EpiPP {
    static constexpr bool PERM = true;
    bf16_t* PROJ; float* ss_pp;
    __device__ __forceinline__ void operator()(AccT& acc, const Unit& u, int wr, int wc, int fr, int fq) const {
        asm volatile("" : "+v"(fr), "+v"(fq));
        const int row0 = u.pm * 256 + wr * 64 + fr;
#pragma unroll
        for (int ai = 0; ai < 2; ++ai)
#pragma unroll
            for (int m = 0; m < 4; ++m) { const int row = row0 + ai * 128 + m * 16; bf16_t* rowp = PROJ + (size_t)row * NP + u.pn * 256 + wc * 32 + 8 * fq; float s = 0.f;
#pragma unroll
                for (int bj = 0; bj < 2; ++bj) { *(u32x4*)(rowp + bj * 128) = pack8(acc[ai][bj][m][0], acc[ai][bj][m][1]); s += sq4(acc[ai][bj][m][0]) + sq4(acc[ai][bj][m][1]); }
                s = red_fq(s); if (fq == 0) unsafeAtomicAdd(ss_pp + row, s); asm volatile("" ::: "memory"); }
    }
};
struct EpiGate {
    static constexpr bool PERM = false;
    float* h; bf16_t* hbB; const bf16_t* PROJ; const float *ss_h2, *ss_pp, *g_post; float* ss_next;
    __device__ __forceinline__ void operator()(AccT& acc, const Unit& u, int wr, int wc, int fr, int fq) const {
        asm volatile("" : "+v"(fr), "+v"(fq));
        const int row0 = u.pm * 256 + wr * 64 + fr, col0 = u.pn * 256 + wc * 32 + 4 * fq;
#pragma unroll
        for (int ai = 0; ai < 2; ++ai)
#pragma unroll
            for (int m = 0; m < 4; ++m) { const int row = row0 + ai * 128 + m * 16; const size_t off = (size_t)row * DM + col0;
                const float rs2 = __builtin_amdgcn_rsqf(ss_h2[row] * (1.0f / 2048.0f) + 1e-6f), rpp = __builtin_amdgcn_rsqf(ss_pp[row] * (1.0f / 2048.0f) + 1e-6f); float s = 0.f;
#pragma unroll
                for (int bj = 0; bj < 2; ++bj)
#pragma unroll
                    for (int n = 0; n < 2; ++n) { const int c = col0 + bj * 128 + n * 16; const f32x4 hv = *(const f32x4*)(h + off + bj * 128 + n * 16);
                        const f32x4 gp = *(const f32x4*)(g_post + c); const u32x2 pw = *(const u32x2*)(PROJ + (size_t)row * NP + c);
                        const f32x4 pp = {bflo(pw.x), bfhi(pw.x), bflo(pw.y), bfhi(pw.y)}; f32x4 o;
#pragma unroll
                        for (int j = 0; j < 4; ++j) { const float gate = __builtin_amdgcn_rcpf(1.0f + __expf(-rs2 * acc[ai][bj][m][n][j])); o[j] = hv[j] + gate * (pp[j] * rpp * gp[j]); }
                        *(f32x4*)(h + off + bj * 128 + n * 16) = o; u32x2 w; w.x = cvt_pk_bf16(o[0], o[1]); w.y = cvt_pk_bf16(o[2], o[3]);
                        *(u32x2*)(hbB + off + bj * 128 + n * 16) = w; s += sq4(o); }
                if (ss_next) { s = red_fq(s); if (fq == 0) unsafeAtomicAdd(ss_next + row, s); } asm volatile("" ::: "memory"); }
    }
};

template <int MODE> __device__ __forceinline__ int srccol(int n) {
    if (MODE == 0) return n;
    if (MODE == 1) {
        if (n < 768) return O_AQ + n;
        if (n < 1024) return O_AK + (n - 768);
        if (n < 1280) return O_AV + (n - 1024);
        if (n < 1792) return O_BCQ + (n - 1280);
        if (n < 2304) return O_BCKV + (n - 1792);
        if (n < 2816) return O_CQ + (n - 2304);
        if (n < 3328) return O_CK + (n - 2816);
        if (n < 3840) return O_CV + (n - 3328);
        if (n < 4608) return O_AZ + (n - 3840);
        if (n < 5376) return O_BZ + (n - 4608);
        if (n < 5888) return O_CZ + (n - 5376);
        if (n < 5952) { const int i = n - 5888, g = i >> 3, e = i & 7; return O_BKR + (e < 4 ? 4 * g + e : 32 + 4 * g + (e - 4)); }
        return -1;
    }
    const int hh = n >> 8, c = n & 255;
    if (c < 128) return hh * 192 + c;
    if (c < 192) { const int i = c - 128, g = i >> 3, e = i & 7; return hh * 192 + 128 + (e < 4 ? 4 * g + e : 32 + 4 * g + (e - 4)); }
    return -1;
}
template <int MODE> __device__ void cvt_weight(const float* src, int ldsrc, int K, int Nout, const float* gain, bf16_t* dst, float* tile) {
    const int ntn = Nout / 64, ntk = K / 64;
    for (int t = blockIdx.x; t < ntn * ntk; t += gridDim.x) {
        const int tn = t / ntk, tk = t % ntk, n0 = tn * 64, k0 = tk * 64;
#pragma unroll
        for (int i = 0; i < 8; ++i) { const int idx = threadIdx.x + i * 512, kk = idx >> 6, nn = idx & 63; const int sc = srccol<MODE>(n0 + nn);
            float v = sc >= 0 ? src[(size_t)(k0 + kk) * ldsrc + sc] : 0.f; if (gain) v *= gain[k0 + kk]; tile[kk * 65 + nn] = v; }
        __syncthreads();
#pragma unroll
        for (int i = 0; i < 4; ++i) { const int idx = threadIdx.x + i * 512, nn = idx >> 5, kp = (idx & 31) * 2;
            *(unsigned*)(dst + (size_t)(n0 + nn) * K + k0 + kp) = cvt_pk_bf16(tile[kp * 65 + nn], tile[(kp + 1) * 65 + nn]); }
        __syncthreads();
    }
}

namespace at {
typedef float f32x16 __attribute__((ext_vector_type(16)));
typedef short s16x4 __attribute__((ext_vector_type(4)));
#define AT_SBAR() __builtin_amdgcn_sched_barrier(0)
constexpr int KVBLK = 64;
constexpr float THR = 8.f, NEGINF = -__builtin_huge_valf();
constexpr int OFF_V = 0, OFF_K = 32768, OFF_WS = 32768 + 51200, OFF_TB = OFF_WS + 2048, TB_PITCH = 160, OFF_SLOT = OFF_TB + 9600, OFF_QR = 95744;
__device__ __forceinline__ int crow(int r, int hi) { return (r & 3) + 8 * (r >> 2) + 4 * hi; }
constexpr int creg(int r) { return (r & 3) + 8 * (r >> 2); }
__device__ __forceinline__ int v_st(int k, int c) { const int kk = (k & ~0xC) | ((k & 4) << 1) | ((k & 8) >> 1); return ((kk >> 3) * 4 + (c >> 5)) * 512 + ((kk & 7) * 32 + (c & 31)) * 2; }
__device__ __forceinline__ int v_rd_base(int lane) { return ((lane & 3) << 3) | (((lane >> 2) & 3) << 6) | (((lane >> 4) & 1) << 5) | (((lane >> 5) & 1) << 8); }
constexpr int v_rd_off(int d0, int ks, int half) { return d0 * 512 + ks * 4096 + half * 2048; }
template <int OFF> __device__ __forceinline__ s16x4 tr_read(int vb) { s16x4 r; asm volatile("ds_read_b64_tr_b16 %0, %1 offset:%2" : "=&v"(r) : "v"(vb), "i"(OFF) : "memory"); return r; }
template <int D0> __device__ __forceinline__ void pv_one(f32x16& od, int vb, bf16x8 pa0, bf16x8 pa1, bf16x8 pa2, bf16x8 pa3) {
    const s16x4 l0 = tr_read<v_rd_off(D0, 0, 0)>(vb), h0 = tr_read<v_rd_off(D0, 0, 1)>(vb), l1 = tr_read<v_rd_off(D0, 1, 0)>(vb), h1 = tr_read<v_rd_off(D0, 1, 1)>(vb);
    const s16x4 l2 = tr_read<v_rd_off(D0, 2, 0)>(vb), h2 = tr_read<v_rd_off(D0, 2, 1)>(vb), l3 = tr_read<v_rd_off(D0, 3, 0)>(vb), h3 = tr_read<v_rd_off(D0, 3, 1)>(vb);
    asm volatile("s_waitcnt lgkmcnt(0)" ::: "memory"); AT_SBAR();
#define AT_PK(L, H) (bf16x8){L[0], L[1], L[2], L[3], H[0], H[1], H[2], H[3]}
    od = __builtin_amdgcn_mfma_f32_32x32x16_bf16(pa0, AT_PK(l0, h0), od, 0, 0, 0);
    od = __builtin_amdgcn_mfma_f32_32x32x16_bf16(pa1, AT_PK(l1, h1), od, 0, 0, 0);
    od = __builtin_amdgcn_mfma_f32_32x32x16_bf16(pa2, AT_PK(l2, h2), od, 0, 0, 0);
    od = __builtin_amdgcn_mfma_f32_32x32x16_bf16(pa3, AT_PK(l3, h3), od, 0, 0, 0);
#undef AT_PK
}
__device__ __forceinline__ void pv_d0(f32x16* o, int vb, bf16x8 pa0, bf16x8 pa1, bf16x8 pa2, bf16x8 pa3) {
    pv_one<0>(o[0], vb, pa0, pa1, pa2, pa3); pv_one<1>(o[1], vb, pa0, pa1, pa2, pa3); pv_one<2>(o[2], vb, pa0, pa1, pa2, pa3); pv_one<3>(o[3], vb, pa0, pa1, pa2, pa3);
}
__device__ __forceinline__ void partialSM(f32x16& p0, f32x16& p1, float& m_reg, float& mn, float& alpha) {
    float pmax = p0[0];
#pragma unroll
    for (int r = 1; r < 16; ++r) pmax = fmaxf(pmax, p0[r]);
#pragma unroll
    for (int r = 0; r < 16; ++r) pmax = fmaxf(pmax, p1[r]);
    { auto rr = __builtin_amdgcn_permlane32_swap(__float_as_uint(pmax), __float_as_uint(pmax), false, false); pmax = fmaxf(__uint_as_float(rr[0]), __uint_as_float(rr[1])); }
    if (__builtin_expect(__all(pmax - m_reg <= THR), 1)) { mn = m_reg; alpha = 1.f; }
    else { mn = fmaxf(m_reg, pmax); alpha = __builtin_amdgcn_exp2f(m_reg - mn); m_reg = mn; }
#pragma unroll
    for (int r = 0; r < 16; ++r) { p0[r] -= mn; p1[r] -= mn; }
#pragma unroll
    for (int r = 0; r < 16; ++r) p0[r] = __builtin_amdgcn_exp2f(p0[r]);
}
__device__ __forceinline__ void finishSM(f32x16& p0, f32x16& p1, float alpha, float& l_reg, bf16x8& pa0, bf16x8& pa1, bf16x8& pa2, bf16x8& pa3) {
#pragma unroll
    for (int r = 0; r < 16; ++r) p1[r] = __builtin_amdgcn_exp2f(p1[r]);
    float ps = 0;
#pragma unroll
    for (int r = 0; r < 16; ++r) ps += p0[r];
#pragma unroll
    for (int r = 0; r < 16; ++r) ps += p1[r];
    { auto rr = __builtin_amdgcn_permlane32_swap(__float_as_uint(ps), __float_as_uint(ps), false, false); ps = __uint_as_float(rr[0]) + __uint_as_float(rr[1]); }
    l_reg = l_reg * alpha + ps;
#define AT_PK4(P, BASE, OUT) do { unsigned a0 = cvt_pk_bf16(P[BASE + 0], P[BASE + 1]), a1 = cvt_pk_bf16(P[BASE + 2], P[BASE + 3]); \
        unsigned b0 = cvt_pk_bf16(P[BASE + 4], P[BASE + 5]), b1 = cvt_pk_bf16(P[BASE + 6], P[BASE + 7]); \
        auto r0 = __builtin_amdgcn_permlane32_swap(a0, b0, false, false); auto r1 = __builtin_amdgcn_permlane32_swap(a1, b1, false, false); \
        u32x4 w = {r0[0], r1[0], r0[1], r1[1]}; OUT = *reinterpret_cast<bf16x8*>(&w); } while (0)
    AT_PK4(p0, 0, pa0); AT_PK4(p0, 8, pa1); AT_PK4(p1, 0, pa2); AT_PK4(p1, 8, pa3);
#undef AT_PK4
}

template <int MODE> struct Cfg;
template <> struct Cfg<0> { static constexpr int DQK = 128, LDQ = NP, LDK = NP, LDV = NP; };
template <> struct Cfg<1> { static constexpr int DQK = 192, LDQ = 1152, LDK = 1152, LDV = 768; };
template <> struct Cfg<2> { static constexpr int DQK = 128, LDQ = NP, LDK = NP, LDV = NP; };

template <int MODE>
__device__ __forceinline__ void attn_unit(const bf16_t* __restrict__ Qb, const bf16_t* __restrict__ Kh, const bf16_t* __restrict__ Vh, bf16_t* __restrict__ Yb,
                                          int pos0, int h, const float* __restrict__ extra, char* lds) {
    constexpr int DQK = Cfg<MODE>::DQK, LDQ = Cfg<MODE>::LDQ, LDK = Cfg<MODE>::LDK, LDV = Cfg<MODE>::LDV, ND = DQK / 16, KPITCH = DQK * 2 + 16, SHM_K = 64 * KPITCH, SHM_V = 16384;
    int tid = threadIdx.x; asm volatile("" : "+v"(tid));
    const int wid = tid >> 6, lane = tid & 63, r32 = lane & 31, hi = lane >> 5;
    char* V_lds = lds + OFF_V; char* K_lds = lds + OFF_K;
    float* wsw = (float*)(lds + OFF_WS) + wid * 64; float* li_l = wsw; float* al_l = wsw + 32;
    int klo, NT;
    if (MODE == 0) { klo = max(0, pos0 - 128); NT = (min(SEQ, pos0 + 384) - klo) >> 6; }
    else if (MODE == 1) { klo = 0; NT = SEQ / 64; }
    else { const int r0 = pos0 >> 6; const int lo = min(max(r0 - 4, 0), 24), hiR = min(max(r0 + 3 - 4, 0), 24) + 8; NT = hiR - lo; if (NT & 1) NT += 1; klo = lo * 64; }
    float slope2 = 0.f; int dbase0 = 0; int cs = 0; bool dummy = false; (void)dummy;
    const float* tbl = nullptr; int rq = 0, rsq = 0;
    if (MODE == 0) { slope2 = exp2f(-8.0f * (float)(h + 1) * (1.0f / 6.0f)) * LOG2E; dbase0 = klo + 4 * hi - (pos0 + wid * 32 + r32); }
    if (MODE == 2) {
        float* TB = (float*)(lds + OFF_TB);
        for (int i = tid; i < 15 * 31; i += 512) { const int a = i / 31, b = i - a * 31; TB[a * TB_PITCH + 64 + b] = extra[i] * LOG2E; }
        const int c = (wid & 1) * 32 + r32; rq = (pos0 >> 6) + (wid >> 1); rsq = min(max(rq - 4, 0), 24); cs = min(max(c - 8, 0), 48);
        tbl = TB + 64 + 15 - c + 4 * hi;
    }
    float m_reg = -1e30f, l_reg = 0; f32x16 o[4];
#pragma unroll
    for (int d = 0; d < 4; ++d)
#pragma unroll
        for (int r = 0; r < 16; ++r) o[d][r] = 0.f;
    bf16x8 qr[8];
    char* QR = lds + OFF_QR + (wid * 32 + r32) * 144 + hi * 16;
    { const bf16_t* Qw = Qb + (size_t)(wid * 32 + r32) * LDQ + hi * 8;
#pragma unroll
      for (int d0 = 0; d0 < 8; ++d0) qr[d0] = *(const bf16x8*)(Qw + d0 * 16);
      if (DQK == 192) {
#pragma unroll
          for (int d0 = 0; d0 < 4; ++d0) *(bf16x8*)(QR + d0 * 32) = *(const bf16x8*)(Qw + 128 + d0 * 16); } }
    const int sr = tid >> 4, sc = (tid & 15) * 8, vst0 = v_st(sr, sc), vst1 = v_st(32 + sr, sc);
    const int sr2 = tid >> 3, sc2 = 128 + (tid & 7) * 8;
    const int vb0 = (int)(uintptr_t)(LAS char*)V_lds + v_rd_base(lane);
    const char* kbase = K_lds + r32 * KPITCH + hi * 16;
    const bf16_t* Kg = Kh + (size_t)klo * LDK; const bf16_t* Vg = Vh + (size_t)klo * LDV;
    bf16x8 sAvv0, sAvv1, sAkk0, sAkk1, sAkk2, sBvv0, sBvv1, sBkk0, sBkk1, sBkk2;
#define AT_KSWZ(row, colB) ((row) * KPITCH + (colB))
#define AT_SLOAD(S, koff) do { S##vv0 = *(const bf16x8*)(Vg + (size_t)((koff) + sr) * LDV + sc); S##vv1 = *(const bf16x8*)(Vg + (size_t)((koff) + 32 + sr) * LDV + sc); \
        S##kk0 = *(const bf16x8*)(Kg + (size_t)((koff) + sr) * LDK + sc); S##kk1 = *(const bf16x8*)(Kg + (size_t)((koff) + 32 + sr) * LDK + sc); \
        if (DQK == 192) S##kk2 = *(const bf16x8*)(Kg + (size_t)((koff) + sr2) * LDK + sc2); } while (0)
#define AT_SWRITE(b, S) do { *(bf16x8*)(V_lds + (b) * SHM_V + vst0) = S##vv0; *(bf16x8*)(V_lds + (b) * SHM_V + vst1) = S##vv1; \
        *(bf16x8*)(K_lds + (b) * SHM_K + AT_KSWZ(sr, sc * 2)) = S##kk0; *(bf16x8*)(K_lds + (b) * SHM_K + AT_KSWZ(32 + sr, sc * 2)) = S##kk1; \
        if (DQK == 192) *(bf16x8*)(K_lds + (b) * SHM_K + AT_KSWZ(sr2, sc2 * 2)) = S##kk2; } while (0)
#define AT_SWAIT() do { if (DQK == 192) asm volatile("s_waitcnt vmcnt(5)" ::: "memory"); else asm volatile("s_waitcnt vmcnt(4)" ::: "memory"); } while (0)
#define AT_RESC(a) do { if (__any((a) < 1.f)) { if (hi == 0) al_l[r32] = (a); asm volatile("s_waitcnt lgkmcnt(0)" ::: "memory"); \
        _Pragma("unroll") for (int d = 0; d < 4; ++d) _Pragma("unroll") for (int r = 0; r < 16; ++r) o[d][r] *= al_l[crow(r, hi)]; } } while (0)
#define AT_QKT(P0, P1, b) do { const char* Ks_ = kbase + (b) * SHM_K; \
        _Pragma("unroll") for (int r = 0; r < 16; ++r) { P0[r] = 0.f; P1[r] = 0.f; } \
        _Pragma("unroll") for (int d0 = 0; d0 < ND; ++d0) { \
            const bf16x8 b0 = *(const bf16x8*)(Ks_ + d0 * 32), b1 = *(const bf16x8*)(Ks_ + 32 * KPITCH + d0 * 32); \
            const bf16x8 qf_ = d0 < 8 ? qr[d0 & 7] : *(const bf16x8*)(QR + ((d0 - 8) & 3) * 32); \
            P0 = __builtin_amdgcn_mfma_f32_32x32x16_bf16(b0, qf_, P0, 0, 0, 0); P1 = __builtin_amdgcn_mfma_f32_32x32x16_bf16(b1, qf_, P1, 0, 0, 0); } } while (0)
#define AT_MASK(P0, P1, j) do { \
        if (MODE == 0) { const int db = dbase0 + (j) * 64; \
            _Pragma("unroll") for (int r = 0; r < 16; ++r) { const int d0_ = db + creg(r), d1_ = d0_ + 32; const int a0_ = d0_ < 0 ? -d0_ : d0_, a1_ = d1_ < 0 ? -d1_ : d1_; \
                P0[r] = a0_ <= 128 ? P0[r] - slope2 * (float)a0_ : NEGINF; P1[r] = a1_ <= 128 ? P1[r] - slope2 * (float)a1_ : NEGINF; } } \
        if (MODE == 2) { const int kr_ = (klo >> 6) + (j); const bool tok_ = (kr_ >= rsq) && (kr_ < rsq + 8); const int di_ = min(max(kr_ - rq + 7, 0), 14); \
            const float* tb_ = tbl + di_ * TB_PITCH; const int kc0_ = 4 * hi - cs; \
            _Pragma("unroll") for (int r = 0; r < 16; ++r) { const unsigned u0_ = (unsigned)(kc0_ + creg(r)), u1_ = (unsigned)(kc0_ + creg(r) + 32); \
                P0[r] = (tok_ && u0_ < 16u) ? P0[r] + tb_[creg(r)] : NEGINF; P1[r] = (tok_ && u1_ < 16u) ? P1[r] + tb_[creg(r) + 32] : NEGINF; } } } while (0)
    f32x16 pA0, pA1, pB0, pB1; float mnA, mnB, alA, alB; bf16x8 pa0, pa1, pa2, pa3;
    __syncthreads();
    constexpr int SD = (MODE == 1) ? 1 : 2;
    AT_SLOAD(sA, 0); asm volatile("s_waitcnt vmcnt(0)" ::: "memory"); AT_SWRITE(0, sA); __syncthreads();
    AT_QKT(pA0, pA1, 0); AT_MASK(pA0, pA1, 0); partialSM(pA0, pA1, m_reg, mnA, alA);
    if (SD == 2) { AT_SLOAD(sB, KVBLK); if (2 < NT) AT_SLOAD(sA, 2 * KVBLK); AT_SWAIT(); AT_SWRITE(1, sB); }
    else { AT_SLOAD(sA, KVBLK); AT_SWRITE(1, sA); }
    __syncthreads();
    for (int j = 1; j + 1 < NT; j += 2) {
        AT_SBAR(); AT_QKT(pB0, pB1, 1); AT_MASK(pB0, pB1, j);
        finishSM(pA0, pA1, alA, l_reg, pa0, pa1, pa2, pa3); AT_SBAR();
        if (SD == 2) AT_SLOAD(sB, (j + 2) * KVBLK); else AT_SLOAD(sA, (j + 1) * KVBLK);
        AT_SBAR();
        pv_d0(o, vb0, pa0, pa1, pa2, pa3); partialSM(pB0, pB1, m_reg, mnB, alB);
        __syncthreads(); if (SD == 2) AT_SWAIT(); AT_SWRITE(0, sA);
        AT_RESC(alB); __syncthreads();
        AT_SBAR(); AT_QKT(pA0, pA1, 0); AT_MASK(pA0, pA1, j + 1);
        finishSM(pB0, pB1, alB, l_reg, pa0, pa1, pa2, pa3); AT_SBAR();
        if (SD == 2) { if (j + 3 < NT) AT_SLOAD(sA, (j + 3) * KVBLK); } else AT_SLOAD(sA, (j + 2) * KVBLK);
        AT_SBAR();
        pv_d0(o, vb0 + SHM_V, pa0, pa1, pa2, pa3); partialSM(pA0, pA1, m_reg, mnA, alA);
        __syncthreads(); if (SD == 2) { AT_SWAIT(); AT_SWRITE(1, sB); } else AT_SWRITE(1, sA);
        AT_RESC(alA); __syncthreads();
    }
    AT_SBAR(); AT_QKT(pB0, pB1, 1); AT_MASK(pB0, pB1, NT - 1);
    finishSM(pA0, pA1, alA, l_reg, pa0, pa1, pa2, pa3); AT_SBAR();
    pv_d0(o, vb0, pa0, pa1, pa2, pa3); partialSM(pB0, pB1, m_reg, mnB, alB);
    __syncthreads(); AT_RESC(alB);
    finishSM(pB0, pB1, alB, l_reg, pa0, pa1, pa2, pa3); AT_SBAR();
    pv_d0(o, vb0 + SHM_V, pa0, pa1, pa2, pa3);
    float fin;
    if (MODE == 0) { const float sk = extra[0] * LOG2E, mf = fmaxf(m_reg, sk), a = __builtin_amdgcn_exp2f(m_reg - mf); fin = a * __builtin_amdgcn_rcpf(l_reg * a + __builtin_amdgcn_exp2f(sk - mf)); }
    else fin = __builtin_amdgcn_rcpf(l_reg);
    if (hi == 0) li_l[r32] = fin;
    asm volatile("s_waitcnt lgkmcnt(0)" ::: "memory");
    __syncthreads();
    bf16_t* Ot = (bf16_t*)lds + wid * (32 * 136);
#pragma unroll
    for (int r = 0; r < 16; ++r) { const int orow = crow(r, hi); const float f = li_l[orow];
#pragma unroll
        for (int d0 = 0; d0 < 4; ++d0) Ot[orow * 136 + d0 * 32 + r32] = (bf16_t)(cvt_pk_bf16(o[d0][r] * f, 0.f) & 0xffffu); }
    asm volatile("s_waitcnt lgkmcnt(0)" ::: "memory");
#pragma unroll
    for (int i = 0; i < 8; ++i) { const int idx = i * 64 + lane, row = idx >> 4, c8 = (idx & 15) * 8;
        const u32x4 ov = *(const u32x4*)(Ot + row * 136 + c8);
        bf16_t* yp = Yb + (size_t)(wid * 32 + row) * NP + c8; const u32x4 sg = *(const u32x4*)yp; u32x4 w;
        w.x = cvt_pk_bf16(bflo(ov.x) * bflo(sg.x), bfhi(ov.x) * bfhi(sg.x)); w.y = cvt_pk_bf16(bflo(ov.y) * bflo(sg.y), bfhi(ov.y) * bfhi(sg.y));
        w.z = cvt_pk_bf16(bflo(ov.z) * bflo(sg.z), bfhi(ov.z) * bfhi(sg.z)); w.w = cvt_pk_bf16(bflo(ov.w) * bflo(sg.w), bfhi(ov.w) * bfhi(sg.w));
        *(u32x4*)yp = w; }
#undef AT_KSWZ
#undef AT_SLOAD
#undef AT_SWRITE
#undef AT_SWAIT
#undef AT_RESC
#undef AT_QKT
#undef AT_MASK
}
}

__global__ __launch_bounds__(512, 2) void hymba_fwd(Params p) {
    extern __shared__ __attribute__((aligned(16))) unsigned char shm[];
    cg::grid_group grid = cg::this_grid();
    LAS unsigned char* lds = (LAS unsigned char*)shm;
    LAS float* TABL = (LAS float*)(lds + LDS_STAGE);
    float* ldsf = (float*)shm;
    unsigned char* ws = p.ws;
    bf16_t* HBB = (bf16_t*)(ws + OFF_HBB); bf16_t* PB = (bf16_t*)(ws + OFF_PB); bf16_t* PROJ = (bf16_t*)(ws + OFF_PROJ);
    bf16_t* QB = (bf16_t*)(ws + OFF_QB); bf16_t* KB = (bf16_t*)(ws + OFF_KB); bf16_t* VB = (bf16_t*)(ws + OFF_VB); bf16_t* HBA = QB;
    float* SS = (float*)(ws + OFF_SS); float2* tab = (float2*)(ws + OFF_TAB); float* GT = (float*)(ws + OFF_GT); unsigned* CTR = (unsigned*)(ws + OFF_CTR);
#define SSP(kind, l) (SS + ((size_t)(kind) * 4 + (l)) * TTOT)
    const int tid = threadIdx.x, gthreads = gridDim.x * 512, gtid = blockIdx.x * 512 + tid;

    for (int l = 0; l < 4; ++l) {
        cvt_weight<1>(p.w_in + (size_t)l * DM * INW, INW, DM, NP, p.norm_in + l * DM, (bf16_t*)(ws + OFF_WIN + l * SZ_WIN), ldsf);
        cvt_weight<2>(p.b_w_uq + (size_t)l * 512 * 1152, 1152, 512, 1536, p.b_cq_norm + l * 512, (bf16_t*)(ws + OFF_WUQ + l * SZ_WU), ldsf);
        cvt_weight<0>(p.b_w_ukv + (size_t)l * 512 * 1536, 1536, 512, 1536, p.b_ckv_norm + l * 512, (bf16_t*)(ws + OFF_WUKV + l * SZ_WU), ldsf);
        cvt_weight<0>(p.w_out + (size_t)l * DM * DM, DM, DM, DM, nullptr, (bf16_t*)(ws + OFF_WOUT + l * SZ_WSQ), ldsf);
        cvt_weight<0>(p.w_gate + (size_t)l * DM * DM, DM, DM, DM, p.ple_norm + l * DM, (bf16_t*)(ws + OFF_WGATE + l * SZ_WSQ), ldsf);
        cvt_weight<0>(p.w_proj + (size_t)l * 256 * DM, DM, 256, DM, nullptr, (bf16_t*)(ws + OFF_WPROJ + l * SZ_WPROJ), ldsf);
    }
    for (int i = gtid; i < 5 * 4 * TTOT; i += gthreads) { const int kind = 1 + i / (4 * TTOT), rem = i % (4 * TTOT); SS[(size_t)kind * 4 * TTOT + rem] = 0.f; }
    for (int i = gtid; i < 3 * TTOT; i += gthreads) SS[TTOT + i] = 0.f;
    if (gtid < 8) CTR[gtid] = 0u;
    if (gtid < 2048) { const int l = gtid >> 9, w = (gtid >> 7) & 3, d = gtid & 127; float v;
        if (w == 0) v = p.a_q_norm[l * 128 + d]; else if (w == 1) v = p.a_k_norm[l * 128 + d]; else if (w == 2) v = p.c_q_norm[l * 128 + d]; else v = p.c_k_norm[l * 128 + d];
        GT[gtid] = v; }
    for (int i = gtid; i < SEQ * 32; i += gthreads) { const int pos = i >> 5, j = i & 31; const double ang = (double)pos * pow(10000.0, -(double)j / 32.0); tab[i] = make_float2((float)cos(ang), (float)sin(ang)); }
    {
        const int gw = gtid >> 6, nw = gthreads >> 6, lane = tid & 63;
        for (int row = gw; row < TTOT; row += nw) {
            const float* src = row < 8192 ? p.x_prompt + (size_t)row * DM : p.x_sample + (size_t)(row - 8192) * DM; float s = 0.f;
#pragma unroll
            for (int i = 0; i < 4; ++i) { const int c = (i * 64 + lane) * 8; const f32x4 a = *(const f32x4*)(src + c), b = *(const f32x4*)(src + c + 4);
                s += sq4(a) + sq4(b); *(u32x4*)(HBB + (size_t)row * DM + c) = pack8(a, b); }
            s = wave_sum(s); if (lane == 0) SSP(0, 0)[row] = s;
        }
        for (size_t i = gtid; i < (size_t)4 * TTOT * 256 / 8; i += gthreads) { const size_t e = i * 8; const int l = (int)(e / ((size_t)TTOT * 256)); const size_t r = e % ((size_t)TTOT * 256);
            const int t = (int)(r >> 8), c = (int)(r & 255);
            const float* src = t < 8192 ? p.p_prompt + ((size_t)l * 8192 + t) * 256 + c : p.p_sample + ((size_t)l * 32768 + (t - 8192)) * 256 + c;
            *(u32x4*)(PB + e) = pack8(*(const f32x4*)src, *(const f32x4*)(src + 4)); }
    }
    grid.sync();

    for (int l = 0; l < 4; ++l) {
        for (int ch = 0; ch < 2; ++ch) {
            const int r0 = ch ? 8192 : 0, TC = ch ? 32768 : 8192;
            pg8::StaticOrder S;
            {
                pg8::Gemm g{HBB + (size_t)r0 * DM, (const bf16_t*)(ws + OFF_WIN + l * SZ_WIN), DM, TC, NP, DM};
                EpiProj E{PROJ, SSP(0, l) + r0, SSP(3, l) + r0, SSP(5, l) + r0, GT + l * 512, p.b_k_norm + l * 192 + 128, tab, TABL};
                S.init(TC, NP, gridDim.x, blockIdx.x); pg8::gemm_phase(lds, g, S, E);
            }
            grid.sync();
            {
                pg8::Gemm g{PROJ + C_BCQ, (const bf16_t*)(ws + OFF_WUQ + l * SZ_WU), NP, TC, 1536, 512};
                EpiUQ E{QB, SSP(3, l) + r0, p.b_q_norm + l * 192, tab, TABL};
                S.init(TC, 1536, gridDim.x, blockIdx.x); pg8::gemm_phase(lds, g, S, E);
            }
            {
                pg8::Gemm g{PROJ + C_BCKV, (const bf16_t*)(ws + OFF_WUKV + l * SZ_WU), NP, TC, 1536, 512};
                EpiUKV E{KB, VB, PROJ, SSP(4, l) + r0, SSP(5, l) + r0, p.b_k_norm + l * 192, TABL};
                S.init(TC, 1536, gridDim.x, blockIdx.x); pg8::gemm_phase(lds, g, S, E);
            }
            grid.sync();
            {
                const int nqb = TC / 256, nB = nqb * 6, nC = nqb * 4, nA = nqb * 6;
                unsigned* ctr = CTR + (l * 2 + ch);
                LAS int* slot = (LAS int*)(lds + at::OFF_SLOT);
                for (;;) {
                    __syncthreads();
                    if (threadIdx.x == 0) *slot = (int)atomicAdd(ctr, 1u);
                    __syncthreads();
                    const int uI = *slot;
                    if (uI >= nB + nC + nA) break;
                    if (uI < nB) { const int hh = uI % 6, t0 = (uI / 6) * 256, sb = t0 & ~(SEQ - 1);
                        at::attn_unit<1>(QB + (size_t)t0 * 1152 + hh * 192, KB + (size_t)sb * 1152 + hh * 192, VB + (size_t)sb * 768 + hh * 128, PROJ + (size_t)t0 * NP + C_Z + 768 + hh * 128,
                                         t0 & (SEQ - 1), hh, nullptr, (char*)shm); }
                    else if (uI < nB + nC) { const int v = uI - nB, hh = v & 3, t0 = (v >> 2) * 256, sb = t0 & ~(SEQ - 1);
                        at::attn_unit<2>(PROJ + (size_t)t0 * NP + C_CQ + hh * 128, PROJ + (size_t)sb * NP + C_CK + hh * 128, PROJ + (size_t)sb * NP + C_CV + hh * 128, PROJ + (size_t)t0 * NP + C_Z + 1536 + hh * 128,
                                         t0 & (SEQ - 1), hh, p.c_rpb + ((size_t)l * 4 + hh) * 15 * 31, (char*)shm); }
                    else { const int v = uI - nB - nC, hh = v % 6, t0 = (v / 6) * 256, sb = t0 & ~(SEQ - 1);
                        at::attn_unit<0>(PROJ + (size_t)t0 * NP + C_AQ + hh * 128, PROJ + (size_t)sb * NP + C_AK + (hh / 3) * 128, PROJ + (size_t)sb * NP + C_AV + (hh / 3) * 128, PROJ + (size_t)t0 * NP + C_Z + hh * 128,
                                         t0 & (SEQ - 1), hh, p.a_sink + l * 6 + hh, (char*)shm); }
                }
            }
            grid.sync();
            {
                const float* hin = (l == 0) ? (ch ? p.x_sample : p.x_prompt) : p.h + (size_t)r0 * DM;
                pg8::Gemm g{PROJ + C_Z, (const bf16_t*)(ws + OFF_WOUT + l * SZ_WSQ), NP, TC, DM, DM};
                EpiOut E{hin, p.h + (size_t)r0 * DM, HBA, SSP(1, l) + r0};
                S.init(TC, DM, gridDim.x, blockIdx.x); pg8::gemm_phase(lds, g, S, E);
            }
            {
                pg8::Gemm g{PB + ((size_t)l * TTOT + r0) * 256, (const bf16_t*)(ws + OFF_WPROJ + l * SZ_WPROJ), 256, TC, DM, 256};
                EpiPP E{PROJ, SSP(2, l) + r0};
                S.init(TC, DM, gridDim.x, blockIdx.x); pg8::gemm_phase(lds, g, S, E);
            }
            grid.sync();
            {
                pg8::Gemm g{HBA, (const bf16_t*)(ws + OFF_WGATE + l * SZ_WSQ), DM, TC, DM, DM};
                EpiGate E{p.h + (size_t)r0 * DM, HBB + (size_t)r0 * DM, PROJ, SSP(1, l) + r0, SSP(2, l) + r0, p.post_norm + l * DM, (l < 3) ? SSP(0, l + 1) + r0 : nullptr};
                S.init(TC, DM, gridDim.x, blockIdx.x); pg8::gemm_phase(lds, g, S, E);
            }
            grid.sync();
        }
    }
}

extern "C" void kernel_launch(void* const* d_in, const int* in_sizes, int n_in, void* d_out, int out_size, void* d_ws, size_t ws_size, hipStream_t stream) {
    static int grid_blocks = 0;
    if (grid_blocks == 0) {
        if (n_in != 23 || ws_size < WS_END) { fprintf(stderr, "kernel_launch: need 23 inputs and %zu bytes of workspace (got %d, %zu)\n", (size_t)WS_END, n_in, ws_size); grid_blocks = -1; return; }
        int dev = 0, cus = 0, per_cu = 0;
        if (hipGetDevice(&dev) != hipSuccess || hipDeviceGetAttribute(&cus, hipDeviceAttributeMultiprocessorCount, dev) != hipSuccess) { grid_blocks = -1; return; }
        if (hipFuncSetAttribute((const void*)hymba_fwd, hipFuncAttributeMaxDynamicSharedMemorySize, LDS_BYTES) != hipSuccess) { fprintf(stderr, "kernel_launch: hipFuncSetAttribute failed\n"); grid_blocks = -1; return; }
        if (hipOccupancyMaxActiveBlocksPerMultiprocessor(&per_cu, (const void*)hymba_fwd, 512, LDS_BYTES) != hipSuccess || per_cu < 1) { fprintf(stderr, "kernel_launch: occupancy query failed (%d)\n", per_cu); (void)hipGetLastError(); per_cu = 1; }
        grid_blocks = cus * per_cu;
    }
    if (grid_blocks < 0) return;
    Params p{};
    const float** pf = (const float**)&p;
    for (int i = 0; i < 23; ++i) pf[i] = (const float*)d_in[i];
    p.h = (float*)d_out; p.ws = (unsigned char*)d_ws;
    void* args[] = {&p};
    hipError_t e = hipLaunchCooperativeKernel((const void*)hymba_fwd, dim3(grid_blocks), dim3(512), args, LDS_BYTES, stream);
    if (e != hipSuccess) fprintf(stderr, "cooperative launch failed: %s (grid %d)\n", hipGetErrorString(e), grid_blocks);
}
```

```cpp
#include <hip/hip_runtime.h>
#include <hip/hip_cooperative_groups.h>
#include <cstdio>
#include <math.h>
namespace cg = cooperative_groups;
#define PROBE_SEL 0

#define LAS __attribute__((address_space(3)))
typedef unsigned short bf16_t;
typedef short bf16x8 __attribute__((ext_vector_type(8)));
typedef float f32x4 __attribute__((ext_vector_type(4)));
typedef unsigned u32x4 __attribute__((ext_vector_type(4)));
typedef unsigned u32x2 __attribute__((ext_vector_type(2)));

constexpr int SEQ = 2048, DM = 2048, INW = 5952, TTOT = 40960, NP = 6144;
constexpr int O_AQ = 0, O_AK = 768, O_AV = 1024, O_AZ = 1280, O_BCQ = 2048, O_BCKV = 2560, O_BKR = 3072, O_BZ = 3136, O_CQ = 3904, O_CK = 4416, O_CV = 4928, O_CZ = 5440;
constexpr int C_AQ = 0, C_AK = 768, C_AV = 1024, C_BCQ = 1280, C_BCKV = 1792, C_CQ = 2304, C_CK = 2816, C_CV = 3328, C_Z = 3840, C_KR = 5888;
constexpr float LOG2E = 1.4426950408889634f;
constexpr float QS_A = 0.08838834764831845f * LOG2E;
constexpr float QS_B = 0.07216878364870323f * LOG2E;
constexpr size_t SZ_WIN = (size_t)NP * 2048 * 2, SZ_WU = (size_t)1536 * 512 * 2, SZ_WSQ = (size_t)2048 * 2048 * 2, SZ_WPROJ = (size_t)2048 * 256 * 2;
constexpr size_t OFF_WIN = 0, OFF_WUQ = OFF_WIN + SZ_WIN, OFF_WUKV = OFF_WUQ + SZ_WU, OFF_WOUT = OFF_WUKV + SZ_WU, OFF_WGATE = OFF_WOUT + SZ_WSQ,
                 OFF_WPROJ = OFF_WGATE + SZ_WSQ, OFF_PB = OFF_WPROJ + SZ_WPROJ, SZ_LAYER = OFF_PB + (size_t)TTOT * 256 * 2,
                 OFF_HBB = 2 * SZ_LAYER,
                 OFF_PROJ = OFF_HBB + (size_t)TTOT * DM * 2, OFF_QB = OFF_PROJ + (size_t)TTOT * NP * 2, OFF_KB = OFF_QB + (size_t)TTOT * 1152 * 2,
                 OFF_VB = OFF_KB + (size_t)TTOT * 1152 * 2, OFF_SS = OFF_VB + (size_t)TTOT * 768 * 2, OFF_TAB = OFF_SS + (size_t)6 * 4 * TTOT * 4,
                 OFF_GT = OFF_TAB + (size_t)SEQ * 32 * 8, OFF_CTR = OFF_GT + 4 * 4 * 128 * 4, OFF_BAR = OFF_CTR + 256, WS_END = OFF_BAR + 3456 * 4;
static_assert(WS_END <= (size_t)1 << 30, "workspace budget");
constexpr int LDS_STAGE = 131072, LDS_XB = LDS_STAGE + 8192, LDS_BYTES = LDS_XB + 16;
constexpr unsigned long long STAGGER_TICKS = 2200;

struct Params {
    const float *x_prompt, *x_sample, *p_prompt, *p_sample, *norm_in, *w_in, *a_q_norm, *a_k_norm, *a_sink, *b_cq_norm, *b_ckv_norm, *b_w_uq, *b_w_ukv,
        *b_q_norm, *b_k_norm, *c_q_norm, *c_k_norm, *c_rpb, *w_out, *ple_norm, *w_gate, *w_proj, *post_norm;
    float* h;
    unsigned char* ws;
};

__device__ __forceinline__ unsigned cvt_pk_bf16(float lo, float hi) { unsigned r; asm volatile("v_cvt_pk_bf16_f32 %0, %1, %2" : "=v"(r) : "v"(lo), "v"(hi)); return r; }
__device__ __forceinline__ float bf2f(unsigned short b) { return __uint_as_float(((unsigned)b) << 16); }
__device__ __forceinline__ float bflo(unsigned w) { return __uint_as_float(w << 16); }
__device__ __forceinline__ float bfhi(unsigned w) { return __uint_as_float(w & 0xffff0000u); }
__device__ __forceinline__ int lane_id() { unsigned m = ~0u; asm volatile("" : "+s"(m)); return (int)__builtin_amdgcn_mbcnt_hi(m, __builtin_amdgcn_mbcnt_lo(m, 0u)); }
__device__ __forceinline__ float wave_sum(float v) {
#pragma unroll
    for (int o = 32; o >= 1; o >>= 1) v += __shfl_xor(v, o);
    return v;
}

namespace pg8 {
constexpr int BM = 256, BK = 64, HALF = 128, HTB = HALF * BK * 2, STAGE_BYTES = 8 * HTB, NXCD = 8, WGM = 8;
__device__ __forceinline__ int lds_byte(int r, int c) { const int st = (r >> 4) * 2 + (c >> 5), rr = r & 15, cc = c & 31, ob = rr * 64 + cc * 2; return st * 1024 + (ob ^ (((ob >> 9) & 1) << 5)); }
__device__ __forceinline__ void stage_rc(int b, int& R, int& C) { const int st = b / 1024, sb = b % 1024, swz = sb ^ (((sb >> 9) & 1) << 5); R = (st >> 1) * 16 + swz / 64; C = (st & 1) * 32 + (swz % 64) / 2; }
__device__ __forceinline__ int perm32(int rho) { const int n = rho >> 4, i = rho & 15; return 8 * (i >> 2) + 4 * n + (i & 3); }
struct Unit { int pm, pn; };
struct Gemm { const bf16_t* A; const bf16_t* Bt; int lda, M, N, K; };
struct StaticOrder {
    int nM, nN, nwg, G, c;
    __device__ void init(int M, int N, int G_, int c_) { nM = M / BM; nN = N / BM; nwg = nM * nN; G = G_; c = c_; }
    __device__ bool next(int i, Unit& u) const {
        const long L = (long)i * G + c; if (L >= nwg) return false;
        int wgid = (int)L; { const int q = nwg / NXCD, r = nwg % NXCD, xcd = wgid % NXCD, off = wgid / NXCD; wgid = (xcd < r ? xcd * (q + 1) : r * (q + 1) + (xcd - r) * q) + off; }
        const int nig = WGM * nN, gid = wgid / nig, fm = gid * WGM, gsz = (nM - fm) < WGM ? (nM - fm) : WGM;
        u.pm = fm + ((wgid % nig) % gsz); u.pn = (wgid % nig) / gsz; return true;
    }
};

template <class Epi>
__device__ __forceinline__ void gemm_phase(LAS unsigned char* lds, const Gemm g, const StaticOrder& S, const Epi& E, int wid_s, unsigned long long* tacc = nullptr) {
    int tid = wid_s * 64 + lane_id(); asm volatile("" : "+v"(tid));
    const int wid = __builtin_amdgcn_readfirstlane(tid >> 6), lane = tid & 63, wr = wid >> 2, wc = wid & 3, fr = lane & 15, fq = lane >> 4;
    int K = g.K; asm volatile("" : "+s"(K));
    const int nt = K / BK;
    unsigned voffA[2], voffB[2];
#pragma unroll
    for (int i = 0; i < 2; ++i) { int R, C; stage_rc(tid * 16 + i * 8192, R, C); const int Rb = Epi::PERM ? ((R & ~31) + perm32(R & 31)) : R;
        voffA[i] = (unsigned)(R * g.lda + C) * 2u; voffB[i] = (unsigned)(Rb * K + C) * 2u; }
    const size_t kstep = (size_t)(BK * 2);
    const size_t hstepA = (size_t)HALF * g.lda * 2, hstepB = (size_t)HALF * K * 2;
    const size_t tstepA = 2 * hstepA, tstepB = 2 * hstepB;
    const unsigned ldsw = (unsigned)wid * 1024u;
    const int aoff = lds_byte(wr * 64 + fr, fq * 8), boff = lds_byte(wc * 32 + fr, fq * 8);
#define PG8_SA(b, h) (((b) * 2 + (h)) * HTB)
#define PG8_SB(b, h) ((4 + (b) * 2 + (h)) * HTB)
#define PG8_STAGE(bufoff, gbase, voff) do { _Pragma("unroll") for (int _i = 0; _i < 2; ++_i) \
        __builtin_amdgcn_global_load_lds((const unsigned*)((const char*)(gbase) + (voff)[_i]), (LAS unsigned*)(lds + (bufoff) + ldsw + _i * 8192), 16, 0, 0); } while (0)
#define PG8_LDA(dst, b, h) do { _Pragma("unroll") for (int m = 0; m < 4; ++m) _Pragma("unroll") for (int k = 0; k < 2; ++k) dst[m][k] = *(const LAS bf16x8*)(lds + PG8_SA(b, h) + aoff + m * 2048 + k * 1024); } while (0)
#define PG8_LDB(dst, b, h) do { _Pragma("unroll") for (int n = 0; n < 2; ++n) _Pragma("unroll") for (int k = 0; k < 2; ++k) dst[n][k] = *(const LAS bf16x8*)(lds + PG8_SB(b, h) + boff + n * 2048 + k * 1024); } while (0)
#define PG8_MMA(ai, bj, At, Bt) do { __builtin_amdgcn_s_setprio(1); _Pragma("unroll") for (int m = 0; m < 4; ++m) _Pragma("unroll") for (int n = 0; n < 2; ++n) _Pragma("unroll") for (int k = 0; k < 2; ++k) \
        acc[ai][bj][m][n] = __builtin_amdgcn_mfma_f32_16x16x32_bf16(Bt[n][k], At[m][k], acc[ai][bj][m][n], 0, 0, 0); __builtin_amdgcn_s_setprio(0); } while (0)
#define PG8_WAIT_V(n) asm volatile("s_waitcnt vmcnt(" #n ")" ::: "memory")
#define PG8_WAIT_L(n) asm volatile("s_waitcnt lgkmcnt(" #n ")" ::: "memory")
#define PG8_BAR __builtin_amdgcn_s_barrier()
#define PG8_SCHED __builtin_amdgcn_sched_barrier(0)
    Unit cur, nxt; int ui = 0;
    if (!S.next(0, cur)) return;
    f32x4 acc[2][2][4][2];
#pragma unroll
    for (int a = 0; a < 2; ++a)
#pragma unroll
        for (int b = 0; b < 2; ++b)
#pragma unroll
            for (int m = 0; m < 4; ++m)
#pragma unroll
                for (int n = 0; n < 2; ++n) acc[a][b][m][n] = (f32x4){0.f, 0.f, 0.f, 0.f};
    bf16x8 At[4][2], B0[2][2], B1[2][2];
    const char* cA = (const char*)g.A + (size_t)cur.pm * tstepA; const char* cB = (const char*)g.Bt + (size_t)cur.pn * tstepB;
    PG8_STAGE(PG8_SB(0, 0), cB, voffB); PG8_STAGE(PG8_SA(0, 0), cA, voffA); PG8_STAGE(PG8_SB(0, 1), cB + hstepB, voffB); PG8_STAGE(PG8_SA(0, 1), cA + hstepA, voffA);
    if (wr == 1) PG8_BAR;
    PG8_WAIT_V(4); PG8_BAR;
    PG8_STAGE(PG8_SB(1, 0), cB + kstep, voffB); PG8_STAGE(PG8_SA(1, 0), cA + kstep, voffA); PG8_STAGE(PG8_SB(1, 1), cB + hstepB + kstep, voffB);
    PG8_WAIT_V(6); PG8_BAR;
    for (;;) {
        const bool has_next = S.next(ui + 1, nxt);
        const char* nA = has_next ? (const char*)g.A + (size_t)nxt.pm * tstepA : cA; const char* nB = has_next ? (const char*)g.Bt + (size_t)nxt.pn * tstepB : cB;
#if PROBE_SEL >= 9
        const unsigned long long k0_ = __builtin_amdgcn_s_memrealtime();
#endif
        for (int t = 0; t < nt; t += 2) {
            const bool last = (t == nt - 2);
            const char* a1 = cA + (size_t)(t + 1) * kstep;
            const char* a2 = last ? nA : cA + (size_t)(t + 2) * kstep; const char* b2 = last ? nB : cB + (size_t)(t + 2) * kstep;
            const char* a3 = a2 + kstep; const char* b3 = b2 + kstep;
            PG8_LDB(B0, 0, 0); PG8_SCHED; PG8_LDA(At, 0, 0); PG8_STAGE(PG8_SA(1, 1), a1 + hstepA, voffA);
            PG8_WAIT_L(8); PG8_BAR; PG8_WAIT_L(0); PG8_MMA(0, 0, At, B0); PG8_BAR; PG8_SCHED;
            PG8_LDB(B1, 0, 1); PG8_STAGE(PG8_SB(0, 0), b2, voffB);
            PG8_BAR; PG8_WAIT_L(0); PG8_MMA(0, 1, At, B1); PG8_BAR;
            PG8_LDA(At, 0, 1); PG8_STAGE(PG8_SA(0, 0), a2, voffA);
            PG8_BAR; PG8_WAIT_L(0); PG8_MMA(1, 0, At, B0); PG8_BAR; PG8_SCHED;
            PG8_STAGE(PG8_SB(0, 1), b2 + hstepB, voffB);
            PG8_WAIT_V(6); PG8_BAR; PG8_MMA(1, 1, At, B1); PG8_BAR;
            PG8_LDB(B0, 1, 0); PG8_SCHED; PG8_LDA(At, 1, 0); PG8_STAGE(PG8_SA(0, 1), a2 + hstepA, voffA);
            PG8_WAIT_L(8); PG8_BAR; PG8_WAIT_L(0); PG8_MMA(0, 0, At, B0); PG8_BAR; PG8_SCHED;
            PG8_LDB(B1, 1, 1); PG8_STAGE(PG8_SB(1, 0), b3, voffB);
            PG8_BAR; PG8_WAIT_L(0); PG8_MMA(0, 1, At, B1); PG8_BAR;
            PG8_LDA(At, 1, 1); PG8_STAGE(PG8_SA(1, 0), a3, voffA);
            PG8_BAR; PG8_WAIT_L(0); PG8_MMA(1, 0, At, B0); PG8_BAR; PG8_SCHED;
            PG8_STAGE(PG8_SB(1, 1), b3 + hstepB, voffB);
            PG8_WAIT_V(6); PG8_BAR; PG8_MMA(1, 1, At, B1); PG8_BAR;
        }
#if PROBE_SEL >= 9
        const unsigned long long e0_ = __builtin_amdgcn_s_memrealtime();
        if (Epi::PROBE_ID + 100 == PROBE_SEL) *tacc += e0_ - k0_;
#endif
        E(acc, cur, wr, wc, fr, fq);
#if PROBE_SEL >= 9
        if (Epi::PROBE_ID == PROBE_SEL) *tacc += __builtin_amdgcn_s_memrealtime() - e0_;
#endif
        if (!has_next) break;
#pragma unroll
        for (int a = 0; a < 2; ++a)
#pragma unroll
            for (int b = 0; b < 2; ++b)
#pragma unroll
                for (int m = 0; m < 4; ++m)
#pragma unroll
                    for (int n = 0; n < 2; ++n) acc[a][b][m][n] = (f32x4){0.f, 0.f, 0.f, 0.f};
        cur = nxt; cA = nA; cB = nB; ++ui;
    }
    PG8_WAIT_V(0);
    if (wr == 0) PG8_BAR;
    PG8_BAR;
#undef PG8_SA
#undef PG8_SB
#undef PG8_STAGE
#undef PG8_LDA
#undef PG8_LDB
#undef PG8_MMA
#undef PG8_WAIT_V
#undef PG8_WAIT_L
#undef PG8_BAR
#undef PG8_SCHED
}
}
using pg8::Unit;
typedef f32x4 AccT[2][2][4][2];

#define EPI_BAR() do { asm volatile("s_waitcnt lgkmcnt(0)" ::: "memory"); __builtin_amdgcn_s_barrier(); asm volatile("" ::: "memory"); } while (0)
__device__ __forceinline__ float sq4(const f32x4 v) { return (v[0] * v[0] + v[1] * v[1]) + (v[2] * v[2] + v[3] * v[3]); }
__device__ __forceinline__ float red_fq(float s) { s += __shfl_xor(s, 16); s += __shfl_xor(s, 32); return s; }
__device__ __forceinline__ u32x4 pack8(const f32x4 a, const f32x4 b) { u32x4 w; w.x = cvt_pk_bf16(a[0], a[1]); w.y = cvt_pk_bf16(a[2], a[3]); w.z = cvt_pk_bf16(b[0], b[1]); w.w = cvt_pk_bf16(b[2], b[3]); return w; }

struct EpiProj {
    static constexpr int PROBE_ID = 10;
    static constexpr bool PERM = true;
    bf16_t* PROJ; const float* ssh; float *ss_cq, *ss_kr;
    const float *gt, *g_kr; const float2* tab; LAS float* TABL;
    __device__ __forceinline__ void operator()(AccT& acc, const Unit& u, int wr, int wc, int fr, int fq) const {
        { int ln_ = lane_id(); asm volatile("" : "+v"(ln_)); fr = ln_ & 15; fq = ln_ >> 4; }
        const int lrow0 = wr * 64 + fr, row0 = u.pm * 256 + lrow0, pn = u.pn;
        float rs[2][4];
#pragma unroll
        for (int ai = 0; ai < 2; ++ai)
#pragma unroll
            for (int m = 0; m < 4; ++m) rs[ai][m] = __builtin_amdgcn_rsqf(ssh[row0 + ai * 128 + m * 16] * (1.0f / 2048.0f) + 1e-6f);
        bf16_t* const outp = PROJ + (size_t)row0 * NP + pn * 256 + wc * 32 + 8 * fq;
        const bool is_norm = (pn <= 3) || (pn >= 9 && pn <= 12);
        if (is_norm) {
            const float* g = gt + ((pn <= 2) ? 0 : (pn == 3) ? 128 : (pn <= 10) ? 256 : 384);
            const float qs = (pn <= 2 || pn == 9 || pn == 10) ? QS_A : 1.0f;
#pragma unroll
            for (int ai = 0; ai < 2; ++ai)
#pragma unroll
                for (int m = 0; m < 4; ++m)
#pragma unroll
                    for (int bj = 0; bj < 2; ++bj) { float s = red_fq(sq4(acc[ai][bj][m][0]) + sq4(acc[ai][bj][m][1]));
                        if (fq == 0) TABL[((lrow0 + ai * 128 + m * 16) * 2 + bj) * 4 + wc] = s; asm volatile("" ::: "memory"); }
            EPI_BAR();
            const f32x4 g0 = *(const f32x4*)(g + 32 * wc + 8 * fq) * qs, g1 = *(const f32x4*)(g + 32 * wc + 8 * fq + 4) * qs;
#pragma unroll
            for (int ai = 0; ai < 2; ++ai)
#pragma unroll
                for (int m = 0; m < 4; ++m)
#pragma unroll
                    for (int bj = 0; bj < 2; ++bj) { const f32x4 t = *(const LAS f32x4*)&TABL[((lrow0 + ai * 128 + m * 16) * 2 + bj) * 4];
                        const float r2 = rs[ai][m] * rs[ai][m];
                        const float rn = rs[ai][m] * __builtin_amdgcn_rsqf(((t[0] + t[1]) + (t[2] + t[3])) * r2 * (1.0f / 128.0f) + 1e-6f);
                        *(u32x4*)(outp + (size_t)(ai * 128 + m * 16) * NP + bj * 128) = pack8(acc[ai][bj][m][0] * rn * g0, acc[ai][bj][m][1] * rn * g1);
                        asm volatile("" ::: "memory"); }
        } else if (pn >= 5 && pn <= 8) {
            float* ss = ss_cq + ((pn <= 6) ? 0 : 4 * TTOT);
#pragma unroll
            for (int ai = 0; ai < 2; ++ai)
#pragma unroll
                for (int m = 0; m < 4; ++m) { const float r = rs[ai][m];
                    float s = red_fq((sq4(acc[ai][0][m][0]) + sq4(acc[ai][0][m][1])) + (sq4(acc[ai][1][m][0]) + sq4(acc[ai][1][m][1]))) * (r * r);
                    if (fq == 0) unsafeAtomicAdd(ss + row0 + ai * 128 + m * 16, s);
#pragma unroll
                    for (int bj = 0; bj < 2; ++bj) *(u32x4*)(outp + (size_t)(ai * 128 + m * 16) * NP + bj * 128) = pack8(acc[ai][bj][m][0] * r, acc[ai][bj][m][1] * r);
                    asm volatile("" ::: "memory"); }
        } else if (pn >= 15 && pn <= 22) {
#pragma unroll
            for (int ai = 0; ai < 2; ++ai)
#pragma unroll
                for (int m = 0; m < 4; ++m) { const float r = rs[ai][m];
#pragma unroll
                    for (int bj = 0; bj < 2; ++bj) { f32x4 o0, o1;
#pragma unroll
                        for (int j = 0; j < 4; ++j) { const float v0 = acc[ai][bj][m][0][j] * r, v1 = acc[ai][bj][m][1][j] * r;
                            o0[j] = v0 * __builtin_amdgcn_rcpf(1.0f + __expf(-v0)); o1[j] = v1 * __builtin_amdgcn_rcpf(1.0f + __expf(-v1)); }
                        *(u32x4*)(outp + (size_t)(ai * 128 + m * 16) * NP + bj * 128) = pack8(o0, o1); }
                    asm volatile("" ::: "memory"); }
        } else if (pn == 23) {
            if (wc < 2) {
                const int gI = wc * 4 + fq;
                const f32x4 gk1 = *(const f32x4*)(g_kr + 4 * gI), gk2 = *(const f32x4*)(g_kr + 32 + 4 * gI);
#pragma unroll
                for (int ai = 0; ai < 2; ++ai)
#pragma unroll
                    for (int m = 0; m < 4; ++m) { const int row = row0 + ai * 128 + m * 16; const float r = rs[ai][m];
                        float s = red_fq(sq4(acc[ai][0][m][0]) + sq4(acc[ai][0][m][1])) * (r * r);
                        if (fq == 0) unsafeAtomicAdd(ss_kr + row, s);
                        const f32x4 x1 = acc[ai][0][m][0] * gk1 * r, x2 = acc[ai][0][m][1] * gk2 * r; f32x4 o1, o2;
                        const float2* tp = tab + (row & (SEQ - 1)) * 32 + 4 * gI;
#pragma unroll
                        for (int j = 0; j < 4; ++j) { const float2 cs = tp[j]; o1[j] = x1[j] * cs.x - x2[j] * cs.y; o2[j] = x1[j] * cs.y + x2[j] * cs.x; }
                        *(u32x4*)(PROJ + (size_t)row * NP + C_KR + 8 * gI) = pack8(o1, o2); asm volatile("" ::: "memory"); }
            }
        } else {
#pragma unroll
            for (int ai = 0; ai < 2; ++ai)
#pragma unroll
                for (int m = 0; m < 4; ++m) { const float r = rs[ai][m];
#pragma unroll
                    for (int bj = 0; bj < 2; ++bj) *(u32x4*)(outp + (size_t)(ai * 128 + m * 16) * NP + bj * 128) = pack8(acc[ai][bj][m][0] * r, acc[ai][bj][m][1] * r);
                    asm volatile("" ::: "memory"); }
        }
    }
};

struct EpiUQ {
    static constexpr int PROBE_ID = 12;
    static constexpr bool PERM = true;
    bf16_t* QB; const float* ss_cq; const float* gq; const float2* tab; LAS float* TABL;
    __device__ __forceinline__ void operator()(AccT& acc, const Unit& u, int wr, int wc, int fr, int fq) const {
        { int ln_ = lane_id(); asm volatile("" : "+v"(ln_)); fr = ln_ & 15; fq = ln_ >> 4; }
        const int lrow0 = wr * 64 + fr, row0 = u.pm * 256 + lrow0, h = u.pn;
        float rs[2][4];
#pragma unroll
        for (int ai = 0; ai < 2; ++ai)
#pragma unroll
            for (int m = 0; m < 4; ++m) rs[ai][m] = ss_cq[row0 + ai * 128 + m * 16];
#pragma unroll
        for (int ai = 0; ai < 2; ++ai)
#pragma unroll
            for (int m = 0; m < 4; ++m) { const float r = __builtin_amdgcn_rsqf(rs[ai][m] * (1.0f / 512.0f) + 1e-6f); rs[ai][m] = r;
#pragma unroll
                for (int bj = 0; bj < 2; ++bj) { float s = red_fq(sq4(acc[ai][bj][m][0]) + sq4(acc[ai][bj][m][1])) * (r * r);
                    if (fq == 0) TABL[((lrow0 + ai * 128 + m * 16) * 2 + bj) * 4 + wc] = s; } }
        EPI_BAR();
        const int gI = (wc & 1) * 4 + fq;
        const f32x4 g00 = *(const f32x4*)(gq + 32 * wc + 8 * fq), g01 = *(const f32x4*)(gq + 32 * wc + 8 * fq + 4);
        const f32x4 g10 = *(const f32x4*)(gq + 128 + 4 * gI), g11 = *(const f32x4*)(gq + 160 + 4 * gI);
#pragma unroll
        for (int ai = 0; ai < 2; ++ai) {
            float2 cs[4][4];
            if (wc < 2) {
#pragma unroll
                for (int m = 0; m < 4; ++m) { const float2* tp = tab + ((u.pm * 256 + lrow0 + ai * 128 + m * 16) & (SEQ - 1)) * 32 + 4 * gI;
#pragma unroll
                    for (int j = 0; j < 4; ++j) cs[m][j] = tp[j]; }
            }
#pragma unroll
            for (int m = 0; m < 4; ++m) { const int lrow = lrow0 + ai * 128 + m * 16, row = u.pm * 256 + lrow;
                const f32x4 t0 = *(const LAS f32x4*)&TABL[lrow * 8], t1 = *(const LAS f32x4*)&TABL[lrow * 8 + 4];
                const float rq = rs[ai][m] * QS_B * __builtin_amdgcn_rsqf((((t0[0] + t0[1]) + (t0[2] + t0[3])) + ((t1[0] + t1[1]) + (t1[2] + t1[3]))) * (1.0f / 192.0f) + 1e-6f);
                bf16_t* rowp = QB + (size_t)row * 1152 + h * 192 + 32 * wc + 8 * fq;
                *(u32x4*)rowp = pack8(acc[ai][0][m][0] * rq * g00, acc[ai][0][m][1] * rq * g01);
                if (wc < 2) {
                    const f32x4 x1 = acc[ai][1][m][0] * rq * g10, x2 = acc[ai][1][m][1] * rq * g11; f32x4 o1, o2;
#pragma unroll
                    for (int j = 0; j < 4; ++j) { o1[j] = x1[j] * cs[m][j].x - x2[j] * cs[m][j].y; o2[j] = x1[j] * cs[m][j].y + x2[j] * cs[m][j].x; }
                    *(u32x4*)(rowp + 128) = pack8(o1, o2);
                } }
            asm volatile("" ::: "memory");
        }
    }
};

struct EpiUKV {
    static constexpr int PROBE_ID = 13;
    static constexpr bool PERM = true;
    bf16_t *KB, *VB; const bf16_t* PROJ; const float *ss_ckv, *ss_kr; const float* gk; LAS float* TABL;
    __device__ __forceinline__ void operator()(AccT& acc, const Unit& u, int wr, int wc, int fr, int fq) const {
        { int ln_ = lane_id(); asm volatile("" : "+v"(ln_)); fr = ln_ & 15; fq = ln_ >> 4; }
        const int lrow0 = wr * 64 + fr, row0 = u.pm * 256 + lrow0, h = u.pn;
        const int i4 = (wc * 4 + fq) * 4;
        float rs[2][4], skr[2][4]; u32x2 rr[2][4];
#pragma unroll
        for (int ai = 0; ai < 2; ++ai)
#pragma unroll
            for (int m = 0; m < 4; ++m) { const int row = row0 + ai * 128 + m * 16; rs[ai][m] = ss_ckv[row]; skr[ai][m] = ss_kr[row]; rr[ai][m] = *(const u32x2*)(PROJ + (size_t)row * NP + C_KR + i4); }
#pragma unroll
        for (int ai = 0; ai < 2; ++ai)
#pragma unroll
            for (int m = 0; m < 4; ++m) { const float r = __builtin_amdgcn_rsqf(rs[ai][m] * (1.0f / 512.0f) + 1e-6f); rs[ai][m] = r;
                float s = red_fq(sq4(acc[ai][0][m][0]) + sq4(acc[ai][0][m][1])) * (r * r);
                if (fq == 0) TABL[(lrow0 + ai * 128 + m * 16) * 4 + wc] = s; }
        EPI_BAR();
        const f32x4 g0 = *(const f32x4*)(gk + 32 * wc + 8 * fq), g1 = *(const f32x4*)(gk + 32 * wc + 8 * fq + 4);
#pragma unroll
        for (int ai = 0; ai < 2; ++ai)
#pragma unroll
            for (int m = 0; m < 4; ++m) { const int lrow = lrow0 + ai * 128 + m * 16, row = u.pm * 256 + lrow; const float r = rs[ai][m];
                const f32x4 t = *(const LAS f32x4*)&TABL[lrow * 4];
                const float rk = __builtin_amdgcn_rsqf((((t[0] + t[1]) + (t[2] + t[3])) + skr[ai][m]) * (1.0f / 192.0f) + 1e-6f);
                bf16_t* kp = KB + (size_t)row * 1152 + h * 192;
                *(u32x4*)(kp + 32 * wc + 8 * fq) = pack8(acc[ai][0][m][0] * (r * rk) * g0, acc[ai][0][m][1] * (r * rk) * g1);
                *(u32x4*)(VB + (size_t)row * 768 + h * 128 + 32 * wc + 8 * fq) = pack8(acc[ai][1][m][0] * r, acc[ai][1][m][1] * r);
                const u32x2 q = rr[ai][m]; u32x2 o; o.x = cvt_pk_bf16(bflo(q.x) * rk, bfhi(q.x) * rk); o.y = cvt_pk_bf16(bflo(q.y) * rk, bfhi(q.y) * rk);
                *(u32x2*)(kp + 128 + i4) = o; }
    }
};

struct EpiOut {
    static constexpr int PROBE_ID = 11;
    static constexpr bool PERM = false;
    const float* hin; long hdelta; float* hout; bf16_t* hbA; float* ss_h2;
    __device__ __forceinline__ void operator()(AccT& acc, const Unit& u, int wr, int wc, int fr, int fq) const {
        { int ln_ = lane_id(); asm volatile("" : "+v"(ln_)); fr = ln_ & 15; fq = ln_ >> 4; }
        const int row0 = u.pm * 256 + wr * 64 + fr, col0 = u.pn * 256 + wc * 32 + 4 * fq;
#pragma unroll
        for (int ai = 0; ai < 2; ++ai)
#pragma unroll
            for (int mp = 0; mp < 2; ++mp) {
                f32x4 hv[2][2][2];
#pragma unroll
                for (int mm = 0; mm < 2; ++mm)
#pragma unroll
                    for (int bj = 0; bj < 2; ++bj)
#pragma unroll
                        for (int n = 0; n < 2; ++n) hv[mm][bj][n] = *(const f32x4*)(hin + (u.pm >= 32 ? hdelta : 0) + (size_t)(row0 + ai * 128 + (mp * 2 + mm) * 16) * DM + col0 + bj * 128 + n * 16);
#pragma unroll
                for (int mm = 0; mm < 2; ++mm) { const int m = mp * 2 + mm, row = row0 + ai * 128 + m * 16; const size_t off = (size_t)row * DM + col0; float s = 0.f;
#pragma unroll
                    for (int bj = 0; bj < 2; ++bj)
#pragma unroll
                        for (int n = 0; n < 2; ++n) { const f32x4 o = hv[mm][bj][n] + acc[ai][bj][m][n];
                            *(f32x4*)(hout + off + bj * 128 + n * 16) = o; u32x2 w; w.x = cvt_pk_bf16(o[0], o[1]); w.y = cvt_pk_bf16(o[2], o[3]);
                            *(u32x2*)(hbA + off + bj * 128 + n * 16) = w; s += sq4(o); }
                    s = red_fq(s); if (fq == 0) unsafeAtomicAdd(ss_h2 + row, s); }
            }
    }
};
struct EpiPP {
    static constexpr int PROBE_ID = 14;
    static constexpr bool PERM = true;
    bf16_t* PROJ; float* ss_pp; const float* g_post;
    __device__ __forceinline__ void operator()(AccT& acc, const Unit& u, int wr, int wc, int fr, int fq) const {
        { int ln_ = lane_id(); asm volatile("" : "+v"(ln_)); fr = ln_ & 15; fq = ln_ >> 4; }
        const int row0 = u.pm * 256 + wr * 64 + fr, colb = u.pn * 256 + wc * 32 + 8 * fq;
        f32x4 g[2][2];
#pragma unroll
        for (int bj = 0; bj < 2; ++bj) { g[bj][0] = *(const f32x4*)(g_post + colb + bj * 128); g[bj][1] = *(const f32x4*)(g_post + colb + bj * 128 + 4); }
#pragma unroll
        for (int ai = 0; ai < 2; ++ai)
#pragma unroll
            for (int m = 0; m < 4; ++m) { const int row = row0 + ai * 128 + m * 16; bf16_t* rowp = PROJ + (size_t)row * NP + colb; float s = 0.f;
#pragma unroll
                for (int bj = 0; bj < 2; ++bj) { *(u32x4*)(rowp + bj * 128) = pack8(acc[ai][bj][m][0] * g[bj][0], acc[ai][bj][m][1] * g[bj][1]); s += sq4(acc[ai][bj][m][0]) + sq4(acc[ai][bj][m][1]); }
                s = red_fq(s); if (fq == 0) unsafeAtomicAdd(ss_pp + row, s); }
    }
};
struct EpiGate {
    static constexpr int PROBE_ID = 9;
    static constexpr bool PERM = false;
    float* h; bf16_t* hbB; const bf16_t* PROJ; const float *ss_h2, *ss_pp; float* ss_next;
    __device__ __forceinline__ void operator()(AccT& acc, const Unit& u, int wr, int wc, int fr, int fq) const {
        { int ln_ = lane_id(); asm volatile("" : "+v"(ln_)); fr = ln_ & 15; fq = ln_ >> 4; }
        const int row0 = u.pm * 256 + wr * 64 + fr, col0 = u.pn * 256 + wc * 32 + 4 * fq;
        float rs2[2][4], rpp[2][4];
#pragma unroll
        for (int ai = 0; ai < 2; ++ai)
#pragma unroll
            for (int m = 0; m < 4; ++m) { rs2[ai][m] = ss_h2[row0 + ai * 128 + m * 16]; rpp[ai][m] = ss_pp[row0 + ai * 128 + m * 16]; }
#pragma unroll
        for (int ai = 0; ai < 2; ++ai)
#pragma unroll
            for (int mp = 0; mp < 2; ++mp) {
                f32x4 hv[2][2][2]; u32x2 pw[2][2][2];
#pragma unroll
                for (int mm = 0; mm < 2; ++mm)
#pragma unroll
                    for (int bj = 0; bj < 2; ++bj)
#pragma unroll
                        for (int n = 0; n < 2; ++n) { const int row = row0 + ai * 128 + (mp * 2 + mm) * 16, c = col0 + bj * 128 + n * 16;
                            hv[mm][bj][n] = *(const f32x4*)(h + (size_t)row * DM + c); pw[mm][bj][n] = *(const u32x2*)(PROJ + (size_t)row * NP + c); }
#pragma unroll
                for (int mm = 0; mm < 2; ++mm) { const int m = mp * 2 + mm, row = row0 + ai * 128 + m * 16; const size_t off = (size_t)row * DM + col0;
                    const float r2 = __builtin_amdgcn_rsqf(rs2[ai][m] * (1.0f / 2048.0f) + 1e-6f), rp = __builtin_amdgcn_rsqf(rpp[ai][m] * (1.0f / 2048.0f) + 1e-6f); float s = 0.f;
#pragma unroll
                    for (int bj = 0; bj < 2; ++bj)
#pragma unroll
                        for (int n = 0; n < 2; ++n) { const u32x2 pq = pw[mm][bj][n]; const f32x4 pp = {bflo(pq.x), bfhi(pq.x), bflo(pq.y), bfhi(pq.y)}; f32x4 o;
#pragma unroll
                            for (int j = 0; j < 4; ++j) { const float gate = __builtin_amdgcn_rcpf(1.0f + __expf(-r2 * acc[ai][bj][m][n][j])); o[j] = hv[mm][bj][n][j] + gate * (pp[j] * rp); }
                            *(f32x4*)(h + off + bj * 128 + n * 16) = o; u32x2 w; w.x = cvt_pk_bf16(o[0], o[1]); w.y = cvt_pk_bf16(o[2], o[3]);
                            *(u32x2*)(hbB + off + bj * 128 + n * 16) = w; s += sq4(o); }
                    if (ss_next) { s = red_fq(s); if (fq == 0) unsafeAtomicAdd(ss_next + row, s); } }
            }
    }
};

template <int MODE> __device__ __forceinline__ int srccol(int n) {
    if (MODE == 0) return n;
    if (MODE == 1) {
        if (n < 768) return O_AQ + n;
        if (n < 1024) return O_AK + (n - 768);
        if (n < 1280) return O_AV + (n - 1024);
        if (n < 1792) return O_BCQ + (n - 1280);
        if (n < 2304) return O_BCKV + (n - 1792);
        if (n < 2816) return O_CQ + (n - 2304);
        if (n < 3328) return O_CK + (n - 2816);
        if (n < 3840) return O_CV + (n - 3328);
        if (n < 4608) return O_AZ + (n - 3840);
        if (n < 5376) return O_BZ + (n - 4608);
        if (n < 5888) return O_CZ + (n - 5376);
        if (n < 5952) { const int i = n - 5888, g = i >> 3, e = i & 7; return O_BKR + (e < 4 ? 4 * g + e : 32 + 4 * g + (e - 4)); }
        return -1;
    }
    const int hh = n >> 8, c = n & 255;
    if (c < 128) return hh * 192 + c;
    if (c < 192) { const int i = c - 128, g = i >> 3, e = i & 7; return hh * 192 + 128 + (e < 4 ? 4 * g + e : 32 + 4 * g + (e - 4)); }
    return -1;
}
template <int MODE> __device__ __forceinline__ void cvt_tile(const float* src, int ldsrc, int K, const float* gain, bf16_t* dst, float* tile, int tn, int tk, int tid) {
    const int n0 = tn * 256, k0 = tk * 64;
#pragma unroll
    for (int i = 0; i < 8; ++i) { const int idx = tid + i * 512, kk = idx >> 6, ng = (idx & 63) * 4; const int sc = srccol<MODE>(n0 + ng);
        f32x4 v = {0.f, 0.f, 0.f, 0.f}; if (sc >= 0) v = *(const f32x4*)(src + (size_t)(k0 + kk) * ldsrc + sc); if (gain) v *= gain[k0 + kk];
        float* tp = tile + kk * 257 + ng; tp[0] = v[0]; tp[1] = v[1]; tp[2] = v[2]; tp[3] = v[3]; }
    __syncthreads();
#pragma unroll
    for (int i = 0; i < 16; ++i) { const int idx = tid + i * 512, nn = idx >> 5, kp = (idx & 31) * 2;
        *(unsigned*)(dst + (size_t)(n0 + nn) * K + k0 + kp) = cvt_pk_bf16(tile[kp * 257 + nn], tile[(kp + 1) * 257 + nn]); }
    __syncthreads();
}

namespace at {
typedef float f32x16 __attribute__((ext_vector_type(16)));
typedef short s16x4 __attribute__((ext_vector_type(4)));
#define AT_SBAR() __builtin_amdgcn_sched_barrier(0)
constexpr int KVBLK = 64;
constexpr float THR = 8.f, NEGINF = -__builtin_huge_valf();
constexpr int OFF_V = 0, OFF_K = 32768, OFF_WS = 32768 + 51200, OFF_TB = OFF_WS + 2048, TB_PITCH = 160, OFF_SLOT = OFF_TB + 9600, OFF_QR = 95744;
__device__ __forceinline__ int crow(int r, int hi) { return (r & 3) + 8 * (r >> 2) + 4 * hi; }
constexpr int creg(int r) { return (r & 3) + 8 * (r >> 2); }
__device__ __forceinline__ int v_st(int k, int c) { const int kk = (k & ~0xC) | ((k & 4) << 1) | ((k & 8) >> 1); return ((kk >> 3) * 4 + (c >> 5)) * 512 + ((kk & 7) * 32 + (c & 31)) * 2; }
__device__ __forceinline__ int v_rd_base(int lane) { return ((lane & 3) << 3) | (((lane >> 2) & 3) << 6) | (((lane >> 4) & 1) << 5) | (((lane >> 5) & 1) << 8); }
constexpr int v_rd_off(int d0, int ks, int half) { return d0 * 512 + ks * 4096 + half * 2048; }
template <int OFF> __device__ __forceinline__ s16x4 tr_read(int vb) { s16x4 r; asm volatile("ds_read_b64_tr_b16 %0, %1 offset:%2" : "=&v"(r) : "v"(vb), "i"(OFF) : "memory"); return r; }
template <int D0> __device__ __forceinline__ void pv_one(f32x16& od, int vb, bf16x8 pa0, bf16x8 pa1, bf16x8 pa2, bf16x8 pa3) {
    const s16x4 l0 = tr_read<v_rd_off(D0, 0, 0)>(vb), h0 = tr_read<v_rd_off(D0, 0, 1)>(vb), l1 = tr_read<v_rd_off(D0, 1, 0)>(vb), h1 = tr_read<v_rd_off(D0, 1, 1)>(vb);
    const s16x4 l2 = tr_read<v_rd_off(D0, 2, 0)>(vb), h2 = tr_read<v_rd_off(D0, 2, 1)>(vb), l3 = tr_read<v_rd_off(D0, 3, 0)>(vb), h3 = tr_read<v_rd_off(D0, 3, 1)>(vb);
    asm volatile("s_waitcnt lgkmcnt(0)" ::: "memory"); AT_SBAR();
#define AT_PK(L, H) (bf16x8){L[0], L[1], L[2], L[3], H[0], H[1], H[2], H[3]}
    od = __builtin_amdgcn_mfma_f32_32x32x16_bf16(pa0, AT_PK(l0, h0), od, 0, 0, 0);
    od = __builtin_amdgcn_mfma_f32_32x32x16_bf16(pa1, AT_PK(l1, h1), od, 0, 0, 0);
    od = __builtin_amdgcn_mfma_f32_32x32x16_bf16(pa2, AT_PK(l2, h2), od, 0, 0, 0);
    od = __builtin_amdgcn_mfma_f32_32x32x16_bf16(pa3, AT_PK(l3, h3), od, 0, 0, 0);
#undef AT_PK
}
__device__ __forceinline__ void pv_d0(f32x16* o, int vb, bf16x8 pa0, bf16x8 pa1, bf16x8 pa2, bf16x8 pa3) {
    pv_one<0>(o[0], vb, pa0, pa1, pa2, pa3); pv_one<1>(o[1], vb, pa0, pa1, pa2, pa3); pv_one<2>(o[2], vb, pa0, pa1, pa2, pa3); pv_one<3>(o[3], vb, pa0, pa1, pa2, pa3);
}
__device__ __forceinline__ void partialSM(f32x16& p0, f32x16& p1, float& m_reg, float& mn, float& alpha) {
    float pmax = p0[0];
#pragma unroll
    for (int r = 1; r < 16; ++r) pmax = fmaxf(pmax, p0[r]);
#pragma unroll
    for (int r = 0; r < 16; ++r) pmax = fmaxf(pmax, p1[r]);
    { auto rr = __builtin_amdgcn_permlane32_swap(__float_as_uint(pmax), __float_as_uint(pmax), false, false); pmax = fmaxf(__uint_as_float(rr[0]), __uint_as_float(rr[1])); }
    if (__builtin_expect(__all(pmax - m_reg <= THR), 1)) { mn = m_reg; alpha = 1.f; }
    else { mn = fmaxf(m_reg, pmax); alpha = __builtin_amdgcn_exp2f(m_reg - mn); m_reg = mn; }
#pragma unroll
    for (int r = 0; r < 16; ++r) { p0[r] -= mn; p1[r] -= mn; }
#pragma unroll
    for (int r = 0; r < 16; ++r) p0[r] = __builtin_amdgcn_exp2f(p0[r]);
}
__device__ __forceinline__ void finishSM(f32x16& p0, f32x16& p1, float alpha, float& l_reg, bf16x8& pa0, bf16x8& pa1, bf16x8& pa2, bf16x8& pa3) {
#pragma unroll
    for (int r = 0; r < 16; ++r) p1[r] = __builtin_amdgcn_exp2f(p1[r]);
    float ps = 0;
#pragma unroll
    for (int r = 0; r < 16; ++r) ps += p0[r];
#pragma unroll
    for (int r = 0; r < 16; ++r) ps += p1[r];
    { auto rr = __builtin_amdgcn_permlane32_swap(__float_as_uint(ps), __float_as_uint(ps), false, false); ps = __uint_as_float(rr[0]) + __uint_as_float(rr[1]); }
    l_reg = l_reg * alpha + ps;
#define AT_PK4(P, BASE, OUT) do { unsigned a0 = cvt_pk_bf16(P[BASE + 0], P[BASE + 1]), a1 = cvt_pk_bf16(P[BASE + 2], P[BASE + 3]); \
        unsigned b0 = cvt_pk_bf16(P[BASE + 4], P[BASE + 5]), b1 = cvt_pk_bf16(P[BASE + 6], P[BASE + 7]); \
        auto r0 = __builtin_amdgcn_permlane32_swap(a0, b0, false, false); auto r1 = __builtin_amdgcn_permlane32_swap(a1, b1, false, false); \
        u32x4 w = {r0[0], r1[0], r0[1], r1[1]}; OUT = *reinterpret_cast<bf16x8*>(&w); } while (0)
    AT_PK4(p0, 0, pa0); AT_PK4(p0, 8, pa1); AT_PK4(p1, 0, pa2); AT_PK4(p1, 8, pa3);
#undef AT_PK4
}

template <int MODE> struct Cfg;
template <> struct Cfg<0> { static constexpr int DQK = 128, LDQ = NP, LDK = NP, LDV = NP; };
template <> struct Cfg<1> { static constexpr int DQK = 192, LDQ = 1152, LDK = 1152, LDV = 768; };
template <> struct Cfg<2> { static constexpr int DQK = 128, LDQ = NP, LDK = NP, LDV = NP; };

template <int MODE>
__device__ __forceinline__ void attn_unit(const bf16_t* __restrict__ Qb, const bf16_t* __restrict__ Kh, const bf16_t* __restrict__ Vh, bf16_t* __restrict__ Yb,
                                          int pos0, int h, const float* __restrict__ extra, char* lds, int wid_s) {
    constexpr int DQK = Cfg<MODE>::DQK, LDQ = Cfg<MODE>::LDQ, LDK = Cfg<MODE>::LDK, LDV = Cfg<MODE>::LDV, ND = DQK / 16, KPITCH = DQK * 2 + 16, SHM_K = 64 * KPITCH, SHM_V = 16384;
    int tid = wid_s * 64 + lane_id(); asm volatile("" : "+v"(tid));
    const int wid = tid >> 6, lane = tid & 63, r32 = lane & 31, hi = lane >> 5;
    char* V_lds = lds + OFF_V; char* K_lds = lds + OFF_K;
    float* wsw = (float*)(lds + OFF_WS) + wid * 64; float* li_l = wsw; float* al_l = wsw + 32;
    int klo, NT;
    if (MODE == 0) { klo = max(0, pos0 - 128); NT = (min(SEQ, pos0 + 384) - klo) >> 6; }
    else if (MODE == 1) { klo = 0; NT = SEQ / 64; }
    else { const int r0 = pos0 >> 6; const int lo = min(max(r0 - 4, 0), 24), hiR = min(max(r0 + 3 - 4, 0), 24) + 8; NT = hiR - lo; if (NT & 1) NT += 1; klo = lo * 64; }
    float slope2 = 0.f; int dbase0 = 0; int cs = 0; bool dummy = false; (void)dummy;
    const float* tbl = nullptr; int rq = 0, rsq = 0;
    if (MODE == 0) { slope2 = exp2f(-8.0f * (float)(h + 1) * (1.0f / 6.0f)) * LOG2E; dbase0 = klo + 4 * hi - (pos0 + wid * 32 + r32); }
    if (MODE == 2) {
        float* TB = (float*)(lds + OFF_TB);
        for (int i = tid; i < 15 * 31; i += 512) { const int a = i / 31, b = i - a * 31; TB[a * TB_PITCH + 64 + b] = extra[i] * LOG2E; }
        const int c = (wid & 1) * 32 + r32; rq = (pos0 >> 6) + (wid >> 1); rsq = min(max(rq - 4, 0), 24); cs = min(max(c - 8, 0), 48);
        tbl = TB + 64 + 15 - c + 4 * hi;
    }
    float m_reg = -1e30f, l_reg = 0; f32x16 o[4];
#pragma unroll
    for (int d = 0; d < 4; ++d)
#pragma unroll
        for (int r = 0; r < 16; ++r) o[d][r] = 0.f;
    bf16x8 qr[8];
    char* QR = lds + OFF_QR + (wid * 32 + r32) * 144 + hi * 16;
    { const bf16_t* Qw = Qb + (size_t)(wid * 32 + r32) * LDQ + hi * 8;
#pragma unroll
      for (int d0 = 0; d0 < 8; ++d0) qr[d0] = *(const bf16x8*)(Qw + d0 * 16);
      if (DQK == 192) {
#pragma unroll
          for (int d0 = 0; d0 < 4; ++d0) *(bf16x8*)(QR + d0 * 32) = *(const bf16x8*)(Qw + 128 + d0 * 16); } }
    const int sr = tid >> 4, sc = (tid & 15) * 8, vst0 = v_st(sr, sc), vst1 = v_st(32 + sr, sc);
    const int sr2 = tid >> 3, sc2 = 128 + (tid & 7) * 8;
    const int vb0 = (int)(uintptr_t)(LAS char*)V_lds + v_rd_base(lane);
    const char* kbase = K_lds + r32 * KPITCH + hi * 16;
    const bf16_t* Kg = Kh + (size_t)klo * LDK; const bf16_t* Vg = Vh + (size_t)klo * LDV;
    bf16x8 sAvv0, sAvv1, sAkk0, sAkk1, sAkk2, sBvv0, sBvv1, sBkk0, sBkk1, sBkk2;
#define AT_KSWZ(row, colB) ((row) * KPITCH + (colB))
#define AT_SLOAD(S, koff) do { S##vv0 = *(const bf16x8*)(Vg + (size_t)((koff) + sr) * LDV + sc); S##vv1 = *(const bf16x8*)(Vg + (size_t)((koff) + 32 + sr) * LDV + sc); \
        S##kk0 = *(const bf16x8*)(Kg + (size_t)((koff) + sr) * LDK + sc); S##kk1 = *(const bf16x8*)(Kg + (size_t)((koff) + 32 + sr) * LDK + sc); \
        if (DQK == 192) S##kk2 = *(const bf16x8*)(Kg + (size_t)((koff) + sr2) * LDK + sc2); } while (0)
#define AT_SWRITE(b, S) do { *(bf16x8*)(V_lds + (b) * SHM_V + vst0) = S##vv0; *(bf16x8*)(V_lds + (b) * SHM_V + vst1) = S##vv1; \
        *(bf16x8*)(K_lds + (b) * SHM_K + AT_KSWZ(sr, sc * 2)) = S##kk0; *(bf16x8*)(K_lds + (b) * SHM_K + AT_KSWZ(32 + sr, sc * 2)) = S##kk1; \
        if (DQK == 192) *(bf16x8*)(K_lds + (b) * SHM_K + AT_KSWZ(sr2, sc2 * 2)) = S##kk2; } while (0)
#define AT_SWAIT() do { if (DQK == 192) asm volatile("s_waitcnt vmcnt(5)" ::: "memory"); else asm volatile("s_waitcnt vmcnt(4)" ::: "memory"); } while (0)
#define AT_RESC(a) do { if (__any((a) < 1.f)) { if (hi == 0) al_l[r32] = (a); asm volatile("s_waitcnt lgkmcnt(0)" ::: "memory"); \
        _Pragma("unroll") for (int d = 0; d < 4; ++d) _Pragma("unroll") for (int r = 0; r < 16; ++r) o[d][r] *= al_l[crow(r, hi)]; } } while (0)
#define AT_QKT(P0, P1, b) do { const char* Ks_ = kbase + (b) * SHM_K; \
        _Pragma("unroll") for (int r = 0; r < 16; ++r) { P0[r] = 0.f; P1[r] = 0.f; } \
        _Pragma("unroll") for (int d0 = 0; d0 < ND; ++d0) { \
            const bf16x8 b0 = *(const bf16x8*)(Ks_ + d0 * 32), b1 = *(const bf16x8*)(Ks_ + 32 * KPITCH + d0 * 32); \
            const bf16x8 qf_ = d0 < 8 ? qr[d0 & 7] : *(const bf16x8*)(QR + ((d0 - 8) & 3) * 32); \
            P0 = __builtin_amdgcn_mfma_f32_32x32x16_bf16(b0, qf_, P0, 0, 0, 0); P1 = __builtin_amdgcn_mfma_f32_32x32x16_bf16(b1, qf_, P1, 0, 0, 0); } } while (0)
#define AT_MASK(P0, P1, j) do { \
        if (MODE == 0) { const int db = dbase0 + (j) * 64; \
            _Pragma("unroll") for (int r = 0; r < 16; ++r) { const int d0_ = db + creg(r), d1_ = d0_ + 32; const int a0_ = d0_ < 0 ? -d0_ : d0_, a1_ = d1_ < 0 ? -d1_ : d1_; \
                P0[r] = a0_ <= 128 ? P0[r] - slope2 * (float)a0_ : NEGINF; P1[r] = a1_ <= 128 ? P1[r] - slope2 * (float)a1_ : NEGINF; } } \
        if (MODE == 2) { const int kr_ = (klo >> 6) + (j); const bool tok_ = (kr_ >= rsq) && (kr_ < rsq + 8); const int di_ = min(max(kr_ - rq + 7, 0), 14); \
            const float* tb_ = tbl + di_ * TB_PITCH; const int kc0_ = 4 * hi - cs; \
            _Pragma("unroll") for (int r = 0; r < 16; ++r) { const unsigned u0_ = (unsigned)(kc0_ + creg(r)), u1_ = (unsigned)(kc0_ + creg(r) + 32); \
                P0[r] = (tok_ && u0_ < 16u) ? P0[r] + tb_[creg(r)] : NEGINF; P1[r] = (tok_ && u1_ < 16u) ? P1[r] + tb_[creg(r) + 32] : NEGINF; } } } while (0)
    f32x16 pA0, pA1, pB0, pB1; float mnA, mnB, alA, alB; bf16x8 pa0, pa1, pa2, pa3;
    __syncthreads();
    constexpr int SD = (MODE == 1) ? 1 : 2;
    AT_SLOAD(sA, 0); asm volatile("s_waitcnt vmcnt(0)" ::: "memory"); AT_SWRITE(0, sA); __syncthreads();
    AT_QKT(pA0, pA1, 0); AT_MASK(pA0, pA1, 0); partialSM(pA0, pA1, m_reg, mnA, alA);
    if (SD == 2) { AT_SLOAD(sB, KVBLK); if (2 < NT) AT_SLOAD(sA, 2 * KVBLK); AT_SWAIT(); AT_SWRITE(1, sB); }
    else { AT_SLOAD(sA, KVBLK); AT_SWRITE(1, sA); }
    __syncthreads();
    for (int j = 1; j + 1 < NT; j += 2) {
        AT_SBAR(); AT_QKT(pB0, pB1, 1); AT_MASK(pB0, pB1, j);
        finishSM(pA0, pA1, alA, l_reg, pa0, pa1, pa2, pa3); AT_SBAR();
        if (SD == 2) AT_SLOAD(sB, (j + 2) * KVBLK); else AT_SLOAD(sA, (j + 1) * KVBLK);
        AT_SBAR();
        pv_d0(o, vb0, pa0, pa1, pa2, pa3); partialSM(pB0, pB1, m_reg, mnB, alB);
        __syncthreads(); if (SD == 2) AT_SWAIT(); AT_SWRITE(0, sA);
        AT_RESC(alB); __syncthreads();
        AT_SBAR(); AT_QKT(pA0, pA1, 0); AT_MASK(pA0, pA1, j + 1);
        finishSM(pB0, pB1, alB, l_reg, pa0, pa1, pa2, pa3); AT_SBAR();
        if (SD == 2) { if (j + 3 < NT) AT_SLOAD(sA, (j + 3) * KVBLK); } else AT_SLOAD(sA, (j + 2) * KVBLK);
        AT_SBAR();
        pv_d0(o, vb0 + SHM_V, pa0, pa1, pa2, pa3); partialSM(pA0, pA1, m_reg, mnA, alA);
        __syncthreads(); if (SD == 2) { AT_SWAIT(); AT_SWRITE(1, sB); } else AT_SWRITE(1, sA);
        AT_RESC(alA); __syncthreads();
    }
    AT_SBAR(); AT_QKT(pB0, pB1, 1); AT_MASK(pB0, pB1, NT - 1);
    finishSM(pA0, pA1, alA, l_reg, pa0, pa1, pa2, pa3); AT_SBAR();
    pv_d0(o, vb0, pa0, pa1, pa2, pa3); partialSM(pB0, pB1, m_reg, mnB, alB);
    __syncthreads(); AT_RESC(alB);
    finishSM(pB0, pB1, alB, l_reg, pa0, pa1, pa2, pa3); AT_SBAR();
    pv_d0(o, vb0 + SHM_V, pa0, pa1, pa2, pa3);
    float fin;
    if (MODE == 0) { const float sk = extra[0] * LOG2E, mf = fmaxf(m_reg, sk), a = __builtin_amdgcn_exp2f(m_reg - mf); fin = a * __builtin_amdgcn_rcpf(l_reg * a + __builtin_amdgcn_exp2f(sk - mf)); }
    else fin = __builtin_amdgcn_rcpf(l_reg);
    if (hi == 0) li_l[r32] = fin;
    asm volatile("s_waitcnt lgkmcnt(0)" ::: "memory");
    __syncthreads();
    bf16_t* Ot = (bf16_t*)lds + wid * (32 * 136);
#pragma unroll
    for (int r = 0; r < 16; ++r) { const int orow = crow(r, hi); const float f = li_l[orow];
#pragma unroll
        for (int d0 = 0; d0 < 4; ++d0) Ot[orow * 136 + d0 * 32 + r32] = (bf16_t)(cvt_pk_bf16(o[d0][r] * f, 0.f) & 0xffffu); }
    asm volatile("s_waitcnt lgkmcnt(0)" ::: "memory");
#pragma unroll
    for (int i = 0; i < 8; ++i) { const int idx = i * 64 + lane, row = idx >> 4, c8 = (idx & 15) * 8;
        const u32x4 ov = *(const u32x4*)(Ot + row * 136 + c8);
        bf16_t* yp = Yb + (size_t)(wid * 32 + row) * NP + c8; const u32x4 sg = *(const u32x4*)yp; u32x4 w;
        w.x = cvt_pk_bf16(bflo(ov.x) * bflo(sg.x), bfhi(ov.x) * bfhi(sg.x)); w.y = cvt_pk_bf16(bflo(ov.y) * bflo(sg.y), bfhi(ov.y) * bfhi(sg.y));
        w.z = cvt_pk_bf16(bflo(ov.z) * bflo(sg.z), bfhi(ov.z) * bfhi(sg.z)); w.w = cvt_pk_bf16(bflo(ov.w) * bflo(sg.w), bfhi(ov.w) * bfhi(sg.w));
        *(u32x4*)yp = w; }
#undef AT_KSWZ
#undef AT_SLOAD
#undef AT_SWRITE
#undef AT_SWAIT
#undef AT_RESC
#undef AT_QKT
#undef AT_MASK
}
}


constexpr int CVT_ITEMS = 1408 + 160;
__device__ __forceinline__ void cvt_item(const Params& p, unsigned char* wsl, int l, int r, float* ldsf, int wtid) {
    if (r < 768) cvt_tile<1>(p.w_in + (size_t)l * DM * INW, INW, DM, p.norm_in + l * DM, (bf16_t*)(wsl + OFF_WIN), ldsf, r >> 5, r & 31, wtid);
    else if (r < 816) cvt_tile<2>(p.b_w_uq + (size_t)l * 512 * 1152, 1152, 512, p.b_cq_norm + l * 512, (bf16_t*)(wsl + OFF_WUQ), ldsf, (r - 768) >> 3, (r - 768) & 7, wtid);
    else if (r < 864) cvt_tile<0>(p.b_w_ukv + (size_t)l * 512 * 1536, 1536, 512, p.b_ckv_norm + l * 512, (bf16_t*)(wsl + OFF_WUKV), ldsf, (r - 816) >> 3, (r - 816) & 7, wtid);
    else if (r < 1120) cvt_tile<0>(p.w_out + (size_t)l * DM * DM, DM, DM, nullptr, (bf16_t*)(wsl + OFF_WOUT), ldsf, (r - 864) >> 5, (r - 864) & 31, wtid);
    else if (r < 1376) cvt_tile<0>(p.w_gate + (size_t)l * DM * DM, DM, DM, p.ple_norm + l * DM, (bf16_t*)(wsl + OFF_WGATE), ldsf, (r - 1120) >> 5, (r - 1120) & 31, wtid);
    else if (r < 1408) cvt_tile<0>(p.w_proj + (size_t)l * 256 * DM, DM, 256, nullptr, (bf16_t*)(wsl + OFF_WPROJ), ldsf, (r - 1376) >> 2, (r - 1376) & 3, wtid);
    else { const int t0 = (r - 1408) * 256; bf16_t* PBl = (bf16_t*)(wsl + OFF_PB);
        const float* srcb = t0 < 8192 ? p.p_prompt + ((size_t)l * 8192 + t0) * 256 : p.p_sample + ((size_t)l * 32768 + (t0 - 8192)) * 256;
#pragma unroll 4
        for (int i = wtid; i < 256 * 256 / 8; i += 512) { const int e = i * 8; *(u32x4*)(PBl + (size_t)t0 * 256 + e) = pack8(*(const f32x4*)(srcb + e), *(const f32x4*)(srcb + e + 4)); } }
}

#define XB_TMO      128
#define XB_XCNT(j)  (256  + 64 * (j))
#define XB_XSUB(j)  (1280 + 64 * (j))
#define XB_XGEN(j)  (2304 + 64 * (j))
#define XB_TOP      3328
#define XB_TOPGEN   3392
#define XCD_BAR_WORDS 3456
#define XB_SPIN_CAP (1u << 18)
__device__ __forceinline__ unsigned xb_ld(unsigned* p)              { return __hip_atomic_load(p, __ATOMIC_RELAXED, __HIP_MEMORY_SCOPE_AGENT); }
__device__ __forceinline__ unsigned xb_add(unsigned* p, unsigned v) { return __hip_atomic_fetch_add(p, v, __ATOMIC_RELAXED, __HIP_MEMORY_SCOPE_AGENT); }
__device__ __forceinline__ unsigned xb_xcc_id() { return (unsigned)__builtin_amdgcn_s_getreg((3 << 11) | 20) & 0xFu; }
#define XB_SPIN(cond, bar) do { unsigned _sp = 0; while (cond) { __builtin_amdgcn_s_sleep(1); \
    if ((++_sp & 255u) == 0u) { if (xb_ld(&(bar)[XB_TMO])) break; if (_sp > XB_SPIN_CAP) { atomicAdd(&(bar)[XB_TMO], 1u); break; } } } } while (0)
struct XcdBarrier { unsigned* bar; unsigned x; volatile LAS unsigned* st; };
__device__ __forceinline__ void xcd_barrier_complete(unsigned* bar, unsigned x, unsigned& nloc, unsigned& nx) {
    const unsigned G = gridDim.x * gridDim.y * gridDim.z;
    unsigned sum, cnt, mine, sp = 0u;
    for (;;) {
        sum = 0u; cnt = 0u; mine = 0u;
#pragma unroll
        for (unsigned j = 0; j < 16; ++j) { const unsigned c = xb_ld(&bar[XB_XCNT(j)]); sum += c; cnt += (c > 0u) ? 1u : 0u; mine = (j == x) ? c : mine; }
        if (sum == G) break;
        __builtin_amdgcn_s_sleep(1);
        if ((++sp & 255u) == 0u) { if (xb_ld(&bar[XB_TMO])) break; if (sp > XB_SPIN_CAP) { atomicAdd(&bar[XB_TMO], 1u); break; } }
    }
    nloc = mine > 0u ? mine : 1u; nx = cnt > 0u ? cnt : 1u;
}
__device__ __forceinline__ void xcd_barrier(const XcdBarrier& b, bool leader_thread) {
    asm volatile("s_waitcnt vmcnt(0)" ::: "memory");
    __syncthreads();
    if (leader_thread) {
        unsigned* bar = b.bar;
        __builtin_amdgcn_s_waitcnt(0);
        unsigned nloc = b.st[0], nx = b.st[1];
        if (nloc == 0u) { xcd_barrier_complete(bar, b.x, nloc, nx); b.st[0] = nloc; b.st[1] = nx; }
        const unsigned old = xb_add(&bar[XB_XSUB(b.x)], 1u);
        const unsigned gen = old / nloc;
        if (old + 1u == (gen + 1u) * nloc) {
            __builtin_amdgcn_fence(__ATOMIC_RELEASE, "agent");
            asm volatile("s_waitcnt vmcnt(0)" ::: "memory");
            const unsigned og = xb_add(&bar[XB_TOP], 1u);
            const unsigned tg = og / nx;
            if (og + 1u == (tg + 1u) * nx) xb_add(&bar[XB_TOPGEN], 1u);
            else XB_SPIN(xb_ld(&bar[XB_TOPGEN]) == tg, bar);
            __builtin_amdgcn_fence(__ATOMIC_ACQUIRE, "agent");
            xb_add(&bar[XB_XGEN(b.x)], 1u);
            asm volatile("s_waitcnt vmcnt(0)" ::: "memory");
        } else {
            XB_SPIN(xb_ld(&bar[XB_XGEN(b.x)]) == gen, bar);
            __builtin_amdgcn_fence(__ATOMIC_ACQUIRE, "agent");
            asm volatile("s_waitcnt vmcnt(0)" ::: "memory");
        }
    }
    __syncthreads();
}

__global__ __launch_bounds__(512, 2) void hymba_fwd(Params p) {
    extern __shared__ __attribute__((aligned(16))) unsigned char shm[];
    cg::grid_group grid = cg::this_grid();
    LAS unsigned char* lds = (LAS unsigned char*)shm;
    LAS float* TABL = (LAS float*)(lds + LDS_STAGE);
    float* ldsf = (float*)shm;
    unsigned char* ws = p.ws;
    bf16_t* HBB = (bf16_t*)(ws + OFF_HBB); bf16_t* PROJ = (bf16_t*)(ws + OFF_PROJ);
    bf16_t* QB = (bf16_t*)(ws + OFF_QB); bf16_t* KB = (bf16_t*)(ws + OFF_KB); bf16_t* VB = (bf16_t*)(ws + OFF_VB); bf16_t* HBA = QB;
    float* SS = (float*)(ws + OFF_SS); float2* tab = (float2*)(ws + OFF_TAB); float* GT = (float*)(ws + OFF_GT); unsigned* CTR = (unsigned*)(ws + OFF_CTR);
#define SSP(kind, l) (SS + ((size_t)(kind) * 4 + (l)) * TTOT)
    const int wid_s = __builtin_amdgcn_readfirstlane((int)threadIdx.x >> 6);
    volatile LAS unsigned* xbst = (volatile LAS unsigned*)((LAS unsigned char*)shm + LDS_XB);
    if (threadIdx.x == 0) { xbst[0] = 0u; xbst[1] = 0u; xbst[2] = 0u; xbst[3] = 0u; }
    __syncthreads();
#define XBAR_NOW() ({ XcdBarrier b_; b_.bar = (unsigned*)(p.ws + OFF_BAR); b_.x = xb_xcc_id(); b_.st = (volatile LAS unsigned*)((LAS unsigned char*)shm + LDS_XB); b_; })
    const int tid = threadIdx.x, gthreads = gridDim.x * 512, gtid = blockIdx.x * 512 + tid;
#if PROBE_SEL
    unsigned long long t_acc = 0, t_mark = __builtin_amdgcn_s_memrealtime();
#define PROBE_MARK(cat) do { const unsigned long long n_ = __builtin_amdgcn_s_memrealtime(); if (PROBE_SEL == 8 || (cat) == PROBE_SEL) t_acc += n_ - t_mark; t_mark = n_; } while (0)
#define PROBE_TACC (&t_acc)
#else
#define PROBE_MARK(cat) do { } while (0)
#define PROBE_TACC nullptr
#endif

    for (int i = gtid; i < 5 * 4 * TTOT; i += gthreads) { const int kind = 1 + i / (4 * TTOT), rem = i % (4 * TTOT); SS[(size_t)kind * 4 * TTOT + rem] = 0.f; }
    for (int i = gtid; i < 3 * TTOT; i += gthreads) SS[TTOT + i] = 0.f;
    if (gtid < 8) CTR[gtid] = 0u;
    for (int i = gtid; i < XCD_BAR_WORDS; i += gthreads) ((unsigned*)(p.ws + OFF_BAR))[i] = 0u;
    if (gtid < 2048) { const int l = gtid >> 9, w = (gtid >> 7) & 3, d = gtid & 127; float v;
        if (w == 0) v = p.a_q_norm[l * 128 + d]; else if (w == 1) v = p.a_k_norm[l * 128 + d]; else if (w == 2) v = p.c_q_norm[l * 128 + d]; else v = p.c_k_norm[l * 128 + d];
        GT[gtid] = v; }
    for (int i = gtid; i < SEQ * 32; i += gthreads) { const int pos = i >> 5, j = i & 31; const double ang = (double)pos * pow(10000.0, -(double)j / 32.0); tab[i] = make_float2((float)cos(ang), (float)sin(ang)); }
    {
        const int gw = gtid >> 6, nw = gthreads >> 6, lane = tid & 63;
        for (int row = gw; row < TTOT; row += nw) {
            const float* src = row < 8192 ? p.x_prompt + (size_t)row * DM : p.x_sample + (size_t)(row - 8192) * DM; float s = 0.f;
#pragma unroll
            for (int i = 0; i < 4; ++i) { const int c = (i * 64 + lane) * 8; const f32x4 a = *(const f32x4*)(src + c), b = *(const f32x4*)(src + c + 4);
                s += sq4(a) + sq4(b); *(u32x4*)(HBB + (size_t)row * DM + c) = pack8(a, b); }
            s = wave_sum(s); if (lane == 0) SSP(0, 0)[row] = s;
        }
    }

    for (int l = 0; l < 4; ++l) {
        unsigned char* const wsl = ws + (size_t)(l & 1) * SZ_LAYER;
        if (l == 0) {
            int wtid = wid_s * 64 + lane_id(); asm volatile("" : "+v"(wtid));
            for (int r = blockIdx.x; r < CVT_ITEMS; r += gridDim.x) cvt_item(p, wsl, 0, r, ldsf, wtid);
            PROBE_MARK(1); grid.sync(); PROBE_MARK(7);
            if (wid_s == 0 && lane_id() == 0) (void)xb_add(&((unsigned*)(p.ws + OFF_BAR))[XB_XCNT(xb_xcc_id())], 1u);
        }
        {
            constexpr int r0 = 0, TC = TTOT;
            pg8::StaticOrder S;
            {
                pg8::Gemm g{HBB + (size_t)r0 * DM, (const bf16_t*)(wsl + OFF_WIN), DM, TC, NP, DM};
                EpiProj E{PROJ, SSP(0, l) + r0, SSP(3, l) + r0, SSP(5, l) + r0, GT + l * 512, p.b_k_norm + l * 192 + 128, tab, TABL};
                S.init(TC, NP, gridDim.x, blockIdx.x); pg8::gemm_phase(lds, g, S, E, wid_s, PROBE_TACC);
            }
            PROBE_MARK(2); xcd_barrier(XBAR_NOW(), wid_s == 0 && lane_id() == 0); PROBE_MARK(7);
            {
                pg8::Gemm g{PROJ + C_BCQ, (const bf16_t*)(wsl + OFF_WUQ), NP, TC, 1536, 512};
                EpiUQ E{QB, SSP(3, l) + r0, p.b_q_norm + l * 192, tab, TABL};
                S.init(TC, 1536, gridDim.x, blockIdx.x); pg8::gemm_phase(lds, g, S, E, wid_s, PROBE_TACC);
            }
            {
                pg8::Gemm g{PROJ + C_BCKV, (const bf16_t*)(wsl + OFF_WUKV), NP, TC, 1536, 512};
                EpiUKV E{KB, VB, PROJ, SSP(4, l) + r0, SSP(5, l) + r0, p.b_k_norm + l * 192, TABL};
                S.init(TC, 1536, gridDim.x, blockIdx.x); pg8::gemm_phase(lds, g, S, E, wid_s, PROBE_TACC);
            }
            PROBE_MARK(3); xcd_barrier(XBAR_NOW(), wid_s == 0 && lane_id() == 0); PROBE_MARK(7);
            {
                const int nqb = TC / 256, nB = nqb * 6, nC = nqb * 4, nA = nqb * 6;
                unsigned* ctr = CTR + l;
                LAS int* slot = (LAS int*)(lds + at::OFF_SLOT);
                for (;;) {
                    __syncthreads();
                    if (wid_s == 0 && lane_id() == 0) *slot = (int)atomicAdd(ctr, 1u);
                    __syncthreads();
                    const int uI = *slot;
                    if (uI >= nB + nC + nA + (l < 3 ? CVT_ITEMS : 0)) break;
                    if (uI >= nB + nC + nA) { int wtid = wid_s * 64 + lane_id(); asm volatile("" : "+v"(wtid)); cvt_item(p, ws + (size_t)((l + 1) & 1) * SZ_LAYER, l + 1, uI - (nB + nC + nA), ldsf, wtid); continue; }
                    if (uI < nB) { const int hh = uI % 6, t0 = (uI / 6) * 256, sb = t0 & ~(SEQ - 1);
                        at::attn_unit<1>(QB + (size_t)t0 * 1152 + hh * 192, KB + (size_t)sb * 1152 + hh * 192, VB + (size_t)sb * 768 + hh * 128, PROJ + (size_t)t0 * NP + C_Z + 768 + hh * 128,
                                         t0 & (SEQ - 1), hh, nullptr, (char*)shm, wid_s); }
                    else if (uI < nB + nC) { const int v = uI - nB, hh = v & 3, t0 = (v >> 2) * 256, sb = t0 & ~(SEQ - 1);
                        at::attn_unit<2>(PROJ + (size_t)t0 * NP + C_CQ + hh * 128, PROJ + (size_t)sb * NP + C_CK + hh * 128, PROJ + (size_t)sb * NP + C_CV + hh * 128, PROJ + (size_t)t0 * NP + C_Z + 1536 + hh * 128,
                                         t0 & (SEQ - 1), hh, p.c_rpb + ((size_t)l * 4 + hh) * 15 * 31, (char*)shm, wid_s); }
                    else { const int v = uI - nB - nC, hh = v % 6, t0 = (v / 6) * 256, sb = t0 & ~(SEQ - 1);
                        at::attn_unit<0>(PROJ + (size_t)t0 * NP + C_AQ + hh * 128, PROJ + (size_t)sb * NP + C_AK + (hh / 3) * 128, PROJ + (size_t)sb * NP + C_AV + (hh / 3) * 128, PROJ + (size_t)t0 * NP + C_Z + hh * 128,
                                         t0 & (SEQ - 1), hh, p.a_sink + l * 6 + hh, (char*)shm, wid_s); }
                }
            }
            PROBE_MARK(4); xcd_barrier(XBAR_NOW(), wid_s == 0 && lane_id() == 0); PROBE_MARK(7);
            for (int s2 = 0; s2 < 2; ++s2) {
                if ((s2 ^ (int)((blockIdx.x >> 3) & 1)) == 0) {
                    const float* hin = (l == 0) ? p.x_prompt : p.h; const long hdelta = (l == 0) ? (long)((p.x_sample - (size_t)8192 * DM) - p.x_prompt) : 0;
                    pg8::Gemm g{PROJ + C_Z, (const bf16_t*)(wsl + OFF_WOUT), NP, TC, DM, DM};
                    EpiOut E{hin, hdelta, p.h, HBA, SSP(1, l)};
                    S.init(TC, DM, gridDim.x, blockIdx.x); pg8::gemm_phase(lds, g, S, E, wid_s, PROBE_TACC);
                } else {
                    pg8::Gemm g{(const bf16_t*)(wsl + OFF_PB), (const bf16_t*)(wsl + OFF_WPROJ), 256, TC, DM, 256};
                    EpiPP E{PROJ, SSP(2, l) + r0, p.post_norm + l * DM};
                    S.init(TC, DM, gridDim.x, blockIdx.x); pg8::gemm_phase(lds, g, S, E, wid_s, PROBE_TACC);
                }
            }
            PROBE_MARK(5); xcd_barrier(XBAR_NOW(), wid_s == 0 && lane_id() == 0); PROBE_MARK(7);
            {
                pg8::Gemm g{HBA, (const bf16_t*)(wsl + OFF_WGATE), DM, TC, DM, DM};
                EpiGate E{p.h + (size_t)r0 * DM, HBB + (size_t)r0 * DM, PROJ, SSP(1, l) + r0, SSP(2, l) + r0, (l < 3) ? SSP(0, l + 1) + r0 : nullptr};
                S.init(TC, DM, gridDim.x, blockIdx.x); pg8::gemm_phase(lds, g, S, E, wid_s, PROBE_TACC);
            }
            PROBE_MARK(6); xcd_barrier(XBAR_NOW(), wid_s == 0 && lane_id() == 0); PROBE_MARK(7);
        }
    }
#if PROBE_SEL
    if (blockIdx.x == 0 && wid_s == 0 && lane_id() == 0) p.h[0] += (float)t_acc * (1e-5f * 4.0f);
#endif
}

extern "C" void kernel_launch(void* const* d_in, const int* in_sizes, int n_in, void* d_out, int out_size, void* d_ws, size_t ws_size, hipStream_t stream) {
    static int grid_blocks = 0;
    if (grid_blocks == 0) {
        if (n_in != 23 || ws_size < WS_END) { fprintf(stderr, "kernel_launch: need 23 inputs and %zu bytes of workspace (got %d, %zu)\n", (size_t)WS_END, n_in, ws_size); grid_blocks = -1; return; }
        int dev = 0, cus = 0, per_cu = 0;
        if (hipGetDevice(&dev) != hipSuccess || hipDeviceGetAttribute(&cus, hipDeviceAttributeMultiprocessorCount, dev) != hipSuccess) { grid_blocks = -1; return; }
        if (hipFuncSetAttribute((const void*)hymba_fwd, hipFuncAttributeMaxDynamicSharedMemorySize, LDS_BYTES) != hipSuccess) { fprintf(stderr, "kernel_launch: hipFuncSetAttribute failed\n"); grid_blocks = -1; return; }
        if (hipOccupancyMaxActiveBlocksPerMultiprocessor(&per_cu, (const void*)hymba_fwd, 512, LDS_BYTES) != hipSuccess || per_cu < 1) { fprintf(stderr, "kernel_launch: occupancy query failed (%d)\n", per_cu); (void)hipGetLastError(); per_cu = 1; }
        grid_blocks = cus * per_cu;
    }
    if (grid_blocks < 0) return;
    Params p{};
    const float** pf = (const float**)&p;
    for (int i = 0; i < 23; ++i) pf[i] = (const float*)d_in[i];
    p.h = (float*)d_out; p.ws = (unsigned char*)d_ws;
    void* args[] = {&p};
    hipError_t e = hipLaunchCooperativeKernel((const void*)hymba_fwd, dim3(grid_blocks), dim3(512), args, LDS_BYTES, stream);
    if (e != hipSuccess) fprintf(stderr, "cooperative launch failed: %s (grid %d)\n", hipGetErrorString(e), grid_blocks);
}
```

```cpp
#include <hip/hip_runtime.h>
#include <hip/hip_cooperative_groups.h>
#include <cstdio>
#include <math.h>
namespace cg = cooperative_groups;
#define PROBE_SEL 0

#define LAS __attribute__((address_space(3)))
typedef unsigned short bf16_t;
typedef short bf16x8 __attribute__((ext_vector_type(8)));
typedef float f32x4 __attribute__((ext_vector_type(4)));
typedef unsigned u32x4 __attribute__((ext_vector_type(4)));
typedef unsigned u32x2 __attribute__((ext_vector_type(2)));

constexpr int SEQ = 2048, DM = 2048, INW = 5952, TTOT = 40960, NP = 6144;
constexpr int O_AQ = 0, O_AK = 768, O_AV = 1024, O_AZ = 1280, O_BCQ = 2048, O_BCKV = 2560, O_BKR = 3072, O_BZ = 3136, O_CQ = 3904, O_CK = 4416, O_CV = 4928, O_CZ = 5440;
constexpr int C_AQ = 0, C_AK = 768, C_AV = 1024, C_BCQ = 1280, C_BCKV = 1792, C_CQ = 2304, C_CK = 2816, C_CV = 3328, C_Z = 3840, C_KR = 5888;
constexpr float LOG2E = 1.4426950408889634f;
constexpr float QS_A = 0.08838834764831845f * LOG2E;
constexpr float QS_B = 0.07216878364870323f * LOG2E;
constexpr size_t SZ_WIN = (size_t)NP * 2048 * 2, SZ_WU = (size_t)1536 * 512 * 2, SZ_WSQ = (size_t)2048 * 2048 * 2, SZ_WPROJ = (size_t)2048 * 256 * 2;
constexpr size_t OFF_WIN = 0, OFF_WUQ = OFF_WIN + SZ_WIN, OFF_WUKV = OFF_WUQ + SZ_WU, OFF_WOUT = OFF_WUKV + SZ_WU, OFF_WGATE = OFF_WOUT + SZ_WSQ,
                 OFF_WPROJ = OFF_WGATE + SZ_WSQ, OFF_PB = OFF_WPROJ + SZ_WPROJ, SZ_LAYER = OFF_PB + (size_t)TTOT * 256 * 2,
                 OFF_HBB = 2 * SZ_LAYER,
                 OFF_PROJ = OFF_HBB + (size_t)TTOT * DM * 2, OFF_QB = OFF_PROJ + (size_t)TTOT * NP * 2, OFF_KB = OFF_QB + (size_t)TTOT * 1152 * 2,
                 OFF_VB = OFF_KB + (size_t)TTOT * 1152 * 2, OFF_SS = OFF_VB + (size_t)TTOT * 768 * 2, OFF_TAB = OFF_SS + (size_t)6 * 4 * TTOT * 4,
                 OFF_GT = OFF_TAB + (size_t)SEQ * 32 * 8, OFF_CTR = OFF_GT + 4 * 4 * 128 * 4, OFF_BAR = OFF_CTR + 256, WS_END = OFF_BAR + 3456 * 4;
static_assert(WS_END <= (size_t)1 << 30, "workspace budget");
constexpr int LDS_STAGE = 131072, LDS_XB = LDS_STAGE + 8192, LDS_BYTES = LDS_XB + 16;
constexpr unsigned long long STAGGER_TICKS = 2200;

struct Params {
    const float *x_prompt, *x_sample, *p_prompt, *p_sample, *norm_in, *w_in, *a_q_norm, *a_k_norm, *a_sink, *b_cq_norm, *b_ckv_norm, *b_w_uq, *b_w_ukv,
        *b_q_norm, *b_k_norm, *c_q_norm, *c_k_norm, *c_rpb, *w_out, *ple_norm, *w_gate, *w_proj, *post_norm;
    float* h;
    unsigned char* ws;
};

__device__ __forceinline__ unsigned cvt_pk_bf16(float lo, float hi) { unsigned r; asm volatile("v_cvt_pk_bf16_f32 %0, %1, %2" : "=v"(r) : "v"(lo), "v"(hi)); return r; }
__device__ __forceinline__ float bf2f(unsigned short b) { return __uint_as_float(((unsigned)b) << 16); }
__device__ __forceinline__ float bflo(unsigned w) { return __uint_as_float(w << 16); }
__device__ __forceinline__ float bfhi(unsigned w) { return __uint_as_float(w & 0xffff0000u); }
__device__ __forceinline__ int lane_id() { unsigned m = ~0u; asm volatile("" : "+s"(m)); return (int)__builtin_amdgcn_mbcnt_hi(m, __builtin_amdgcn_mbcnt_lo(m, 0u)); }
__device__ __forceinline__ float wave_sum(float v) {
#pragma unroll
    for (int o = 32; o >= 1; o >>= 1) v += __shfl_xor(v, o);
    return v;
}

namespace pg8 {
constexpr int BM = 256, BK = 64, HALF = 128, HTB = HALF * BK * 2, STAGE_BYTES = 8 * HTB, NXCD = 8, WGM = 8;
__device__ __forceinline__ int lds_byte(int r, int c) { const int st = (r >> 4) * 2 + (c >> 5), rr = r & 15, cc = c & 31, ob = rr * 64 + cc * 2; return st * 1024 + (ob ^ (((ob >> 9) & 1) << 5)); }
__device__ __forceinline__ void stage_rc(int b, int& R, int& C) { const int st = b / 1024, sb = b % 1024, swz = sb ^ (((sb >> 9) & 1) << 5); R = (st >> 1) * 16 + swz / 64; C = (st & 1) * 32 + (swz % 64) / 2; }
__device__ __forceinline__ int perm32(int rho) { const int n = rho >> 4, i = rho & 15; return 8 * (i >> 2) + 4 * n + (i & 3); }
struct Unit { int pm, pn; };
struct Gemm { const bf16_t* A; const bf16_t* Bt; int lda, M, N, K; };
struct StaticOrder {
    int nM, nN, nwg, G, c;
    __device__ void init(int M, int N, int G_, int c_) { nM = M / BM; nN = N / BM; nwg = nM * nN; G = G_; c = c_; }
    __device__ bool next(int i, Unit& u) const {
        const long L = (long)i * G + c; if (L >= nwg) return false;
        int wgid = (int)L; { const int q = nwg / NXCD, r = nwg % NXCD, xcd = wgid % NXCD, off = wgid / NXCD; wgid = (xcd < r ? xcd * (q + 1) : r * (q + 1) + (xcd - r) * q) + off; }
        const int nig = WGM * nN, gid = wgid / nig, fm = gid * WGM, gsz = (nM - fm) < WGM ? (nM - fm) : WGM;
        u.pm = fm + ((wgid % nig) % gsz); u.pn = (wgid % nig) / gsz; return true;
    }
};

template <class Epi>
__device__ __forceinline__ void gemm_phase(LAS unsigned char* lds, const Gemm g, const StaticOrder& S, const Epi& E, int wid_s, unsigned long long* tacc = nullptr) {
    int tid = wid_s * 64 + lane_id(); asm volatile("" : "+v"(tid));
    const int wid = __builtin_amdgcn_readfirstlane(tid >> 6), lane = tid & 63, wr = wid >> 2, wc = wid & 3, fr = lane & 15, fq = lane >> 4;
    int K = g.K; asm volatile("" : "+s"(K));
    const int nt = K / BK;
    unsigned voffA[2], voffB[2];
#pragma unroll
    for (int i = 0; i < 2; ++i) { int R, C; stage_rc(tid * 16 + i * 8192, R, C); const int Rb = Epi::PERM ? ((R & ~31) + perm32(R & 31)) : R;
        voffA[i] = (unsigned)(R * g.lda + C) * 2u; voffB[i] = (unsigned)(Rb * K + C) * 2u; }
    const size_t kstep = (size_t)(BK * 2);
    const size_t hstepA = (size_t)HALF * g.lda * 2, hstepB = (size_t)HALF * K * 2;
    const size_t tstepA = 2 * hstepA, tstepB = 2 * hstepB;
    const unsigned ldsw = (unsigned)wid * 1024u;
    const int aoff = lds_byte(wr * 64 + fr, fq * 8), boff = lds_byte(wc * 32 + fr, fq * 8);
#define PG8_SA(b, h) (((b) * 2 + (h)) * HTB)
#define PG8_SB(b, h) ((4 + (b) * 2 + (h)) * HTB)
#define PG8_STAGE(bufoff, gbase, voff) do { _Pragma("unroll") for (int _i = 0; _i < 2; ++_i) \
        __builtin_amdgcn_global_load_lds((const unsigned*)((const char*)(gbase) + (voff)[_i]), (LAS unsigned*)(lds + (bufoff) + ldsw + _i * 8192), 16, 0, 0); } while (0)
#define PG8_LDA(dst, b, h) do { _Pragma("unroll") for (int m = 0; m < 4; ++m) _Pragma("unroll") for (int k = 0; k < 2; ++k) dst[m][k] = *(const LAS bf16x8*)(lds + PG8_SA(b, h) + aoff + m * 2048 + k * 1024); } while (0)
#define PG8_LDB(dst, b, h) do { _Pragma("unroll") for (int n = 0; n < 2; ++n) _Pragma("unroll") for (int k = 0; k < 2; ++k) dst[n][k] = *(const LAS bf16x8*)(lds + PG8_SB(b, h) + boff + n * 2048 + k * 1024); } while (0)
#define PG8_MMA(ai, bj, At, Bt) do { __builtin_amdgcn_s_setprio(1); _Pragma("unroll") for (int m = 0; m < 4; ++m) _Pragma("unroll") for (int n = 0; n < 2; ++n) _Pragma("unroll") for (int k = 0; k < 2; ++k) \
        acc[ai][bj][m][n] = __builtin_amdgcn_mfma_f32_16x16x32_bf16(Bt[n][k], At[m][k], acc[ai][bj][m][n], 0, 0, 0); __builtin_amdgcn_s_setprio(0); } while (0)
#define PG8_WAIT_V(n) asm volatile("s_waitcnt vmcnt(" #n ")" ::: "memory")
#define PG8_WAIT_L(n) asm volatile("s_waitcnt lgkmcnt(" #n ")" ::: "memory")
#define PG8_BAR __builtin_amdgcn_s_barrier()
#define PG8_SCHED __builtin_amdgcn_sched_barrier(0)
    Unit cur, nxt; int ui = 0;
    if (!S.next(0, cur)) return;
    f32x4 acc[2][2][4][2];
#pragma unroll
    for (int a = 0; a < 2; ++a)
#pragma unroll
        for (int b = 0; b < 2; ++b)
#pragma unroll
            for (int m = 0; m < 4; ++m)
#pragma unroll
                for (int n = 0; n < 2; ++n) acc[a][b][m][n] = (f32x4){0.f, 0.f, 0.f, 0.f};
    bf16x8 At[4][2], B0[2][2], B1[2][2];
    const char* cA = (const char*)g.A + (size_t)cur.pm * tstepA; const char* cB = (const char*)g.Bt + (size_t)cur.pn * tstepB;
    PG8_STAGE(PG8_SB(0, 0), cB, voffB); PG8_STAGE(PG8_SA(0, 0), cA, voffA); PG8_STAGE(PG8_SB(0, 1), cB + hstepB, voffB); PG8_STAGE(PG8_SA(0, 1), cA + hstepA, voffA);
    if (wr == 1) PG8_BAR;
    PG8_WAIT_V(4); PG8_BAR;
    PG8_STAGE(PG8_SB(1, 0), cB + kstep, voffB); PG8_STAGE(PG8_SA(1, 0), cA + kstep, voffA); PG8_STAGE(PG8_SB(1, 1), cB + hstepB + kstep, voffB);
    PG8_WAIT_V(6); PG8_BAR;
    for (;;) {
        const bool has_next = S.next(ui + 1, nxt);
        const char* nA = has_next ? (const char*)g.A + (size_t)nxt.pm * tstepA : cA; const char* nB = has_next ? (const char*)g.Bt + (size_t)nxt.pn * tstepB : cB;
#if PROBE_SEL >= 9
        const unsigned long long k0_ = __builtin_amdgcn_s_memrealtime();
#endif
        for (int t = 0; t < nt; t += 2) {
            const bool last = (t == nt - 2);
            const char* a1 = cA + (size_t)(t + 1) * kstep;
            const char* a2 = last ? nA : cA + (size_t)(t + 2) * kstep; const char* b2 = last ? nB : cB + (size_t)(t + 2) * kstep;
            const char* a3 = a2 + kstep; const char* b3 = b2 + kstep;
            PG8_LDB(B0, 0, 0); PG8_SCHED; PG8_LDA(At, 0, 0); PG8_STAGE(PG8_SA(1, 1), a1 + hstepA, voffA);
            PG8_WAIT_L(8); PG8_BAR; PG8_WAIT_L(0); PG8_MMA(0, 0, At, B0); PG8_BAR; PG8_SCHED;
            PG8_LDB(B1, 0, 1); PG8_STAGE(PG8_SB(0, 0), b2, voffB);
            PG8_BAR; PG8_WAIT_L(0); PG8_MMA(0, 1, At, B1); PG8_BAR;
            PG8_LDA(At, 0, 1); PG8_STAGE(PG8_SA(0, 0), a2, voffA);
            PG8_BAR; PG8_WAIT_L(0); PG8_MMA(1, 0, At, B0); PG8_BAR; PG8_SCHED;
            PG8_STAGE(PG8_SB(0, 1), b2 + hstepB, voffB);
            PG8_WAIT_V(6); PG8_BAR; PG8_MMA(1, 1, At, B1); PG8_BAR;
            PG8_LDB(B0, 1, 0); PG8_SCHED; PG8_LDA(At, 1, 0); PG8_STAGE(PG8_SA(0, 1), a2 + hstepA, voffA);
            PG8_WAIT_L(8); PG8_BAR; PG8_WAIT_L(0); PG8_MMA(0, 0, At, B0); PG8_BAR; PG8_SCHED;
            PG8_LDB(B1, 1, 1); PG8_STAGE(PG8_SB(1, 0), b3, voffB);
            PG8_BAR; PG8_WAIT_L(0); PG8_MMA(0, 1, At, B1); PG8_BAR;
            PG8_LDA(At, 1, 1); PG8_STAGE(PG8_SA(1, 0), a3, voffA);
            PG8_BAR; PG8_WAIT_L(0); PG8_MMA(1, 0, At, B0); PG8_BAR; PG8_SCHED;
            PG8_STAGE(PG8_SB(1, 1), b3 + hstepB, voffB);
            PG8_WAIT_V(6); PG8_BAR; PG8_MMA(1, 1, At, B1); PG8_BAR;
        }
#if PROBE_SEL >= 9
        const unsigned long long e0_ = __builtin_amdgcn_s_memrealtime();
        if (Epi::PROBE_ID + 100 == PROBE_SEL) *tacc += e0_ - k0_;
#endif
        E(acc, cur, wr, wc, fr, fq);
#if PROBE_SEL >= 9
        if (Epi::PROBE_ID == PROBE_SEL) *tacc += __builtin_amdgcn_s_memrealtime() - e0_;
#endif
        if (!has_next) break;
#pragma unroll
        for (int a = 0; a < 2; ++a)
#pragma unroll
            for (int b = 0; b < 2; ++b)
#pragma unroll
                for (int m = 0; m < 4; ++m)
#pragma unroll
                    for (int n = 0; n < 2; ++n) acc[a][b][m][n] = (f32x4){0.f, 0.f, 0.f, 0.f};
        cur = nxt; cA = nA; cB = nB; ++ui;
    }
    PG8_WAIT_V(0);
    if (wr == 0) PG8_BAR;
    PG8_BAR;
#undef PG8_SA
#undef PG8_SB
#undef PG8_STAGE
#undef PG8_LDA
#undef PG8_LDB
#undef PG8_MMA
#undef PG8_WAIT_V
#undef PG8_WAIT_L
#undef PG8_BAR
#undef PG8_SCHED
}
}
using pg8::Unit;
typedef f32x4 AccT[2][2][4][2];

#define EPI_BAR() do { asm volatile("s_waitcnt lgkmcnt(0)" ::: "memory"); __builtin_amdgcn_s_barrier(); asm volatile("" ::: "memory"); } while (0)
__device__ __forceinline__ float sq4(const f32x4 v) { return (v[0] * v[0] + v[1] * v[1]) + (v[2] * v[2] + v[3] * v[3]); }
__device__ __forceinline__ float red_fq(float s) { s += __shfl_xor(s, 16); s += __shfl_xor(s, 32); return s; }
__device__ __forceinline__ u32x4 pack8(const f32x4 a, const f32x4 b) { u32x4 w; w.x = cvt_pk_bf16(a[0], a[1]); w.y = cvt_pk_bf16(a[2], a[3]); w.z = cvt_pk_bf16(b[0], b[1]); w.w = cvt_pk_bf16(b[2], b[3]); return w; }

struct EpiProj {
    static constexpr int PROBE_ID = 10;
    static constexpr bool PERM = true;
    bf16_t* PROJ; const float* ssh; float *ss_cq, *ss_kr;
    const float *gt, *g_kr; const float2* tab; LAS float* TABL;
    __device__ __forceinline__ void operator()(AccT& acc, const Unit& u, int wr, int wc, int fr, int fq) const {
        { int ln_ = lane_id(); asm volatile("" : "+v"(ln_)); fr = ln_ & 15; fq = ln_ >> 4; }
        const int lrow0 = wr * 64 + fr, row0 = u.pm * 256 + lrow0, pn = u.pn;
        float rs[2][4];
#pragma unroll
        for (int ai = 0; ai < 2; ++ai)
#pragma unroll
            for (int m = 0; m < 4; ++m) rs[ai][m] = __builtin_amdgcn_rsqf(ssh[row0 + ai * 128 + m * 16] * (1.0f / 2048.0f) + 1e-6f);
        bf16_t* const outp = PROJ + (size_t)row0 * NP + pn * 256 + wc * 32 + 8 * fq;
        const bool is_norm = (pn <= 3) || (pn >= 9 && pn <= 12);
        if (is_norm) {
            const float* g = gt + ((pn <= 2) ? 0 : (pn == 3) ? 128 : (pn <= 10) ? 256 : 384);
            const float qs = (pn <= 2 || pn == 9 || pn == 10) ? QS_A : 1.0f;
#pragma unroll
            for (int ai = 0; ai < 2; ++ai)
#pragma unroll
                for (int m = 0; m < 4; ++m)
#pragma unroll
                    for (int bj = 0; bj < 2; ++bj) { float s = red_fq(sq4(acc[ai][bj][m][0]) + sq4(acc[ai][bj][m][1]));
                        if (fq == 0) TABL[((lrow0 + ai * 128 + m * 16) * 2 + bj) * 4 + wc] = s; asm volatile("" ::: "memory"); }
            EPI_BAR();
            const f32x4 g0 = *(const f32x4*)(g + 32 * wc + 8 * fq) * qs, g1 = *(const f32x4*)(g + 32 * wc + 8 * fq + 4) * qs;
#pragma unroll
            for (int ai = 0; ai < 2; ++ai)
#pragma unroll
                for (int m = 0; m < 4; ++m)
#pragma unroll
                    for (int bj = 0; bj < 2; ++bj) { const f32x4 t = *(const LAS f32x4*)&TABL[((lrow0 + ai * 128 + m * 16) * 2 + bj) * 4];
                        const float r2 = rs[ai][m] * rs[ai][m];
                        const float rn = rs[ai][m] * __builtin_amdgcn_rsqf(((t[0] + t[1]) + (t[2] + t[3])) * r2 * (1.0f / 128.0f) + 1e-6f);
                        *(u32x4*)(outp + (size_t)(ai * 128 + m * 16) * NP + bj * 128) = pack8(acc[ai][bj][m][0] * rn * g0, acc[ai][bj][m][1] * rn * g1);
                        asm volatile("" ::: "memory"); }
        } else if (pn >= 5 && pn <= 8) {
            float* ss = ss_cq + ((pn <= 6) ? 0 : 4 * TTOT);
#pragma unroll
            for (int ai = 0; ai < 2; ++ai)
#pragma unroll
                for (int m = 0; m < 4; ++m) { const float r = rs[ai][m];
                    float s = red_fq((sq4(acc[ai][0][m][0]) + sq4(acc[ai][0][m][1])) + (sq4(acc[ai][1][m][0]) + sq4(acc[ai][1][m][1]))) * (r * r);
                    if (fq == 0) unsafeAtomicAdd(ss + row0 + ai * 128 + m * 16, s);
#pragma unroll
                    for (int bj = 0; bj < 2; ++bj) *(u32x4*)(outp + (size_t)(ai * 128 + m * 16) * NP + bj * 128) = pack8(acc[ai][bj][m][0] * r, acc[ai][bj][m][1] * r);
                    asm volatile("" ::: "memory"); }
        } else if (pn >= 15 && pn <= 22) {
#pragma unroll
            for (int ai = 0; ai < 2; ++ai)
#pragma unroll
                for (int m = 0; m < 4; ++m) { const float r = rs[ai][m];
#pragma unroll
                    for (int bj = 0; bj < 2; ++bj) { f32x4 o0, o1;
#pragma unroll
                        for (int j = 0; j < 4; ++j) { const float v0 = acc[ai][bj][m][0][j] * r, v1 = acc[ai][bj][m][1][j] * r;
                            o0[j] = v0 * __builtin_amdgcn_rcpf(1.0f + __expf(-v0)); o1[j] = v1 * __builtin_amdgcn_rcpf(1.0f + __expf(-v1)); }
                        *(u32x4*)(outp + (size_t)(ai * 128 + m * 16) * NP + bj * 128) = pack8(o0, o1); }
                    asm volatile("" ::: "memory"); }
        } else if (pn == 23) {
            if (wc < 2) {
                const int gI = wc * 4 + fq;
                const f32x4 gk1 = *(const f32x4*)(g_kr + 4 * gI), gk2 = *(const f32x4*)(g_kr + 32 + 4 * gI);
#pragma unroll
                for (int ai = 0; ai < 2; ++ai)
#pragma unroll
                    for (int m = 0; m < 4; ++m) { const int row = row0 + ai * 128 + m * 16; const float r = rs[ai][m];
                        float s = red_fq(sq4(acc[ai][0][m][0]) + sq4(acc[ai][0][m][1])) * (r * r);
                        if (fq == 0) unsafeAtomicAdd(ss_kr + row, s);
                        const f32x4 x1 = acc[ai][0][m][0] * gk1 * r, x2 = acc[ai][0][m][1] * gk2 * r; f32x4 o1, o2;
                        const float2* tp = tab + (row & (SEQ - 1)) * 32 + 4 * gI;
#pragma unroll
                        for (int j = 0; j < 4; ++j) { const float2 cs = tp[j]; o1[j] = x1[j] * cs.x - x2[j] * cs.y; o2[j] = x1[j] * cs.y + x2[j] * cs.x; }
                        *(u32x4*)(PROJ + (size_t)row * NP + C_KR + 8 * gI) = pack8(o1, o2); asm volatile("" ::: "memory"); }
            }
        } else {
#pragma unroll
            for (int ai = 0; ai < 2; ++ai)
#pragma unroll
                for (int m = 0; m < 4; ++m) { const float r = rs[ai][m];
#pragma unroll
                    for (int bj = 0; bj < 2; ++bj) *(u32x4*)(outp + (size_t)(ai * 128 + m * 16) * NP + bj * 128) = pack8(acc[ai][bj][m][0] * r, acc[ai][bj][m][1] * r);
                    asm volatile("" ::: "memory"); }
        }
    }
};

struct EpiUQ {
    static constexpr int PROBE_ID = 12;
    static constexpr bool PERM = true;
    bf16_t* QB; const float* ss_cq; const float* gq; const float2* tab; LAS float* TABL;
    __device__ __forceinline__ void operator()(AccT& acc, const Unit& u, int wr, int wc, int fr, int fq) const {
        { int ln_ = lane_id(); asm volatile("" : "+v"(ln_)); fr = ln_ & 15; fq = ln_ >> 4; }
        const int lrow0 = wr * 64 + fr, row0 = u.pm * 256 + lrow0, h = u.pn;
        float rs[2][4];
#pragma unroll
        for (int ai = 0; ai < 2; ++ai)
#pragma unroll
            for (int m = 0; m < 4; ++m) rs[ai][m] = ss_cq[row0 + ai * 128 + m * 16];
#pragma unroll
        for (int ai = 0; ai < 2; ++ai)
#pragma unroll
            for (int m = 0; m < 4; ++m) { const float r = __builtin_amdgcn_rsqf(rs[ai][m] * (1.0f / 512.0f) + 1e-6f); rs[ai][m] = r;
#pragma unroll
                for (int bj = 0; bj < 2; ++bj) { float s = red_fq(sq4(acc[ai][bj][m][0]) + sq4(acc[ai][bj][m][1])) * (r * r);
                    if (fq == 0) TABL[((lrow0 + ai * 128 + m * 16) * 2 + bj) * 4 + wc] = s; } }
        EPI_BAR();
        const int gI = (wc & 1) * 4 + fq;
        const f32x4 g00 = *(const f32x4*)(gq + 32 * wc + 8 * fq), g01 = *(const f32x4*)(gq + 32 * wc + 8 * fq + 4);
        const f32x4 g10 = *(const f32x4*)(gq + 128 + 4 * gI), g11 = *(const f32x4*)(gq + 160 + 4 * gI);
#pragma unroll
        for (int ai = 0; ai < 2; ++ai) {
            float2 cs[4][4];
            if (wc < 2) {
#pragma unroll
                for (int m = 0; m < 4; ++m) { const float2* tp = tab + ((u.pm * 256 + lrow0 + ai * 128 + m * 16) & (SEQ - 1)) * 32 + 4 * gI;
#pragma unroll
                    for (int j = 0; j < 4; ++j) cs[m][j] = tp[j]; }
            }
#pragma unroll
            for (int m = 0; m < 4; ++m) { const int lrow = lrow0 + ai * 128 + m * 16, row = u.pm * 256 + lrow;
                const f32x4 t0 = *(const LAS f32x4*)&TABL[lrow * 8], t1 = *(const LAS f32x4*)&TABL[lrow * 8 + 4];
                const float rq = rs[ai][m] * QS_B * __builtin_amdgcn_rsqf((((t0[0] + t0[1]) + (t0[2] + t0[3])) + ((t1[0] + t1[1]) + (t1[2] + t1[3]))) * (1.0f / 192.0f) + 1e-6f);
                bf16_t* rowp = QB + (size_t)row * 1152 + h * 192 + 32 * wc + 8 * fq;
                *(u32x4*)rowp = pack8(acc[ai][0][m][0] * rq * g00, acc[ai][0][m][1] * rq * g01);
                if (wc < 2) {
                    const f32x4 x1 = acc[ai][1][m][0] * rq * g10, x2 = acc[ai][1][m][1] * rq * g11; f32x4 o1, o2;
#pragma unroll
                    for (int j = 0; j < 4; ++j) { o1[j] = x1[j] * cs[m][j].x - x2[j] * cs[m][j].y; o2[j] = x1[j] * cs[m][j].y + x2[j] * cs[m][j].x; }
                    *(u32x4*)(rowp + 128) = pack8(o1, o2);
                } }
            asm volatile("" ::: "memory");
        }
    }
};

struct EpiUKV {
    static constexpr int PROBE_ID = 13;
    static constexpr bool PERM = true;
    bf16_t *KB, *VB; const bf16_t* PROJ; const float *ss_ckv, *ss_kr; const float* gk; LAS float* TABL;
    __device__ __forceinline__ void operator()(AccT& acc, const Unit& u, int wr, int wc, int fr, int fq) const {
        { int ln_ = lane_id(); asm volatile("" : "+v"(ln_)); fr = ln_ & 15; fq = ln_ >> 4; }
        const int lrow0 = wr * 64 + fr, row0 = u.pm * 256 + lrow0, h = u.pn;
        const int i4 = (wc * 4 + fq) * 4;
        float rs[2][4], skr[2][4]; u32x2 rr[2][4];
#pragma unroll
        for (int ai = 0; ai < 2; ++ai)
#pragma unroll
            for (int m = 0; m < 4; ++m) { const int row = row0 + ai * 128 + m * 16; rs[ai][m] = ss_ckv[row]; skr[ai][m] = ss_kr[row]; rr[ai][m] = *(const u32x2*)(PROJ + (size_t)row * NP + C_KR + i4); }
#pragma unroll
        for (int ai = 0; ai < 2; ++ai)
#pragma unroll
            for (int m = 0; m < 4; ++m) { const float r = __builtin_amdgcn_rsqf(rs[ai][m] * (1.0f / 512.0f) + 1e-6f); rs[ai][m] = r;
                float s = red_fq(sq4(acc[ai][0][m][0]) + sq4(acc[ai][0][m][1])) * (r * r);
                if (fq == 0) TABL[(lrow0 + ai * 128 + m * 16) * 4 + wc] = s; }
        EPI_BAR();
        const f32x4 g0 = *(const f32x4*)(gk + 32 * wc + 8 * fq), g1 = *(const f32x4*)(gk + 32 * wc + 8 * fq + 4);
#pragma unroll
        for (int ai = 0; ai < 2; ++ai)
#pragma unroll
            for (int m = 0; m < 4; ++m) { const int lrow = lrow0 + ai * 128 + m * 16, row = u.pm * 256 + lrow; const float r = rs[ai][m];
                const f32x4 t = *(const LAS f32x4*)&TABL[lrow * 4];
                const float rk = __builtin_amdgcn_rsqf((((t[0] + t[1]) + (t[2] + t[3])) + skr[ai][m]) * (1.0f / 192.0f) + 1e-6f);
                bf16_t* kp = KB + (size_t)row * 1152 + h * 192;
                *(u32x4*)(kp + 32 * wc + 8 * fq) = pack8(acc[ai][0][m][0] * (r * rk) * g0, acc[ai][0][m][1] * (r * rk) * g1);
                *(u32x4*)(VB + (size_t)row * 768 + h * 128 + 32 * wc + 8 * fq) = pack8(acc[ai][1][m][0] * r, acc[ai][1][m][1] * r);
                const u32x2 q = rr[ai][m]; u32x2 o; o.x = cvt_pk_bf16(bflo(q.x) * rk, bfhi(q.x) * rk); o.y = cvt_pk_bf16(bflo(q.y) * rk, bfhi(q.y) * rk);
                *(u32x2*)(kp + 128 + i4) = o; }
    }
};

struct EpiOut {
    static constexpr int PROBE_ID = 11;
    static constexpr bool PERM = true;
    const float* hin; long hdelta; float* hout; bf16_t* hbA; float* ss_h2;
    __device__ __forceinline__ void operator()(AccT& acc, const Unit& u, int wr, int wc, int fr, int fq) const {
        { int ln_ = lane_id(); asm volatile("" : "+v"(ln_)); fr = ln_ & 15; fq = ln_ >> 4; }
        const int row0 = u.pm * 256 + wr * 64 + fr, col0 = u.pn * 256 + wc * 32 + 8 * fq;
#pragma unroll
        for (int ai = 0; ai < 2; ++ai)
#pragma unroll
            for (int mp = 0; mp < 2; ++mp) {
                f32x4 hv[2][2][2];
#pragma unroll
                for (int mm = 0; mm < 2; ++mm)
#pragma unroll
                    for (int bj = 0; bj < 2; ++bj)
#pragma unroll
                        for (int n = 0; n < 2; ++n) hv[mm][bj][n] = *(const f32x4*)(hin + (u.pm >= 32 ? hdelta : 0) + (size_t)(row0 + ai * 128 + (mp * 2 + mm) * 16) * DM + col0 + bj * 128 + n * 4);
#pragma unroll
                for (int mm = 0; mm < 2; ++mm) { const int m = mp * 2 + mm, row = row0 + ai * 128 + m * 16; const size_t off = (size_t)row * DM + col0; float s = 0.f;
#pragma unroll
                    for (int bj = 0; bj < 2; ++bj) { const f32x4 o0 = hv[mm][bj][0] + acc[ai][bj][m][0], o1 = hv[mm][bj][1] + acc[ai][bj][m][1];
                            *(f32x4*)(hout + off + bj * 128) = o0; *(f32x4*)(hout + off + bj * 128 + 4) = o1;
                            *(u32x4*)(hbA + off + bj * 128) = pack8(o0, o1); s += sq4(o0) + sq4(o1); }
                    s = red_fq(s); if (fq == 0) unsafeAtomicAdd(ss_h2 + row, s); }
            }
    }
};
struct EpiPP {
    static constexpr int PROBE_ID = 14;
    static constexpr bool PERM = true;
    bf16_t* PROJ; float* ss_pp; const float* g_post;
    __device__ __forceinline__ void operator()(AccT& acc, const Unit& u, int wr, int wc, int fr, int fq) const {
        { int ln_ = lane_id(); asm volatile("" : "+v"(ln_)); fr = ln_ & 15; fq = ln_ >> 4; }
        const int row0 = u.pm * 256 + wr * 64 + fr, colb = u.pn * 256 + wc * 32 + 8 * fq;
        f32x4 g[2][2];
#pragma unroll
        for (int bj = 0; bj < 2; ++bj) { g[bj][0] = *(const f32x4*)(g_post + colb + bj * 128); g[bj][1] = *(const f32x4*)(g_post + colb + bj * 128 + 4); }
#pragma unroll
        for (int ai = 0; ai < 2; ++ai)
#pragma unroll
            for (int m = 0; m < 4; ++m) { const int row = row0 + ai * 128 + m * 16; bf16_t* rowp = PROJ + (size_t)row * NP + colb; float s = 0.f;
#pragma unroll
                for (int bj = 0; bj < 2; ++bj) { *(u32x4*)(rowp + bj * 128) = pack8(acc[ai][bj][m][0] * g[bj][0], acc[ai][bj][m][1] * g[bj][1]); s += sq4(acc[ai][bj][m][0]) + sq4(acc[ai][bj][m][1]); }
                s = red_fq(s); if (fq == 0) unsafeAtomicAdd(ss_pp + row, s); }
    }
};
struct EpiGate {
    static constexpr int PROBE_ID = 9;
    static constexpr bool PERM = true;
    float* h; bf16_t* hbB; const bf16_t* PROJ; const float *ss_h2, *ss_pp; float* ss_next;
    __device__ __forceinline__ void operator()(AccT& acc, const Unit& u, int wr, int wc, int fr, int fq) const {
        { int ln_ = lane_id(); asm volatile("" : "+v"(ln_)); fr = ln_ & 15; fq = ln_ >> 4; }
        const int row0 = u.pm * 256 + wr * 64 + fr, col0 = u.pn * 256 + wc * 32 + 8 * fq;
        float rs2[2][4], rpp[2][4];
#pragma unroll
        for (int ai = 0; ai < 2; ++ai)
#pragma unroll
            for (int m = 0; m < 4; ++m) { rs2[ai][m] = ss_h2[row0 + ai * 128 + m * 16]; rpp[ai][m] = ss_pp[row0 + ai * 128 + m * 16]; }
#pragma unroll
        for (int ai = 0; ai < 2; ++ai)
#pragma unroll
            for (int mp = 0; mp < 2; ++mp) {
                f32x4 hv[2][2][2]; u32x2 pw[2][2][2];
#pragma unroll
                for (int mm = 0; mm < 2; ++mm)
#pragma unroll
                    for (int bj = 0; bj < 2; ++bj)
#pragma unroll
                        for (int n = 0; n < 2; ++n) { const int row = row0 + ai * 128 + (mp * 2 + mm) * 16, c = col0 + bj * 128 + n * 4;
                            hv[mm][bj][n] = *(const f32x4*)(h + (size_t)row * DM + c); if (n == 0) { const u32x4 q_ = *(const u32x4*)(PROJ + (size_t)row * NP + c); pw[mm][bj][0] = (u32x2){q_.x, q_.y}; pw[mm][bj][1] = (u32x2){q_.z, q_.w}; } }
#pragma unroll
                for (int mm = 0; mm < 2; ++mm) { const int m = mp * 2 + mm, row = row0 + ai * 128 + m * 16; const size_t off = (size_t)row * DM + col0;
                    const float r2 = __builtin_amdgcn_rsqf(rs2[ai][m] * (1.0f / 2048.0f) + 1e-6f), rp = __builtin_amdgcn_rsqf(rpp[ai][m] * (1.0f / 2048.0f) + 1e-6f); float s = 0.f;
#pragma unroll
                    for (int bj = 0; bj < 2; ++bj) { f32x4 oo[2];
#pragma unroll
                        for (int n = 0; n < 2; ++n) { const u32x2 pq = pw[mm][bj][n]; const f32x4 pp = {bflo(pq.x), bfhi(pq.x), bflo(pq.y), bfhi(pq.y)};
#pragma unroll
                            for (int j = 0; j < 4; ++j) { const float gate = __builtin_amdgcn_rcpf(1.0f + __expf(-r2 * acc[ai][bj][m][n][j])); oo[n][j] = hv[mm][bj][n][j] + gate * (pp[j] * rp); } }
                        *(f32x4*)(h + off + bj * 128) = oo[0]; *(f32x4*)(h + off + bj * 128 + 4) = oo[1];
                        *(u32x4*)(hbB + off + bj * 128) = pack8(oo[0], oo[1]); s += sq4(oo[0]) + sq4(oo[1]); }
                    if (ss_next) { s = red_fq(s); if (fq == 0) unsafeAtomicAdd(ss_next + row, s); } }
            }
    }
};

template <int MODE> __device__ __forceinline__ int srccol(int n) {
    if (MODE == 0) return n;
    if (MODE == 1) {
        if (n < 768) return O_AQ + n;
        if (n < 1024) return O_AK + (n - 768);
        if (n < 1280) return O_AV + (n - 1024);
        if (n < 1792) return O_BCQ + (n - 1280);
        if (n < 2304) return O_BCKV + (n - 1792);
        if (n < 2816) return O_CQ + (n - 2304);
        if (n < 3328) return O_CK + (n - 2816);
        if (n < 3840) return O_CV + (n - 3328);
        if (n < 4608) return O_AZ + (n - 3840);
        if (n < 5376) return O_BZ + (n - 4608);
        if (n < 5888) return O_CZ + (n - 5376);
        if (n < 5952) { const int i = n - 5888, g = i >> 3, e = i & 7; return O_BKR + (e < 4 ? 4 * g + e : 32 + 4 * g + (e - 4)); }
        return -1;
    }
    const int hh = n >> 8, c = n & 255;
    if (c < 128) return hh * 192 + c;
    if (c < 192) { const int i = c - 128, g = i >> 3, e = i & 7; return hh * 192 + 128 + (e < 4 ? 4 * g + e : 32 + 4 * g + (e - 4)); }
    return -1;
}
template <int MODE> __device__ __forceinline__ void cvt_tile(const float* src, int ldsrc, int K, const float* gain, bf16_t* dst, float* tile, int tn, int tk, int tid) {
    const int n0 = tn * 256, k0 = tk * 64;
#pragma unroll
    for (int i = 0; i < 8; ++i) { const int idx = tid + i * 512, kk = idx >> 6, ng = (idx & 63) * 4; const int sc = srccol<MODE>(n0 + ng);
        f32x4 v = {0.f, 0.f, 0.f, 0.f}; if (sc >= 0) v = *(const f32x4*)(src + (size_t)(k0 + kk) * ldsrc + sc); if (gain) v *= gain[k0 + kk];
        float* tp = tile + kk * 257 + ng; tp[0] = v[0]; tp[1] = v[1]; tp[2] = v[2]; tp[3] = v[3]; }
    __syncthreads();
#pragma unroll
    for (int i = 0; i < 16; ++i) { const int idx = tid + i * 512, nn = idx >> 5, kp = (idx & 31) * 2;
        *(unsigned*)(dst + (size_t)(n0 + nn) * K + k0 + kp) = cvt_pk_bf16(tile[kp * 257 + nn], tile[(kp + 1) * 257 + nn]); }
    __syncthreads();
}

namespace at {
typedef float f32x16 __attribute__((ext_vector_type(16)));
typedef short s16x4 __attribute__((ext_vector_type(4)));
#define AT_SBAR() __builtin_amdgcn_sched_barrier(0)
constexpr int KVBLK = 64;
constexpr float THR = 8.f, NEGINF = -__builtin_huge_valf();
constexpr int OFF_V = 0, OFF_K = 32768, OFF_WS = 32768 + 51200, OFF_TB = OFF_WS + 2048, TB_PITCH = 160, OFF_SLOT = OFF_TB + 9600, OFF_QR = 95744;
__device__ __forceinline__ int crow(int r, int hi) { return (r & 3) + 8 * (r >> 2) + 4 * hi; }
constexpr int creg(int r) { return (r & 3) + 8 * (r >> 2); }
__device__ __forceinline__ int v_st(int k, int c) { const int kk = (k & ~0xC) | ((k & 4) << 1) | ((k & 8) >> 1); return ((kk >> 3) * 4 + (c >> 5)) * 512 + ((kk & 7) * 32 + (c & 31)) * 2; }
__device__ __forceinline__ int v_rd_base(int lane) { return ((lane & 3) << 3) | (((lane >> 2) & 3) << 6) | (((lane >> 4) & 1) << 5) | (((lane >> 5) & 1) << 8); }
constexpr int v_rd_off(int d0, int ks, int half) { return d0 * 512 + ks * 4096 + half * 2048; }
template <int OFF> __device__ __forceinline__ s16x4 tr_read(int vb) { s16x4 r; asm volatile("ds_read_b64_tr_b16 %0, %1 offset:%2" : "=&v"(r) : "v"(vb), "i"(OFF) : "memory"); return r; }
template <int D0> __device__ __forceinline__ void pv_one(f32x16& od, int vb, bf16x8 pa0, bf16x8 pa1, bf16x8 pa2, bf16x8 pa3) {
    const s16x4 l0 = tr_read<v_rd_off(D0, 0, 0)>(vb), h0 = tr_read<v_rd_off(D0, 0, 1)>(vb), l1 = tr_read<v_rd_off(D0, 1, 0)>(vb), h1 = tr_read<v_rd_off(D0, 1, 1)>(vb);
    const s16x4 l2 = tr_read<v_rd_off(D0, 2, 0)>(vb), h2 = tr_read<v_rd_off(D0, 2, 1)>(vb), l3 = tr_read<v_rd_off(D0, 3, 0)>(vb), h3 = tr_read<v_rd_off(D0, 3, 1)>(vb);
    asm volatile("s_waitcnt lgkmcnt(0)" ::: "memory"); AT_SBAR();
#define AT_PK(L, H) (bf16x8){L[0], L[1], L[2], L[3], H[0], H[1], H[2], H[3]}
    od = __builtin_amdgcn_mfma_f32_32x32x16_bf16(pa0, AT_PK(l0, h0), od, 0, 0, 0);
    od = __builtin_amdgcn_mfma_f32_32x32x16_bf16(pa1, AT_PK(l1, h1), od, 0, 0, 0);
    od = __builtin_amdgcn_mfma_f32_32x32x16_bf16(pa2, AT_PK(l2, h2), od, 0, 0, 0);
    od = __builtin_amdgcn_mfma_f32_32x32x16_bf16(pa3, AT_PK(l3, h3), od, 0, 0, 0);
#undef AT_PK
}
__device__ __forceinline__ void pv_d0(f32x16* o, int vb, bf16x8 pa0, bf16x8 pa1, bf16x8 pa2, bf16x8 pa3) {
    pv_one<0>(o[0], vb, pa0, pa1, pa2, pa3); pv_one<1>(o[1], vb, pa0, pa1, pa2, pa3); pv_one<2>(o[2], vb, pa0, pa1, pa2, pa3); pv_one<3>(o[3], vb, pa0, pa1, pa2, pa3);
}
__device__ __forceinline__ void partialSM(f32x16& p0, f32x16& p1, float& m_reg, float& mn, float& alpha) {
    float pmax = p0[0];
#pragma unroll
    for (int r = 1; r < 16; ++r) pmax = fmaxf(pmax, p0[r]);
#pragma unroll
    for (int r = 0; r < 16; ++r) pmax = fmaxf(pmax, p1[r]);
    { auto rr = __builtin_amdgcn_permlane32_swap(__float_as_uint(pmax), __float_as_uint(pmax), false, false); pmax = fmaxf(__uint_as_float(rr[0]), __uint_as_float(rr[1])); }
    if (__builtin_expect(__all(pmax - m_reg <= THR), 1)) { mn = m_reg; alpha = 1.f; }
    else { mn = fmaxf(m_reg, pmax); alpha = __builtin_amdgcn_exp2f(m_reg - mn); m_reg = mn; }
#pragma unroll
    for (int r = 0; r < 16; ++r) { p0[r] -= mn; p1[r] -= mn; }
#pragma unroll
    for (int r = 0; r < 16; ++r) p0[r] = __builtin_amdgcn_exp2f(p0[r]);
}
__device__ __forceinline__ void finishSM(f32x16& p0, f32x16& p1, float alpha, float& l_reg, bf16x8& pa0, bf16x8& pa1, bf16x8& pa2, bf16x8& pa3) {
#pragma unroll
    for (int r = 0; r < 16; ++r) p1[r] = __builtin_amdgcn_exp2f(p1[r]);
    float ps = 0;
#pragma unroll
    for (int r = 0; r < 16; ++r) ps += p0[r];
#pragma unroll
    for (int r = 0; r < 16; ++r) ps += p1[r];
    { auto rr = __builtin_amdgcn_permlane32_swap(__float_as_uint(ps), __float_as_uint(ps), false, false); ps = __uint_as_float(rr[0]) + __uint_as_float(rr[1]); }
    l_reg = l_reg * alpha + ps;
#define AT_PK4(P, BASE, OUT) do { unsigned a0 = cvt_pk_bf16(P[BASE + 0], P[BASE + 1]), a1 = cvt_pk_bf16(P[BASE + 2], P[BASE + 3]); \
        unsigned b0 = cvt_pk_bf16(P[BASE + 4], P[BASE + 5]), b1 = cvt_pk_bf16(P[BASE + 6], P[BASE + 7]); \
        auto r0 = __builtin_amdgcn_permlane32_swap(a0, b0, false, false); auto r1 = __builtin_amdgcn_permlane32_swap(a1, b1, false, false); \
        u32x4 w = {r0[0], r1[0], r0[1], r1[1]}; OUT = *reinterpret_cast<bf16x8*>(&w); } while (0)
    AT_PK4(p0, 0, pa0); AT_PK4(p0, 8, pa1); AT_PK4(p1, 0, pa2); AT_PK4(p1, 8, pa3);
#undef AT_PK4
}

template <int MODE> struct Cfg;
template <> struct Cfg<0> { static constexpr int DQK = 128, LDQ = NP, LDK = NP, LDV = NP; };
template <> struct Cfg<1> { static constexpr int DQK = 192, LDQ = 1152, LDK = 1152, LDV = 768; };
template <> struct Cfg<2> { static constexpr int DQK = 128, LDQ = NP, LDK = NP, LDV = NP; };

template <int MODE>
__device__ __forceinline__ void attn_unit(const bf16_t* __restrict__ Qb, const bf16_t* __restrict__ Kh, const bf16_t* __restrict__ Vh, bf16_t* __restrict__ Yb,
                                          int pos0, int h, const float* __restrict__ extra, char* lds, int wid_s) {
    constexpr int DQK = Cfg<MODE>::DQK, LDQ = Cfg<MODE>::LDQ, LDK = Cfg<MODE>::LDK, LDV = Cfg<MODE>::LDV, ND = DQK / 16, KPITCH = DQK * 2 + 16, SHM_K = 64 * KPITCH, SHM_V = 16384;
    int tid = wid_s * 64 + lane_id(); asm volatile("" : "+v"(tid));
    const int wid = tid >> 6, lane = tid & 63, r32 = lane & 31, hi = lane >> 5;
    char* V_lds = lds + OFF_V; char* K_lds = lds + OFF_K;
    float* wsw = (float*)(lds + OFF_WS) + wid * 64; float* li_l = wsw; float* al_l = wsw + 32;
    int klo, NT;
    if (MODE == 0) { klo = max(0, pos0 - 128); NT = (min(SEQ, pos0 + 384) - klo) >> 6; }
    else if (MODE == 1) { klo = 0; NT = SEQ / 64; }
    else { const int r0 = pos0 >> 6; const int lo = min(max(r0 - 4, 0), 24), hiR = min(max(r0 + 3 - 4, 0), 24) + 8; NT = hiR - lo; if (NT & 1) NT += 1; klo = lo * 64; }
    float slope2 = 0.f; int dbase0 = 0; int cs = 0; bool dummy = false; (void)dummy;
    const float* tbl = nullptr; int rq = 0, rsq = 0;
    if (MODE == 0) { slope2 = exp2f(-8.0f * (float)(h + 1) * (1.0f / 6.0f)) * LOG2E; dbase0 = klo + 4 * hi - (pos0 + wid * 32 + r32); }
    if (MODE == 2) {
        float* TB = (float*)(lds + OFF_TB);
        for (int i = tid; i < 15 * 31; i += 512) { const int a = i / 31, b = i - a * 31; TB[a * TB_PITCH + 64 + b] = extra[i] * LOG2E; }
        const int c = (wid & 1) * 32 + r32; rq = (pos0 >> 6) + (wid >> 1); rsq = min(max(rq - 4, 0), 24); cs = min(max(c - 8, 0), 48);
        tbl = TB + 64 + 15 - c + 4 * hi;
    }
    float m_reg = -1e30f, l_reg = 0; f32x16 o[4];
#pragma unroll
    for (int d = 0; d < 4; ++d)
#pragma unroll
        for (int r = 0; r < 16; ++r) o[d][r] = 0.f;
    bf16x8 qr[8];
    char* QR = lds + OFF_QR + (wid * 32 + r32) * 144 + hi * 16;
    { const bf16_t* Qw = Qb + (size_t)(wid * 32 + r32) * LDQ + hi * 8;
#pragma unroll
      for (int d0 = 0; d0 < 8; ++d0) qr[d0] = *(const bf16x8*)(Qw + d0 * 16);
      if (DQK == 192) {
#pragma unroll
          for (int d0 = 0; d0 < 4; ++d0) *(bf16x8*)(QR + d0 * 32) = *(const bf16x8*)(Qw + 128 + d0 * 16); } }
    const int sr = tid >> 4, sc = (tid & 15) * 8, vst0 = v_st(sr, sc), vst1 = v_st(32 + sr, sc);
    const int sr2 = tid >> 3, sc2 = 128 + (tid & 7) * 8;
    const int vb0 = (int)(uintptr_t)(LAS char*)V_lds + v_rd_base(lane);
    const char* kbase = K_lds + r32 * KPITCH + hi * 16;
    const bf16_t* Kg = Kh + (size_t)klo * LDK; const bf16_t* Vg = Vh + (size_t)klo * LDV;
    bf16x8 sAvv0, sAvv1, sAkk0, sAkk1, sAkk2, sBvv0, sBvv1, sBkk0, sBkk1, sBkk2;
#define AT_KSWZ(row, colB) ((row) * KPITCH + (colB))
#define AT_SLOAD(S, koff) do { S##vv0 = *(const bf16x8*)(Vg + (size_t)((koff) + sr) * LDV + sc); S##vv1 = *(const bf16x8*)(Vg + (size_t)((koff) + 32 + sr) * LDV + sc); \
        S##kk0 = *(const bf16x8*)(Kg + (size_t)((koff) + sr) * LDK + sc); S##kk1 = *(const bf16x8*)(Kg + (size_t)((koff) + 32 + sr) * LDK + sc); \
        if (DQK == 192) S##kk2 = *(const bf16x8*)(Kg + (size_t)((koff) + sr2) * LDK + sc2); } while (0)
#define AT_SWRITE(b, S) do { *(bf16x8*)(V_lds + (b) * SHM_V + vst0) = S##vv0; *(bf16x8*)(V_lds + (b) * SHM_V + vst1) = S##vv1; \
        *(bf16x8*)(K_lds + (b) * SHM_K + AT_KSWZ(sr, sc * 2)) = S##kk0; *(bf16x8*)(K_lds + (b) * SHM_K + AT_KSWZ(32 + sr, sc * 2)) = S##kk1; \
        if (DQK == 192) *(bf16x8*)(K_lds + (b) * SHM_K + AT_KSWZ(sr2, sc2 * 2)) = S##kk2; } while (0)
#define AT_SWAIT() do { if (DQK == 192) asm volatile("s_waitcnt vmcnt(5)" ::: "memory"); else asm volatile("s_waitcnt vmcnt(4)" ::: "memory"); } while (0)
#define AT_RESC(a) do { if (__any((a) < 1.f)) { if (hi == 0) al_l[r32] = (a); asm volatile("s_waitcnt lgkmcnt(0)" ::: "memory"); \
        _Pragma("unroll") for (int d = 0; d < 4; ++d) _Pragma("unroll") for (int r = 0; r < 16; ++r) o[d][r] *= al_l[crow(r, hi)]; } } while (0)
#define AT_QKT(P0, P1, b) do { const char* Ks_ = kbase + (b) * SHM_K; \
        _Pragma("unroll") for (int r = 0; r < 16; ++r) { P0[r] = 0.f; P1[r] = 0.f; } \
        _Pragma("unroll") for (int d0 = 0; d0 < ND; ++d0) { \
            const bf16x8 b0 = *(const bf16x8*)(Ks_ + d0 * 32), b1 = *(const bf16x8*)(Ks_ + 32 * KPITCH + d0 * 32); \
            const bf16x8 qf_ = d0 < 8 ? qr[d0 & 7] : *(const bf16x8*)(QR + ((d0 - 8) & 3) * 32); \
            P0 = __builtin_amdgcn_mfma_f32_32x32x16_bf16(b0, qf_, P0, 0, 0, 0); P1 = __builtin_amdgcn_mfma_f32_32x32x16_bf16(b1, qf_, P1, 0, 0, 0); } } while (0)
#define AT_MASK(P0, P1, j) do { \
        if (MODE == 0) { const int db = dbase0 + (j) * 64; \
            _Pragma("unroll") for (int r = 0; r < 16; ++r) { const int d0_ = db + creg(r), d1_ = d0_ + 32; const int a0_ = d0_ < 0 ? -d0_ : d0_, a1_ = d1_ < 0 ? -d1_ : d1_; \
                P0[r] = a0_ <= 128 ? P0[r] - slope2 * (float)a0_ : NEGINF; P1[r] = a1_ <= 128 ? P1[r] - slope2 * (float)a1_ : NEGINF; } } \
        if (MODE == 2) { const int kr_ = (klo >> 6) + (j); const bool tok_ = (kr_ >= rsq) && (kr_ < rsq + 8); const int di_ = min(max(kr_ - rq + 7, 0), 14); \
            const float* tb_ = tbl + di_ * TB_PITCH; const int kc0_ = 4 * hi - cs; \
            _Pragma("unroll") for (int r = 0; r < 16; ++r) { const unsigned u0_ = (unsigned)(kc0_ + creg(r)), u1_ = (unsigned)(kc0_ + creg(r) + 32); \
                P0[r] = (tok_ && u0_ < 16u) ? P0[r] + tb_[creg(r)] : NEGINF; P1[r] = (tok_ && u1_ < 16u) ? P1[r] + tb_[creg(r) + 32] : NEGINF; } } } while (0)
    f32x16 pA0, pA1, pB0, pB1; float mnA, mnB, alA, alB; bf16x8 pa0, pa1, pa2, pa3;
    __syncthreads();
    constexpr int SD = (MODE == 1) ? 1 : 2;
    AT_SLOAD(sA, 0); asm volatile("s_waitcnt vmcnt(0)" ::: "memory"); AT_SWRITE(0, sA); __syncthreads();
    AT_QKT(pA0, pA1, 0); AT_MASK(pA0, pA1, 0); partialSM(pA0, pA1, m_reg, mnA, alA);
    if (SD == 2) { AT_SLOAD(sB, KVBLK); if (2 < NT) AT_SLOAD(sA, 2 * KVBLK); AT_SWAIT(); AT_SWRITE(1, sB); }
    else { AT_SLOAD(sA, KVBLK); AT_SWRITE(1, sA); }
    __syncthreads();
    for (int j = 1; j + 1 < NT; j += 2) {
        AT_SBAR(); AT_QKT(pB0, pB1, 1); AT_MASK(pB0, pB1, j);
        finishSM(pA0, pA1, alA, l_reg, pa0, pa1, pa2, pa3); AT_SBAR();
        if (SD == 2) AT_SLOAD(sB, (j + 2) * KVBLK); else AT_SLOAD(sA, (j + 1) * KVBLK);
        AT_SBAR();
        pv_d0(o, vb0, pa0, pa1, pa2, pa3); partialSM(pB0, pB1, m_reg, mnB, alB);
        __syncthreads(); if (SD == 2) AT_SWAIT(); AT_SWRITE(0, sA);
        AT_RESC(alB); __syncthreads();
        AT_SBAR(); AT_QKT(pA0, pA1, 0); AT_MASK(pA0, pA1, j + 1);
        finishSM(pB0, pB1, alB, l_reg, pa0, pa1, pa2, pa3); AT_SBAR();
        if (SD == 2) { if (j + 3 < NT) AT_SLOAD(sA, (j + 3) * KVBLK); } else AT_SLOAD(sA, (j + 2) * KVBLK);
        AT_SBAR();
        pv_d0(o, vb0 + SHM_V, pa0, pa1, pa2, pa3); partialSM(pA0, pA1, m_reg, mnA, alA);
        __syncthreads(); if (SD == 2) { AT_SWAIT(); AT_SWRITE(1, sB); } else AT_SWRITE(1, sA);
        AT_RESC(alA); __syncthreads();
    }
    AT_SBAR(); AT_QKT(pB0, pB1, 1); AT_MASK(pB0, pB1, NT - 1);
    finishSM(pA0, pA1, alA, l_reg, pa0, pa1, pa2, pa3); AT_SBAR();
    pv_d0(o, vb0, pa0, pa1, pa2, pa3); partialSM(pB0, pB1, m_reg, mnB, alB);
    __syncthreads(); AT_RESC(alB);
    finishSM(pB0, pB1, alB, l_reg, pa0, pa1, pa2, pa3); AT_SBAR();
    pv_d0(o, vb0 + SHM_V, pa0, pa1, pa2, pa3);
    float fin;
    if (MODE == 0) { const float sk = extra[0] * LOG2E, mf = fmaxf(m_reg, sk), a = __builtin_amdgcn_exp2f(m_reg - mf); fin = a * __builtin_amdgcn_rcpf(l_reg * a + __builtin_amdgcn_exp2f(sk - mf)); }
    else fin = __builtin_amdgcn_rcpf(l_reg);
    if (hi == 0) li_l[r32] = fin;
    asm volatile("s_waitcnt lgkmcnt(0)" ::: "memory");
    __syncthreads();
    bf16_t* Ot = (bf16_t*)lds + wid * (32 * 136);
#pragma unroll
    for (int r = 0; r < 16; ++r) { const int orow = crow(r, hi); const float f = li_l[orow];
#pragma unroll
        for (int d0 = 0; d0 < 4; ++d0) Ot[orow * 136 + d0 * 32 + r32] = (bf16_t)(cvt_pk_bf16(o[d0][r] * f, 0.f) & 0xffffu); }
    asm volatile("s_waitcnt lgkmcnt(0)" ::: "memory");
#pragma unroll
    for (int i = 0; i < 8; ++i) { const int idx = i * 64 + lane, row = idx >> 4, c8 = (idx & 15) * 8;
        const u32x4 ov = *(const u32x4*)(Ot + row * 136 + c8);
        bf16_t* yp = Yb + (size_t)(wid * 32 + row) * NP + c8; const u32x4 sg = *(const u32x4*)yp; u32x4 w;
        w.x = cvt_pk_bf16(bflo(ov.x) * bflo(sg.x), bfhi(ov.x) * bfhi(sg.x)); w.y = cvt_pk_bf16(bflo(ov.y) * bflo(sg.y), bfhi(ov.y) * bfhi(sg.y));
        w.z = cvt_pk_bf16(bflo(ov.z) * bflo(sg.z), bfhi(ov.z) * bfhi(sg.z)); w.w = cvt_pk_bf16(bflo(ov.w) * bflo(sg.w), bfhi(ov.w) * bfhi(sg.w));
        *(u32x4*)yp = w; }
#undef AT_KSWZ
#undef AT_SLOAD
#undef AT_SWRITE
#undef AT_SWAIT
#undef AT_RESC
#undef AT_QKT
#undef AT_MASK
}
}


constexpr int CVT_ITEMS = 1408 + 160;
__device__ __forceinline__ void cvt_item(const Params& p, unsigned char* wsl, int l, int r, float* ldsf, int wtid) {
    if (r < 768) cvt_tile<1>(p.w_in + (size_t)l * DM * INW, INW, DM, p.norm_in + l * DM, (bf16_t*)(wsl + OFF_WIN), ldsf, r >> 5, r & 31, wtid);
    else if (r < 816) cvt_tile<2>(p.b_w_uq + (size_t)l * 512 * 1152, 1152, 512, p.b_cq_norm + l * 512, (bf16_t*)(wsl + OFF_WUQ), ldsf, (r - 768) >> 3, (r - 768) & 7, wtid);
    else if (r < 864) cvt_tile<0>(p.b_w_ukv + (size_t)l * 512 * 1536, 1536, 512, p.b_ckv_norm + l * 512, (bf16_t*)(wsl + OFF_WUKV), ldsf, (r - 816) >> 3, (r - 816) & 7, wtid);
    else if (r < 1120) cvt_tile<0>(p.w_out + (size_t)l * DM * DM, DM, DM, nullptr, (bf16_t*)(wsl + OFF_WOUT), ldsf, (r - 864) >> 5, (r - 864) & 31, wtid);
    else if (r < 1376) cvt_tile<0>(p.w_gate + (size_t)l * DM * DM, DM, DM, p.ple_norm + l * DM, (bf16_t*)(wsl + OFF_WGATE), ldsf, (r - 1120) >> 5, (r - 1120) & 31, wtid);
    else if (r < 1408) cvt_tile<0>(p.w_proj + (size_t)l * 256 * DM, DM, 256, nullptr, (bf16_t*)(wsl + OFF_WPROJ), ldsf, (r - 1376) >> 2, (r - 1376) & 3, wtid);
    else { const int t0 = (r - 1408) * 256; bf16_t* PBl = (bf16_t*)(wsl + OFF_PB);
        const float* srcb = t0 < 8192 ? p.p_prompt + ((size_t)l * 8192 + t0) * 256 : p.p_sample + ((size_t)l * 32768 + (t0 - 8192)) * 256;
#pragma unroll 4
        for (int i = wtid; i < 256 * 256 / 8; i += 512) { const int e = i * 8; *(u32x4*)(PBl + (size_t)t0 * 256 + e) = pack8(*(const f32x4*)(srcb + e), *(const f32x4*)(srcb + e + 4)); } }
}

#define XB_TMO      128
#define XB_XCNT(j)  (256  + 64 * (j))
#define XB_XSUB(j)  (1280 + 64 * (j))
#define XB_XGEN(j)  (2304 + 64 * (j))
#define XB_TOP      3328
#define XB_TOPGEN   3392
#define XCD_BAR_WORDS 3456
#define XB_SPIN_CAP (1u << 18)
__device__ __forceinline__ unsigned xb_ld(unsigned* p)              { return __hip_atomic_load(p, __ATOMIC_RELAXED, __HIP_MEMORY_SCOPE_AGENT); }
__device__ __forceinline__ unsigned xb_add(unsigned* p, unsigned v) { return __hip_atomic_fetch_add(p, v, __ATOMIC_RELAXED, __HIP_MEMORY_SCOPE_AGENT); }
__device__ __forceinline__ unsigned xb_xcc_id() { return (unsigned)__builtin_amdgcn_s_getreg((3 << 11) | 20) & 0xFu; }
#define XB_SPIN(cond, bar) do { unsigned _sp = 0; while (cond) { __builtin_amdgcn_s_sleep(1); \
    if ((++_sp & 255u) == 0u) { if (xb_ld(&(bar)[XB_TMO])) break; if (_sp > XB_SPIN_CAP) { atomicAdd(&(bar)[XB_TMO], 1u); break; } } } } while (0)
struct XcdBarrier { unsigned* bar; unsigned x; volatile LAS unsigned* st; };
__device__ __forceinline__ void xcd_barrier_complete(unsigned* bar, unsigned x, unsigned& nloc, unsigned& nx) {
    const unsigned G = gridDim.x * gridDim.y * gridDim.z;
    unsigned sum, cnt, mine, sp = 0u;
    for (;;) {
        sum = 0u; cnt = 0u; mine = 0u;
#pragma unroll
        for (unsigned j = 0; j < 16; ++j) { const unsigned c = xb_ld(&bar[XB_XCNT(j)]); sum += c; cnt += (c > 0u) ? 1u : 0u; mine = (j == x) ? c : mine; }
        if (sum == G) break;
        __builtin_amdgcn_s_sleep(1);
        if ((++sp & 255u) == 0u) { if (xb_ld(&bar[XB_TMO])) break; if (sp > XB_SPIN_CAP) { atomicAdd(&bar[XB_TMO], 1u); break; } }
    }
    nloc = mine > 0u ? mine : 1u; nx = cnt > 0u ? cnt : 1u;
}
__device__ __forceinline__ void xcd_barrier(const XcdBarrier& b, bool leader_thread) {
    asm volatile("s_waitcnt vmcnt(0)" ::: "memory");
    __syncthreads();
    if (leader_thread) {
        unsigned* bar = b.bar;
        __builtin_amdgcn_s_waitcnt(0);
        unsigned nloc = b.st[0], nx = b.st[1];
        if (nloc == 0u) { xcd_barrier_complete(bar, b.x, nloc, nx); b.st[0] = nloc; b.st[1] = nx; }
        const unsigned old = xb_add(&bar[XB_XSUB(b.x)], 1u);
        const unsigned gen = old / nloc;
        if (old + 1u == (gen + 1u) * nloc) {
            __builtin_amdgcn_fence(__ATOMIC_RELEASE, "agent");
            asm volatile("s_waitcnt vmcnt(0)" ::: "memory");
            const unsigned og = xb_add(&bar[XB_TOP], 1u);
            const unsigned tg = og / nx;
            if (og + 1u == (tg + 1u) * nx) xb_add(&bar[XB_TOPGEN], 1u);
            else XB_SPIN(xb_ld(&bar[XB_TOPGEN]) == tg, bar);
            __builtin_amdgcn_fence(__ATOMIC_ACQUIRE, "agent");
            xb_add(&bar[XB_XGEN(b.x)], 1u);
            asm volatile("s_waitcnt vmcnt(0)" ::: "memory");
        } else {
            XB_SPIN(xb_ld(&bar[XB_XGEN(b.x)]) == gen, bar);
            __builtin_amdgcn_fence(__ATOMIC_ACQUIRE, "agent");
            asm volatile("s_waitcnt vmcnt(0)" ::: "memory");
        }
    }
    __syncthreads();
}

__global__ __launch_bounds__(512, 2) void hymba_fwd(Params p) {
    extern __shared__ __attribute__((aligned(16))) unsigned char shm[];
    cg::grid_group grid = cg::this_grid();
    LAS unsigned char* lds = (LAS unsigned char*)shm;
    LAS float* TABL = (LAS float*)(lds + LDS_STAGE);
    float* ldsf = (float*)shm;
    unsigned char* ws = p.ws;
    bf16_t* HBB = (bf16_t*)(ws + OFF_HBB); bf16_t* PROJ = (bf16_t*)(ws + OFF_PROJ);
    bf16_t* QB = (bf16_t*)(ws + OFF_QB); bf16_t* KB = (bf16_t*)(ws + OFF_KB); bf16_t* VB = (bf16_t*)(ws + OFF_VB); bf16_t* HBA = QB;
    float* SS = (float*)(ws + OFF_SS); float2* tab = (float2*)(ws + OFF_TAB); float* GT = (float*)(ws + OFF_GT); unsigned* CTR = (unsigned*)(ws + OFF_CTR);
#define SSP(kind, l) (SS + ((size_t)(kind) * 4 + (l)) * TTOT)
    const int wid_s = __builtin_amdgcn_readfirstlane((int)threadIdx.x >> 6);
    volatile LAS unsigned* xbst = (volatile LAS unsigned*)((LAS unsigned char*)shm + LDS_XB);
    if (threadIdx.x == 0) { xbst[0] = 0u; xbst[1] = 0u; xbst[2] = 0u; xbst[3] = 0u; }
    __syncthreads();
#define XBAR_NOW() ({ XcdBarrier b_; b_.bar = (unsigned*)(p.ws + OFF_BAR); b_.x = xb_xcc_id(); b_.st = (volatile LAS unsigned*)((LAS unsigned char*)shm + LDS_XB); b_; })
    const int tid = threadIdx.x, gthreads = gridDim.x * 512, gtid = blockIdx.x * 512 + tid;
#if PROBE_SEL
    unsigned long long t_acc = 0, t_mark = __builtin_amdgcn_s_memrealtime();
#define PROBE_MARK(cat) do { const unsigned long long n_ = __builtin_amdgcn_s_memrealtime(); if (PROBE_SEL == 8 || (cat) == PROBE_SEL) t_acc += n_ - t_mark; t_mark = n_; } while (0)
#define PROBE_TACC (&t_acc)
#else
#define PROBE_MARK(cat) do { } while (0)
#define PROBE_TACC nullptr
#endif

    for (int i = gtid; i < 5 * 4 * TTOT; i += gthreads) { const int kind = 1 + i / (4 * TTOT), rem = i % (4 * TTOT); SS[(size_t)kind * 4 * TTOT + rem] = 0.f; }
    for (int i = gtid; i < 3 * TTOT; i += gthreads) SS[TTOT + i] = 0.f;
    if (gtid < 32) CTR[gtid] = 0u;
    for (int i = gtid; i < XCD_BAR_WORDS; i += gthreads) ((unsigned*)(p.ws + OFF_BAR))[i] = 0u;
    if (gtid < 2048) { const int l = gtid >> 9, w = (gtid >> 7) & 3, d = gtid & 127; float v;
        if (w == 0) v = p.a_q_norm[l * 128 + d]; else if (w == 1) v = p.a_k_norm[l * 128 + d]; else if (w == 2) v = p.c_q_norm[l * 128 + d]; else v = p.c_k_norm[l * 128 + d];
        GT[gtid] = v; }
    for (int i = gtid; i < SEQ * 32; i += gthreads) { const int pos = i >> 5, j = i & 31; const double ang = (double)pos * pow(10000.0, -(double)j / 32.0); tab[i] = make_float2((float)cos(ang), (float)sin(ang)); }
    {
        const int gw = gtid >> 6, nw = gthreads >> 6, lane = tid & 63;
        for (int row = gw; row < TTOT; row += nw) {
            const float* src = row < 8192 ? p.x_prompt + (size_t)row * DM : p.x_sample + (size_t)(row - 8192) * DM; float s = 0.f;
#pragma unroll
            for (int i = 0; i < 4; ++i) { const int c = (i * 64 + lane) * 8; const f32x4 a = *(const f32x4*)(src + c), b = *(const f32x4*)(src + c + 4);
                s += sq4(a) + sq4(b); *(u32x4*)(HBB + (size_t)row * DM + c) = pack8(a, b); }
            s = wave_sum(s); if (lane == 0) SSP(0, 0)[row] = s;
        }
    }

    for (int l = 0; l < 4; ++l) {
        unsigned char* const wsl = ws + (size_t)(l & 1) * SZ_LAYER;
        if (l == 0) {
            int wtid = wid_s * 64 + lane_id(); asm volatile("" : "+v"(wtid));
            for (int r = blockIdx.x; r < CVT_ITEMS; r += gridDim.x) cvt_item(p, wsl, 0, r, ldsf, wtid);
            PROBE_MARK(1); grid.sync(); PROBE_MARK(7);
            if (wid_s == 0 && lane_id() == 0) (void)xb_add(&((unsigned*)(p.ws + OFF_BAR))[XB_XCNT(xb_xcc_id())], 1u);
        }
        {
            constexpr int r0 = 0, TC = TTOT;
            pg8::StaticOrder S;
            {
                pg8::Gemm g{HBB + (size_t)r0 * DM, (const bf16_t*)(wsl + OFF_WIN), DM, TC, NP, DM};
                EpiProj E{PROJ, SSP(0, l) + r0, SSP(3, l) + r0, SSP(5, l) + r0, GT + l * 512, p.b_k_norm + l * 192 + 128, tab, TABL};
                S.init(TC, NP, gridDim.x, blockIdx.x); pg8::gemm_phase(lds, g, S, E, wid_s, PROBE_TACC);
            }
            PROBE_MARK(2); xcd_barrier(XBAR_NOW(), wid_s == 0 && lane_id() == 0); PROBE_MARK(7);
            {
                pg8::Gemm g{PROJ + C_BCQ, (const bf16_t*)(wsl + OFF_WUQ), NP, TC, 1536, 512};
                EpiUQ E{QB, SSP(3, l) + r0, p.b_q_norm + l * 192, tab, TABL};
                S.init(TC, 1536, gridDim.x, blockIdx.x); pg8::gemm_phase(lds, g, S, E, wid_s, PROBE_TACC);
            }
            {
                pg8::Gemm g{PROJ + C_BCKV, (const bf16_t*)(wsl + OFF_WUKV), NP, TC, 1536, 512};
                EpiUKV E{KB, VB, PROJ, SSP(4, l) + r0, SSP(5, l) + r0, p.b_k_norm + l * 192, TABL};
                S.init(TC, 1536, gridDim.x, blockIdx.x); pg8::gemm_phase(lds, g, S, E, wid_s, PROBE_TACC);
            }
            PROBE_MARK(3); xcd_barrier(XBAR_NOW(), wid_s == 0 && lane_id() == 0); PROBE_MARK(7);
            {
                constexpr int QB_ITEMS = 120, QC_ITEMS = 80, QA_ITEMS = 120, QW_ITEMS = CVT_ITEMS / 8, Q_ITEMS = QB_ITEMS + QC_ITEMS + QA_ITEMS + QW_ITEMS;
                const int xme = (int)(xb_xcc_id() & 7u);
                LAS int* slot = (LAS int*)(lds + at::OFF_SLOT);
                for (int dx = 0; dx < 8; ++dx) {
                    const int xq = (xme + dx) & 7;
                    unsigned* ctr = CTR + l * 8 + xq;
                    for (;;) {
                        __syncthreads();
                        if (wid_s == 0 && lane_id() == 0) *slot = (int)atomicAdd(ctr, 1u);
                        __syncthreads();
                        const int k = *slot;
                        if (k >= Q_ITEMS) break;
                        if (k < QB_ITEMS) { const int s = xq + 8 * (k >> 3), sq = s / 6, hh = s - sq * 6, sb = sq * SEQ, t0 = sb + (k & 7) * 256;
                            at::attn_unit<1>(QB + (size_t)t0 * 1152 + hh * 192, KB + (size_t)sb * 1152 + hh * 192, VB + (size_t)sb * 768 + hh * 128, PROJ + (size_t)t0 * NP + C_Z + 768 + hh * 128,
                                             t0 & (SEQ - 1), hh, nullptr, (char*)shm, wid_s); }
                        else if (k < QB_ITEMS + QC_ITEMS) { const int k2 = k - QB_ITEMS, s = xq + 8 * (k2 >> 3), sq = s >> 2, hh = s & 3, sb = sq * SEQ, t0 = sb + (k2 & 7) * 256;
                            at::attn_unit<2>(PROJ + (size_t)t0 * NP + C_CQ + hh * 128, PROJ + (size_t)sb * NP + C_CK + hh * 128, PROJ + (size_t)sb * NP + C_CV + hh * 128, PROJ + (size_t)t0 * NP + C_Z + 1536 + hh * 128,
                                             t0 & (SEQ - 1), hh, p.c_rpb + ((size_t)l * 4 + hh) * 15 * 31, (char*)shm, wid_s); }
                        else if (k < QB_ITEMS + QC_ITEMS + QA_ITEMS) { const int k2 = k - QB_ITEMS - QC_ITEMS, g = xq + 8 * (k2 / 24), r = k2 % 24, sq = g >> 1, kvh = g & 1, hh = kvh * 3 + r % 3, sb = sq * SEQ, t0 = sb + (r / 3) * 256;
                            at::attn_unit<0>(PROJ + (size_t)t0 * NP + C_AQ + hh * 128, PROJ + (size_t)sb * NP + C_AK + kvh * 128, PROJ + (size_t)sb * NP + C_AV + kvh * 128, PROJ + (size_t)t0 * NP + C_Z + hh * 128,
                                             t0 & (SEQ - 1), hh, p.a_sink + l * 6 + hh, (char*)shm, wid_s); }
                        else if (l < 3) { int wtid = wid_s * 64 + lane_id(); asm volatile("" : "+v"(wtid)); cvt_item(p, ws + (size_t)((l + 1) & 1) * SZ_LAYER, l + 1, xq + 8 * (k - (QB_ITEMS + QC_ITEMS + QA_ITEMS)), ldsf, wtid); }
                    }
                }
            }
            PROBE_MARK(4); xcd_barrier(XBAR_NOW(), wid_s == 0 && lane_id() == 0); PROBE_MARK(7);
            for (int s2 = 0; s2 < 2; ++s2) {
                if ((s2 ^ (int)((blockIdx.x >> 3) & 1)) == 0) {
                    const float* hin = (l == 0) ? p.x_prompt : p.h; const long hdelta = (l == 0) ? (long)((p.x_sample - (size_t)8192 * DM) - p.x_prompt) : 0;
                    pg8::Gemm g{PROJ + C_Z, (const bf16_t*)(wsl + OFF_WOUT), NP, TC, DM, DM};
                    EpiOut E{hin, hdelta, p.h, HBA, SSP(1, l)};
                    S.init(TC, DM, gridDim.x, blockIdx.x); pg8::gemm_phase(lds, g, S, E, wid_s, PROBE_TACC);
                } else {
                    pg8::Gemm g{(const bf16_t*)(wsl + OFF_PB), (const bf16_t*)(wsl + OFF_WPROJ), 256, TC, DM, 256};
                    EpiPP E{PROJ, SSP(2, l) + r0, p.post_norm + l * DM};
                    S.init(TC, DM, gridDim.x, blockIdx.x); pg8::gemm_phase(lds, g, S, E, wid_s, PROBE_TACC);
                }
            }
            PROBE_MARK(5); xcd_barrier(XBAR_NOW(), wid_s == 0 && lane_id() == 0); PROBE_MARK(7);
            {
                pg8::Gemm g{HBA, (const bf16_t*)(wsl + OFF_WGATE), DM, TC, DM, DM};
                EpiGate E{p.h + (size_t)r0 * DM, HBB + (size_t)r0 * DM, PROJ, SSP(1, l) + r0, SSP(2, l) + r0, (l < 3) ? SSP(0, l + 1) + r0 : nullptr};
                S.init(TC, DM, gridDim.x, blockIdx.x); pg8::gemm_phase(lds, g, S, E, wid_s, PROBE_TACC);
            }
            PROBE_MARK(6); xcd_barrier(XBAR_NOW(), wid_s == 0 && lane_id() == 0); PROBE_MARK(7);
        }
    }
#if PROBE_SEL
    if (blockIdx.x == 0 && wid_s == 0 && lane_id() == 0) p.h[0] += (float)t_acc * (1e-5f * 4.0f);
#endif
}

extern "C" void kernel_launch(void* const* d_in, const int* in_sizes, int n_in, void* d_out, int out_size, void* d_ws, size_t ws_size, hipStream_t stream) {
    static int grid_blocks = 0;
    if (grid_blocks == 0) {
        if (n_in != 23 || ws_size < WS_END) { fprintf(stderr, "kernel_launch: need 23 inputs and %zu bytes of workspace (got %d, %zu)\n", (size_t)WS_END, n_in, ws_size); grid_blocks = -1; return; }
        int dev = 0, cus = 0, per_cu = 0;
        if (hipGetDevice(&dev) != hipSuccess || hipDeviceGetAttribute(&cus, hipDeviceAttributeMultiprocessorCount, dev) != hipSuccess) { grid_blocks = -1; return; }
        if (hipFuncSetAttribute((const void*)hymba_fwd, hipFuncAttributeMaxDynamicSharedMemorySize, LDS_BYTES) != hipSuccess) { fprintf(stderr, "kernel_launch: hipFuncSetAttribute failed\n"); grid_blocks = -1; return; }
        if (hipOccupancyMaxActiveBlocksPerMultiprocessor(&per_cu, (const void*)hymba_fwd, 512, LDS_BYTES) != hipSuccess || per_cu < 1) { fprintf(stderr, "kernel_launch: occupancy query failed (%d)\n", per_cu); (void)hipGetLastError(); per_cu = 1; }
        grid_blocks = cus * per_cu;
    }
    if (grid_blocks < 0) return;
    Params p{};
    const float** pf = (const float**)&p;
    for (int i = 0; i < 23; ++i) pf[i] = (const float*)d_in[i];
    p.h = (float*)d_out; p.ws = (unsigned char*)d_ws;
    void* args[] = {&p};
    hipError_t e = hipLaunchCooperativeKernel((const void*)hymba_fwd, dim3(grid_blocks), dim3(512), args, LDS_BYTES, stream);
    if (e != hipSuccess) fprintf(stderr, "cooperative launch failed: %s (grid %d)\n", hipGetErrorString(e), grid_blocks);
}
```

```cpp
#include <hip/hip_runtime.h>
#include <hip/hip_cooperative_groups.h>
#include <cstdio>
#include <math.h>
namespace cg = cooperative_groups;
#define PROBE_SEL 0

#define LAS __attribute__((address_space(3)))
typedef unsigned short bf16_t;
typedef short bf16x8 __attribute__((ext_vector_type(8)));
typedef float f32x4 __attribute__((ext_vector_type(4)));
typedef unsigned u32x4 __attribute__((ext_vector_type(4)));
typedef unsigned u32x2 __attribute__((ext_vector_type(2)));

constexpr int SEQ = 2048, DM = 2048, INW = 5952, TTOT = 40960, NP = 6144;
constexpr int O_AQ = 0, O_AK = 768, O_AV = 1024, O_AZ = 1280, O_BCQ = 2048, O_BCKV = 2560, O_BKR = 3072, O_BZ = 3136, O_CQ = 3904, O_CK = 4416, O_CV = 4928, O_CZ = 5440;
constexpr int C_AQ = 0, C_AK = 768, C_AV = 1024, C_BCQ = 1280, C_BCKV = 1792, C_CQ = 2304, C_CK = 2816, C_CV = 3328, C_Z = 3840, C_KR = 5888;
constexpr float LOG2E = 1.4426950408889634f;
constexpr float QS_A = 0.08838834764831845f * LOG2E;
constexpr float QS_B = 0.07216878364870323f * LOG2E;
constexpr size_t SZ_WIN = (size_t)NP * 2048 * 2, SZ_WU = (size_t)1536 * 512 * 2, SZ_WSQ = (size_t)2048 * 2048 * 2, SZ_WPROJ = (size_t)2048 * 256 * 2;
constexpr size_t OFF_WIN = 0, OFF_WUQ = OFF_WIN + SZ_WIN, OFF_WUKV = OFF_WUQ + SZ_WU, OFF_WOUT = OFF_WUKV + SZ_WU, OFF_WGATE = OFF_WOUT + SZ_WSQ,
                 OFF_WPROJ = OFF_WGATE + SZ_WSQ, OFF_PB = OFF_WPROJ + SZ_WPROJ, SZ_LAYER = OFF_PB + (size_t)TTOT * 256 * 2,
                 OFF_HBB = 2 * SZ_LAYER,
                 OFF_PROJ = OFF_HBB + (size_t)TTOT * DM * 2, OFF_QB = OFF_PROJ + (size_t)TTOT * NP * 2, OFF_KB = OFF_QB + (size_t)TTOT * 1152 * 2,
                 OFF_VB = OFF_KB + (size_t)TTOT * 1152 * 2, OFF_SS = OFF_VB + (size_t)TTOT * 768 * 2, OFF_TAB = OFF_SS + (size_t)6 * 4 * TTOT * 4,
                 OFF_GT = OFF_TAB + (size_t)SEQ * 32 * 8, OFF_CTR = OFF_GT + 4 * 4 * 128 * 4, OFF_BAR = OFF_CTR + 256, WS_END = OFF_BAR + 3456 * 4;
static_assert(WS_END <= (size_t)1 << 30, "workspace budget");
constexpr int LDS_STAGE = 131072, LDS_XB = 148992, LDS_BYTES = LDS_XB + 16;
constexpr unsigned long long STAGGER_TICKS = 2200;

struct Params {
    const float *x_prompt, *x_sample, *p_prompt, *p_sample, *norm_in, *w_in, *a_q_norm, *a_k_norm, *a_sink, *b_cq_norm, *b_ckv_norm, *b_w_uq, *b_w_ukv,
        *b_q_norm, *b_k_norm, *c_q_norm, *c_k_norm, *c_rpb, *w_out, *ple_norm, *w_gate, *w_proj, *post_norm;
    float* h;
    unsigned char* ws;
};

__device__ __forceinline__ unsigned cvt_pk_bf16(float lo, float hi) { unsigned r; asm volatile("v_cvt_pk_bf16_f32 %0, %1, %2" : "=v"(r) : "v"(lo), "v"(hi)); return r; }
__device__ __forceinline__ float bf2f(unsigned short b) { return __uint_as_float(((unsigned)b) << 16); }
__device__ __forceinline__ float bflo(unsigned w) { return __uint_as_float(w << 16); }
__device__ __forceinline__ float bfhi(unsigned w) { return __uint_as_float(w & 0xffff0000u); }
__device__ __forceinline__ int lane_id() { unsigned m = ~0u; asm volatile("" : "+s"(m)); return (int)__builtin_amdgcn_mbcnt_hi(m, __builtin_amdgcn_mbcnt_lo(m, 0u)); }
__device__ __forceinline__ float wave_sum(float v) {
#pragma unroll
    for (int o = 32; o >= 1; o >>= 1) v += __shfl_xor(v, o);
    return v;
}

namespace pg8 {
constexpr int BM = 256, BK = 64, HALF = 128, HTB = HALF * BK * 2, STAGE_BYTES = 8 * HTB, NXCD = 8, WGM = 8;
__device__ __forceinline__ int lds_byte(int r, int c) { const int st = (r >> 4) * 2 + (c >> 5), rr = r & 15, cc = c & 31, ob = rr * 64 + cc * 2; return st * 1024 + (ob ^ (((ob >> 9) & 1) << 5)); }
__device__ __forceinline__ void stage_rc(int b, int& R, int& C) { const int st = b / 1024, sb = b % 1024, swz = sb ^ (((sb >> 9) & 1) << 5); R = (st >> 1) * 16 + swz / 64; C = (st & 1) * 32 + (swz % 64) / 2; }
__device__ __forceinline__ int perm32(int rho) { const int n = rho >> 4, i = rho & 15; return 8 * (i >> 2) + 4 * n + (i & 3); }
struct Unit { int pm, pn; };
struct Gemm { const bf16_t* A; const bf16_t* Bt; int lda, M, N, K; };
struct StaticOrder {
    int nM, nN, nwg, G, c;
    __device__ void init(int M, int N, int G_, int c_) { nM = M / BM; nN = N / BM; nwg = nM * nN; G = G_; c = c_; }
    __device__ bool next(int i, Unit& u) const {
        const long L = (long)i * G + c; if (L >= nwg) return false;
        int wgid = (int)L; { const int q = nwg / NXCD, r = nwg % NXCD, xcd = wgid % NXCD, off = wgid / NXCD; wgid = (xcd < r ? xcd * (q + 1) : r * (q + 1) + (xcd - r) * q) + off; }
        const int nig = WGM * nN, gid = wgid / nig, fm = gid * WGM, gsz = (nM - fm) < WGM ? (nM - fm) : WGM;
        u.pm = fm + ((wgid % nig) % gsz); u.pn = (wgid % nig) / gsz; return true;
    }
};

template <class Epi>
__device__ __forceinline__ void gemm_phase(LAS unsigned char* lds, const Gemm g, const StaticOrder& S, const Epi& E, int wid_s, unsigned long long* tacc = nullptr) {
    int tid = wid_s * 64 + lane_id(); asm volatile("" : "+v"(tid));
    const int wid = __builtin_amdgcn_readfirstlane(tid >> 6), lane = tid & 63, wr = wid >> 2, wc = wid & 3, fr = lane & 15, fq = lane >> 4;
    int K = g.K; asm volatile("" : "+s"(K));
    const int nt = K / BK;
    unsigned voffA[2], voffB[2];
#pragma unroll
    for (int i = 0; i < 2; ++i) { int R, C; stage_rc(tid * 16 + i * 8192, R, C); const int Rb = Epi::PERM ? ((R & ~31) + perm32(R & 31)) : R;
        voffA[i] = (unsigned)(R * g.lda + C) * 2u; voffB[i] = (unsigned)(Rb * K + C) * 2u; }
    const size_t kstep = (size_t)(BK * 2);
    const size_t hstepA = (size_t)HALF * g.lda * 2, hstepB = (size_t)HALF * K * 2;
    const size_t tstepA = 2 * hstepA, tstepB = 2 * hstepB;
    const unsigned ldsw = (unsigned)wid * 1024u;
    const int aoff = lds_byte(wr * 64 + fr, fq * 8), boff = lds_byte(wc * 32 + fr, fq * 8);
#define PG8_SA(b, h) (((b) * 2 + (h)) * HTB)
#define PG8_SB(b, h) ((4 + (b) * 2 + (h)) * HTB)
#define PG8_STAGE(bufoff, gbase, voff) do { _Pragma("unroll") for (int _i = 0; _i < 2; ++_i) \
        __builtin_amdgcn_global_load_lds((const unsigned*)((const char*)(gbase) + (voff)[_i]), (LAS unsigned*)(lds + (bufoff) + ldsw + _i * 8192), 16, 0, 0); } while (0)
#define PG8_LDA(dst, b, h) do { _Pragma("unroll") for (int m = 0; m < 4; ++m) _Pragma("unroll") for (int k = 0; k < 2; ++k) dst[m][k] = *(const LAS bf16x8*)(lds + PG8_SA(b, h) + aoff + m * 2048 + k * 1024); } while (0)
#define PG8_LDB(dst, b, h) do { _Pragma("unroll") for (int n = 0; n < 2; ++n) _Pragma("unroll") for (int k = 0; k < 2; ++k) dst[n][k] = *(const LAS bf16x8*)(lds + PG8_SB(b, h) + boff + n * 2048 + k * 1024); } while (0)
#define PG8_MMA(ai, bj, At, Bt) do { __builtin_amdgcn_s_setprio(1); _Pragma("unroll") for (int m = 0; m < 4; ++m) _Pragma("unroll") for (int n = 0; n < 2; ++n) _Pragma("unroll") for (int k = 0; k < 2; ++k) \
        acc[ai][bj][m][n] = __builtin_amdgcn_mfma_f32_16x16x32_bf16(Bt[n][k], At[m][k], acc[ai][bj][m][n], 0, 0, 0); __builtin_amdgcn_s_setprio(0); } while (0)
#define PG8_WAIT_V(n) asm volatile("s_waitcnt vmcnt(" #n ")" ::: "memory")
#define PG8_WAIT_L(n) asm volatile("s_waitcnt lgkmcnt(" #n ")" ::: "memory")
#define PG8_BAR __builtin_amdgcn_s_barrier()
#define PG8_SCHED __builtin_amdgcn_sched_barrier(0)
    Unit cur, nxt; int ui = 0;
    if (!S.next(0, cur)) return;
    f32x4 acc[2][2][4][2];
#pragma unroll
    for (int a = 0; a < 2; ++a)
#pragma unroll
        for (int b = 0; b < 2; ++b)
#pragma unroll
            for (int m = 0; m < 4; ++m)
#pragma unroll
                for (int n = 0; n < 2; ++n) acc[a][b][m][n] = (f32x4){0.f, 0.f, 0.f, 0.f};
    bf16x8 At[4][2], B0[2][2], B1[2][2];
    const char* cA = (const char*)g.A + (size_t)cur.pm * tstepA; const char* cB = (const char*)g.Bt + (size_t)cur.pn * tstepB;
    PG8_STAGE(PG8_SB(0, 0), cB, voffB); PG8_STAGE(PG8_SA(0, 0), cA, voffA); PG8_STAGE(PG8_SB(0, 1), cB + hstepB, voffB); PG8_STAGE(PG8_SA(0, 1), cA + hstepA, voffA);
    if (wr == 1) PG8_BAR;
    PG8_WAIT_V(4); PG8_BAR;
    PG8_STAGE(PG8_SB(1, 0), cB + kstep, voffB); PG8_STAGE(PG8_SA(1, 0), cA + kstep, voffA); PG8_STAGE(PG8_SB(1, 1), cB + hstepB + kstep, voffB);
    PG8_WAIT_V(6); PG8_BAR;
    for (;;) {
        const bool has_next = S.next(ui + 1, nxt);
        const char* nA = has_next ? (const char*)g.A + (size_t)nxt.pm * tstepA : cA; const char* nB = has_next ? (const char*)g.Bt + (size_t)nxt.pn * tstepB : cB;
#if PROBE_SEL >= 9
        const unsigned long long k0_ = __builtin_amdgcn_s_memrealtime();
#endif
        for (int t = 0; t < nt; t += 2) {
            const bool last = (t == nt - 2);
            const char* a1 = cA + (size_t)(t + 1) * kstep;
            const char* a2 = last ? nA : cA + (size_t)(t + 2) * kstep; const char* b2 = last ? nB : cB + (size_t)(t + 2) * kstep;
            const char* a3 = a2 + kstep; const char* b3 = b2 + kstep;
            PG8_LDB(B0, 0, 0); PG8_SCHED; PG8_LDA(At, 0, 0); PG8_STAGE(PG8_SA(1, 1), a1 + hstepA, voffA);
            PG8_WAIT_L(8); PG8_BAR; PG8_WAIT_L(0); PG8_MMA(0, 0, At, B0); PG8_BAR; PG8_SCHED;
            PG8_LDB(B1, 0, 1); PG8_STAGE(PG8_SB(0, 0), b2, voffB);
            PG8_BAR; PG8_WAIT_L(0); PG8_MMA(0, 1, At, B1); PG8_BAR;
            PG8_LDA(At, 0, 1); PG8_STAGE(PG8_SA(0, 0), a2, voffA);
            PG8_BAR; PG8_WAIT_L(0); PG8_MMA(1, 0, At, B0); PG8_BAR; PG8_SCHED;
            PG8_STAGE(PG8_SB(0, 1), b2 + hstepB, voffB);
            PG8_WAIT_V(6); PG8_BAR; PG8_MMA(1, 1, At, B1); PG8_BAR;
            PG8_LDB(B0, 1, 0); PG8_SCHED; PG8_LDA(At, 1, 0); PG8_STAGE(PG8_SA(0, 1), a2 + hstepA, voffA);
            PG8_WAIT_L(8); PG8_BAR; PG8_WAIT_L(0); PG8_MMA(0, 0, At, B0); PG8_BAR; PG8_SCHED;
            PG8_LDB(B1, 1, 1); PG8_STAGE(PG8_SB(1, 0), b3, voffB);
            PG8_BAR; PG8_WAIT_L(0); PG8_MMA(0, 1, At, B1); PG8_BAR;
            PG8_LDA(At, 1, 1); PG8_STAGE(PG8_SA(1, 0), a3, voffA);
            PG8_BAR; PG8_WAIT_L(0); PG8_MMA(1, 0, At, B0); PG8_BAR; PG8_SCHED;
            PG8_STAGE(PG8_SB(1, 1), b3 + hstepB, voffB);
            PG8_WAIT_V(6); PG8_BAR; PG8_MMA(1, 1, At, B1); PG8_BAR;
        }
#if PROBE_SEL >= 9
        const unsigned long long e0_ = __builtin_amdgcn_s_memrealtime();
        if (Epi::PROBE_ID + 100 == PROBE_SEL) *tacc += e0_ - k0_;
#endif
        E(acc, cur, wr, wc, fr, fq);
#if PROBE_SEL >= 9
        if (Epi::PROBE_ID == PROBE_SEL) *tacc += __builtin_amdgcn_s_memrealtime() - e0_;
#endif
        if (!has_next) break;
#pragma unroll
        for (int a = 0; a < 2; ++a)
#pragma unroll
            for (int b = 0; b < 2; ++b)
#pragma unroll
                for (int m = 0; m < 4; ++m)
#pragma unroll
                    for (int n = 0; n < 2; ++n) acc[a][b][m][n] = (f32x4){0.f, 0.f, 0.f, 0.f};
        cur = nxt; cA = nA; cB = nB; ++ui;
    }
    PG8_WAIT_V(0);
    if (wr == 0) PG8_BAR;
    PG8_BAR;
#undef PG8_SA
#undef PG8_SB
#undef PG8_STAGE
#undef PG8_LDA
#undef PG8_LDB
#undef PG8_MMA
#undef PG8_WAIT_V
#undef PG8_WAIT_L
#undef PG8_BAR
#undef PG8_SCHED
}
}
using pg8::Unit;
typedef f32x4 AccT[2][2][4][2];

#define EPI_BAR() do { asm volatile("s_waitcnt lgkmcnt(0)" ::: "memory"); __builtin_amdgcn_s_barrier(); asm volatile("" ::: "memory"); } while (0)
__device__ __forceinline__ float sq4(const f32x4 v) { return (v[0] * v[0] + v[1] * v[1]) + (v[2] * v[2] + v[3] * v[3]); }
__device__ __forceinline__ float red_fq(float s) { s += __shfl_xor(s, 16); s += __shfl_xor(s, 32); return s; }
__device__ __forceinline__ u32x4 pack8(const f32x4 a, const f32x4 b) { u32x4 w; w.x = cvt_pk_bf16(a[0], a[1]); w.y = cvt_pk_bf16(a[2], a[3]); w.z = cvt_pk_bf16(b[0], b[1]); w.w = cvt_pk_bf16(b[2], b[3]); return w; }

struct EpiProj {
    static constexpr int PROBE_ID = 10;
    static constexpr bool PERM = true;
    bf16_t* PROJ; const float* ssh; float *ss_cq, *ss_kr;
    const float *gt, *g_kr; const float2* tab; LAS float* TABL;
    __device__ __forceinline__ void operator()(AccT& acc, const Unit& u, int wr, int wc, int fr, int fq) const {
        { int ln_ = lane_id(); asm volatile("" : "+v"(ln_)); fr = ln_ & 15; fq = ln_ >> 4; }
        const int lrow0 = wr * 64 + fr, row0 = u.pm * 256 + lrow0, pn = u.pn;
        float rs[2][4];
#pragma unroll
        for (int ai = 0; ai < 2; ++ai)
#pragma unroll
            for (int m = 0; m < 4; ++m) rs[ai][m] = __builtin_amdgcn_rsqf(ssh[row0 + ai * 128 + m * 16] * (1.0f / 2048.0f) + 1e-6f);
        bf16_t* const outp = PROJ + (size_t)row0 * NP + pn * 256 + wc * 32 + 8 * fq;
        const bool is_norm = (pn <= 3) || (pn >= 9 && pn <= 12);
        if (is_norm) {
            const float* g = gt + ((pn <= 2) ? 0 : (pn == 3) ? 128 : (pn <= 10) ? 256 : 384);
            const float qs = (pn <= 2 || pn == 9 || pn == 10) ? QS_A : 1.0f;
#pragma unroll
            for (int ai = 0; ai < 2; ++ai)
#pragma unroll
                for (int m = 0; m < 4; ++m)
#pragma unroll
                    for (int bj = 0; bj < 2; ++bj) { float s = red_fq(sq4(acc[ai][bj][m][0]) + sq4(acc[ai][bj][m][1]));
                        if (fq == 0) TABL[((lrow0 + ai * 128 + m * 16) * 2 + bj) * 4 + wc] = s; asm volatile("" ::: "memory"); }
            EPI_BAR();
            const f32x4 g0 = *(const f32x4*)(g + 32 * wc + 8 * fq) * qs, g1 = *(const f32x4*)(g + 32 * wc + 8 * fq + 4) * qs;
#pragma unroll
            for (int ai = 0; ai < 2; ++ai)
#pragma unroll
                for (int m = 0; m < 4; ++m)
#pragma unroll
                    for (int bj = 0; bj < 2; ++bj) { const f32x4 t = *(const LAS f32x4*)&TABL[((lrow0 + ai * 128 + m * 16) * 2 + bj) * 4];
                        const float r2 = rs[ai][m] * rs[ai][m];
                        const float rn = rs[ai][m] * __builtin_amdgcn_rsqf(((t[0] + t[1]) + (t[2] + t[3])) * r2 * (1.0f / 128.0f) + 1e-6f);
                        *(u32x4*)(outp + (size_t)(ai * 128 + m * 16) * NP + bj * 128) = pack8(acc[ai][bj][m][0] * rn * g0, acc[ai][bj][m][1] * rn * g1);
                        asm volatile("" ::: "memory"); }
        } else if (pn >= 5 && pn <= 8) {
            float* ss = ss_cq + ((pn <= 6) ? 0 : 4 * TTOT);
#pragma unroll
            for (int ai = 0; ai < 2; ++ai)
#pragma unroll
                for (int m = 0; m < 4; ++m) { const float r = rs[ai][m];
                    float s = red_fq((sq4(acc[ai][0][m][0]) + sq4(acc[ai][0][m][1])) + (sq4(acc[ai][1][m][0]) + sq4(acc[ai][1][m][1]))) * (r * r);
                    if (fq == 0) unsafeAtomicAdd(ss + row0 + ai * 128 + m * 16, s);
#pragma unroll
                    for (int bj = 0; bj < 2; ++bj) *(u32x4*)(outp + (size_t)(ai * 128 + m * 16) * NP + bj * 128) = pack8(acc[ai][bj][m][0] * r, acc[ai][bj][m][1] * r);
                    asm volatile("" ::: "memory"); }
        } else if (pn >= 15 && pn <= 22) {
#pragma unroll
            for (int ai = 0; ai < 2; ++ai)
#pragma unroll
                for (int m = 0; m < 4; ++m) { const float r = rs[ai][m];
#pragma unroll
                    for (int bj = 0; bj < 2; ++bj) { f32x4 o0, o1;
#pragma unroll
                        for (int j = 0; j < 4; ++j) { const float v0 = acc[ai][bj][m][0][j] * r, v1 = acc[ai][bj][m][1][j] * r;
                            o0[j] = v0 * __builtin_amdgcn_rcpf(1.0f + __expf(-v0)); o1[j] = v1 * __builtin_amdgcn_rcpf(1.0f + __expf(-v1)); }
                        *(u32x4*)(outp + (size_t)(ai * 128 + m * 16) * NP + bj * 128) = pack8(o0, o1); }
                    asm volatile("" ::: "memory"); }
        } else if (pn == 23) {
            if (wc < 2) {
                const int gI = wc * 4 + fq;
                const f32x4 gk1 = *(const f32x4*)(g_kr + 4 * gI), gk2 = *(const f32x4*)(g_kr + 32 + 4 * gI);
#pragma unroll
                for (int ai = 0; ai < 2; ++ai)
#pragma unroll
                    for (int m = 0; m < 4; ++m) { const int row = row0 + ai * 128 + m * 16; const float r = rs[ai][m];
                        float s = red_fq(sq4(acc[ai][0][m][0]) + sq4(acc[ai][0][m][1])) * (r * r);
                        if (fq == 0) unsafeAtomicAdd(ss_kr + row, s);
                        const f32x4 x1 = acc[ai][0][m][0] * gk1 * r, x2 = acc[ai][0][m][1] * gk2 * r; f32x4 o1, o2;
                        const float2* tp = tab + (row & (SEQ - 1)) * 32 + 4 * gI;
#pragma unroll
                        for (int j = 0; j < 4; ++j) { const float2 cs = tp[j]; o1[j] = x1[j] * cs.x - x2[j] * cs.y; o2[j] = x1[j] * cs.y + x2[j] * cs.x; }
                        *(u32x4*)(PROJ + (size_t)row * NP + C_KR + 8 * gI) = pack8(o1, o2); asm volatile("" ::: "memory"); }
            }
        } else {
#pragma unroll
            for (int ai = 0; ai < 2; ++ai)
#pragma unroll
                for (int m = 0; m < 4; ++m) { const float r = rs[ai][m];
#pragma unroll
                    for (int bj = 0; bj < 2; ++bj) *(u32x4*)(outp + (size_t)(ai * 128 + m * 16) * NP + bj * 128) = pack8(acc[ai][bj][m][0] * r, acc[ai][bj][m][1] * r);
                    asm volatile("" ::: "memory"); }
        }
    }
};

struct EpiUQ {
    static constexpr int PROBE_ID = 12;
    static constexpr bool PERM = true;
    bf16_t* QB; const float* ss_cq; const float* gq; const float2* tab; LAS float* TABL;
    __device__ __forceinline__ void operator()(AccT& acc, const Unit& u, int wr, int wc, int fr, int fq) const {
        { int ln_ = lane_id(); asm volatile("" : "+v"(ln_)); fr = ln_ & 15; fq = ln_ >> 4; }
        const int lrow0 = wr * 64 + fr, row0 = u.pm * 256 + lrow0, h = u.pn;
        float rs[2][4];
#pragma unroll
        for (int ai = 0; ai < 2; ++ai)
#pragma unroll
            for (int m = 0; m < 4; ++m) rs[ai][m] = ss_cq[row0 + ai * 128 + m * 16];
#pragma unroll
        for (int ai = 0; ai < 2; ++ai)
#pragma unroll
            for (int m = 0; m < 4; ++m) { const float r = __builtin_amdgcn_rsqf(rs[ai][m] * (1.0f / 512.0f) + 1e-6f); rs[ai][m] = r;
#pragma unroll
                for (int bj = 0; bj < 2; ++bj) { float s = red_fq(sq4(acc[ai][bj][m][0]) + sq4(acc[ai][bj][m][1])) * (r * r);
                    if (fq == 0) TABL[((lrow0 + ai * 128 + m * 16) * 2 + bj) * 4 + wc] = s; } }
        EPI_BAR();
        const int gI = (wc & 1) * 4 + fq;
        const f32x4 g00 = *(const f32x4*)(gq + 32 * wc + 8 * fq), g01 = *(const f32x4*)(gq + 32 * wc + 8 * fq + 4);
        const f32x4 g10 = *(const f32x4*)(gq + 128 + 4 * gI), g11 = *(const f32x4*)(gq + 160 + 4 * gI);
#pragma unroll
        for (int ai = 0; ai < 2; ++ai) {
            float2 cs[4][4];
            if (wc < 2) {
#pragma unroll
                for (int m = 0; m < 4; ++m) { const float2* tp = tab + ((u.pm * 256 + lrow0 + ai * 128 + m * 16) & (SEQ - 1)) * 32 + 4 * gI;
#pragma unroll
                    for (int j = 0; j < 4; ++j) cs[m][j] = tp[j]; }
            }
#pragma unroll
            for (int m = 0; m < 4; ++m) { const int lrow = lrow0 + ai * 128 + m * 16, row = u.pm * 256 + lrow;
                const f32x4 t0 = *(const LAS f32x4*)&TABL[lrow * 8], t1 = *(const LAS f32x4*)&TABL[lrow * 8 + 4];
                const float rq = rs[ai][m] * QS_B * __builtin_amdgcn_rsqf((((t0[0] + t0[1]) + (t0[2] + t0[3])) + ((t1[0] + t1[1]) + (t1[2] + t1[3]))) * (1.0f / 192.0f) + 1e-6f);
                bf16_t* rowp = QB + (size_t)row * 1152 + h * 192 + 32 * wc + 8 * fq;
                *(u32x4*)rowp = pack8(acc[ai][0][m][0] * rq * g00, acc[ai][0][m][1] * rq * g01);
                if (wc < 2) {
                    const f32x4 x1 = acc[ai][1][m][0] * rq * g10, x2 = acc[ai][1][m][1] * rq * g11; f32x4 o1, o2;
#pragma unroll
                    for (int j = 0; j < 4; ++j) { o1[j] = x1[j] * cs[m][j].x - x2[j] * cs[m][j].y; o2[j] = x1[j] * cs[m][j].y + x2[j] * cs[m][j].x; }
                    *(u32x4*)(rowp + 128) = pack8(o1, o2);
                } }
            asm volatile("" ::: "memory");
        }
    }
};

struct EpiUKV {
    static constexpr int PROBE_ID = 13;
    static constexpr bool PERM = true;
    bf16_t *KB, *VB; const bf16_t* PROJ; const float *ss_ckv, *ss_kr; const float* gk; LAS float* TABL;
    __device__ __forceinline__ void operator()(AccT& acc, const Unit& u, int wr, int wc, int fr, int fq) const {
        { int ln_ = lane_id(); asm volatile("" : "+v"(ln_)); fr = ln_ & 15; fq = ln_ >> 4; }
        const int lrow0 = wr * 64 + fr, row0 = u.pm * 256 + lrow0, h = u.pn;
        const int i4 = (wc * 4 + fq) * 4;
        float rs[2][4], skr[2][4]; u32x2 rr[2][4];
#pragma unroll
        for (int ai = 0; ai < 2; ++ai)
#pragma unroll
            for (int m = 0; m < 4; ++m) { const int row = row0 + ai * 128 + m * 16; rs[ai][m] = ss_ckv[row]; skr[ai][m] = ss_kr[row]; rr[ai][m] = *(const u32x2*)(PROJ + (size_t)row * NP + C_KR + i4); }
#pragma unroll
        for (int ai = 0; ai < 2; ++ai)
#pragma unroll
            for (int m = 0; m < 4; ++m) { const float r = __builtin_amdgcn_rsqf(rs[ai][m] * (1.0f / 512.0f) + 1e-6f); rs[ai][m] = r;
                float s = red_fq(sq4(acc[ai][0][m][0]) + sq4(acc[ai][0][m][1])) * (r * r);
                if (fq == 0) TABL[(lrow0 + ai * 128 + m * 16) * 4 + wc] = s; }
        EPI_BAR();
        const f32x4 g0 = *(const f32x4*)(gk + 32 * wc + 8 * fq), g1 = *(const f32x4*)(gk + 32 * wc + 8 * fq + 4);
#pragma unroll
        for (int ai = 0; ai < 2; ++ai)
#pragma unroll
            for (int m = 0; m < 4; ++m) { const int lrow = lrow0 + ai * 128 + m * 16, row = u.pm * 256 + lrow; const float r = rs[ai][m];
                const f32x4 t = *(const LAS f32x4*)&TABL[lrow * 4];
                const float rk = __builtin_amdgcn_rsqf((((t[0] + t[1]) + (t[2] + t[3])) + skr[ai][m]) * (1.0f / 192.0f) + 1e-6f);
                bf16_t* kp = KB + (size_t)row * 1152 + h * 192;
                *(u32x4*)(kp + 32 * wc + 8 * fq) = pack8(acc[ai][0][m][0] * (r * rk) * g0, acc[ai][0][m][1] * (r * rk) * g1);
                *(u32x4*)(VB + (size_t)row * 768 + h * 128 + 32 * wc + 8 * fq) = pack8(acc[ai][1][m][0] * r, acc[ai][1][m][1] * r);
                const u32x2 q = rr[ai][m]; u32x2 o; o.x = cvt_pk_bf16(bflo(q.x) * rk, bfhi(q.x) * rk); o.y = cvt_pk_bf16(bflo(q.y) * rk, bfhi(q.y) * rk);
                *(u32x2*)(kp + 128 + i4) = o; }
    }
};

struct EpiOut {
    static constexpr int PROBE_ID = 11;
    static constexpr bool PERM = true;
    const float* hin; long hdelta; float* hout; bf16_t* hbA; float* ss_h2;
    __device__ __forceinline__ void operator()(AccT& acc, const Unit& u, int wr, int wc, int fr, int fq) const {
        { int ln_ = lane_id(); asm volatile("" : "+v"(ln_)); fr = ln_ & 15; fq = ln_ >> 4; }
        const int row0 = u.pm * 256 + wr * 64 + fr, col0 = u.pn * 256 + wc * 32 + 8 * fq;
#pragma unroll
        for (int ai = 0; ai < 2; ++ai)
#pragma unroll
            for (int mp = 0; mp < 2; ++mp) {
                f32x4 hv[2][2][2];
#pragma unroll
                for (int mm = 0; mm < 2; ++mm)
#pragma unroll
                    for (int bj = 0; bj < 2; ++bj)
#pragma unroll
                        for (int n = 0; n < 2; ++n) hv[mm][bj][n] = *(const f32x4*)(hin + (u.pm >= 32 ? hdelta : 0) + (size_t)(row0 + ai * 128 + (mp * 2 + mm) * 16) * DM + col0 + bj * 128 + n * 4);
#pragma unroll
                for (int mm = 0; mm < 2; ++mm) { const int m = mp * 2 + mm, row = row0 + ai * 128 + m * 16; const size_t off = (size_t)row * DM + col0; float s = 0.f;
#pragma unroll
                    for (int bj = 0; bj < 2; ++bj) { const f32x4 o0 = hv[mm][bj][0] + acc[ai][bj][m][0], o1 = hv[mm][bj][1] + acc[ai][bj][m][1];
                            *(f32x4*)(hout + off + bj * 128) = o0; *(f32x4*)(hout + off + bj * 128 + 4) = o1;
                            *(u32x4*)(hbA + off + bj * 128) = pack8(o0, o1); s += sq4(o0) + sq4(o1); }
                    s = red_fq(s); if (fq == 0) unsafeAtomicAdd(ss_h2 + row, s); }
            }
    }
};
struct EpiPP {
    static constexpr int PROBE_ID = 14;
    static constexpr bool PERM = true;
    bf16_t* PROJ; float* ss_pp; const float* g_post;
    __device__ __forceinline__ void operator()(AccT& acc, const Unit& u, int wr, int wc, int fr, int fq) const {
        { int ln_ = lane_id(); asm volatile("" : "+v"(ln_)); fr = ln_ & 15; fq = ln_ >> 4; }
        const int row0 = u.pm * 256 + wr * 64 + fr, colb = u.pn * 256 + wc * 32 + 8 * fq;
        f32x4 g[2][2];
#pragma unroll
        for (int bj = 0; bj < 2; ++bj) { g[bj][0] = *(const f32x4*)(g_post + colb + bj * 128); g[bj][1] = *(const f32x4*)(g_post + colb + bj * 128 + 4); }
#pragma unroll
        for (int ai = 0; ai < 2; ++ai)
#pragma unroll
            for (int m = 0; m < 4; ++m) { const int row = row0 + ai * 128 + m * 16; bf16_t* rowp = PROJ + (size_t)row * NP + colb; float s = 0.f;
#pragma unroll
                for (int bj = 0; bj < 2; ++bj) { *(u32x4*)(rowp + bj * 128) = pack8(acc[ai][bj][m][0] * g[bj][0], acc[ai][bj][m][1] * g[bj][1]); s += sq4(acc[ai][bj][m][0]) + sq4(acc[ai][bj][m][1]); }
                s = red_fq(s); if (fq == 0) unsafeAtomicAdd(ss_pp + row, s); }
    }
};
struct EpiGate {
    static constexpr int PROBE_ID = 9;
    static constexpr bool PERM = true;
    float* h; bf16_t* hbB; const bf16_t* PROJ; const float *ss_h2, *ss_pp; float* ss_next;
    __device__ __forceinline__ void operator()(AccT& acc, const Unit& u, int wr, int wc, int fr, int fq) const {
        { int ln_ = lane_id(); asm volatile("" : "+v"(ln_)); fr = ln_ & 15; fq = ln_ >> 4; }
        const int row0 = u.pm * 256 + wr * 64 + fr, col0 = u.pn * 256 + wc * 32 + 8 * fq;
        float rs2[2][4], rpp[2][4];
#pragma unroll
        for (int ai = 0; ai < 2; ++ai)
#pragma unroll
            for (int m = 0; m < 4; ++m) { rs2[ai][m] = ss_h2[row0 + ai * 128 + m * 16]; rpp[ai][m] = ss_pp[row0 + ai * 128 + m * 16]; }
#pragma unroll
        for (int ai = 0; ai < 2; ++ai)
#pragma unroll
            for (int mp = 0; mp < 2; ++mp) {
                f32x4 hv[2][2][2]; u32x2 pw[2][2][2];
#pragma unroll
                for (int mm = 0; mm < 2; ++mm)
#pragma unroll
                    for (int bj = 0; bj < 2; ++bj)
#pragma unroll
                        for (int n = 0; n < 2; ++n) { const int row = row0 + ai * 128 + (mp * 2 + mm) * 16, c = col0 + bj * 128 + n * 4;
                            hv[mm][bj][n] = *(const f32x4*)(h + (size_t)row * DM + c); if (n == 0) { const u32x4 q_ = *(const u32x4*)(PROJ + (size_t)row * NP + c); pw[mm][bj][0] = (u32x2){q_.x, q_.y}; pw[mm][bj][1] = (u32x2){q_.z, q_.w}; } }
#pragma unroll
                for (int mm = 0; mm < 2; ++mm) { const int m = mp * 2 + mm, row = row0 + ai * 128 + m * 16; const size_t off = (size_t)row * DM + col0;
                    const float r2 = __builtin_amdgcn_rsqf(rs2[ai][m] * (1.0f / 2048.0f) + 1e-6f), rp = __builtin_amdgcn_rsqf(rpp[ai][m] * (1.0f / 2048.0f) + 1e-6f); float s = 0.f;
#pragma unroll
                    for (int bj = 0; bj < 2; ++bj) { f32x4 oo[2];
#pragma unroll
                        for (int n = 0; n < 2; ++n) { const u32x2 pq = pw[mm][bj][n]; const f32x4 pp = {bflo(pq.x), bfhi(pq.x), bflo(pq.y), bfhi(pq.y)};
#pragma unroll
                            for (int j = 0; j < 4; ++j) { const float gate = __builtin_amdgcn_rcpf(1.0f + __expf(-r2 * acc[ai][bj][m][n][j])); oo[n][j] = hv[mm][bj][n][j] + gate * (pp[j] * rp); } }
                        *(f32x4*)(h + off + bj * 128) = oo[0]; *(f32x4*)(h + off + bj * 128 + 4) = oo[1];
                        *(u32x4*)(hbB + off + bj * 128) = pack8(oo[0], oo[1]); s += sq4(oo[0]) + sq4(oo[1]); }
                    if (ss_next) { s = red_fq(s); if (fq == 0) unsafeAtomicAdd(ss_next + row, s); } }
            }
    }
};

template <int MODE> __device__ __forceinline__ int srccol(int n) {
    if (MODE == 0) return n;
    if (MODE == 1) {
        if (n < 768) return O_AQ + n;
        if (n < 1024) return O_AK + (n - 768);
        if (n < 1280) return O_AV + (n - 1024);
        if (n < 1792) return O_BCQ + (n - 1280);
        if (n < 2304) return O_BCKV + (n - 1792);
        if (n < 2816) return O_CQ + (n - 2304);
        if (n < 3328) return O_CK + (n - 2816);
        if (n < 3840) return O_CV + (n - 3328);
        if (n < 4608) return O_AZ + (n - 3840);
        if (n < 5376) return O_BZ + (n - 4608);
        if (n < 5888) return O_CZ + (n - 5376);
        if (n < 5952) { const int i = n - 5888, g = i >> 3, e = i & 7; return O_BKR + (e < 4 ? 4 * g + e : 32 + 4 * g + (e - 4)); }
        return -1;
    }
    const int hh = n >> 8, c = n & 255;
    if (c < 128) return hh * 192 + c;
    if (c < 192) { const int i = c - 128, g = i >> 3, e = i & 7; return hh * 192 + 128 + (e < 4 ? 4 * g + e : 32 + 4 * g + (e - 4)); }
    return -1;
}
template <int MODE> __device__ __forceinline__ void cvt_tile(const float* src, int ldsrc, int K, const float* gain, bf16_t* dst, float* tile, int tn, int tk, int tid) {
    const int n0 = tn * 256, k0 = tk * 64;
#pragma unroll
    for (int i = 0; i < 8; ++i) { const int idx = tid + i * 512, kk = idx >> 6, ng = (idx & 63) * 4; const int sc = srccol<MODE>(n0 + ng);
        f32x4 v = {0.f, 0.f, 0.f, 0.f}; if (sc >= 0) v = *(const f32x4*)(src + (size_t)(k0 + kk) * ldsrc + sc); if (gain) v *= gain[k0 + kk];
        float* tp = tile + kk * 257 + ng; tp[0] = v[0]; tp[1] = v[1]; tp[2] = v[2]; tp[3] = v[3]; }
    __syncthreads();
#pragma unroll
    for (int i = 0; i < 16; ++i) { const int idx = tid + i * 512, nn = idx >> 5, kp = (idx & 31) * 2;
        *(unsigned*)(dst + (size_t)(n0 + nn) * K + k0 + kp) = cvt_pk_bf16(tile[kp * 257 + nn], tile[(kp + 1) * 257 + nn]); }
    __syncthreads();
}

namespace at {
typedef float f32x16 __attribute__((ext_vector_type(16)));
typedef short s16x4 __attribute__((ext_vector_type(4)));
#define AT_SBAR() __builtin_amdgcn_sched_barrier(0)
constexpr int KVBLK = 64;
constexpr float THR = 8.f, NEGINF = -__builtin_huge_valf();
constexpr int OFF_V = 0, OFF_K = 32768, OFF_WS = 32768 + 51200, OFF_TB = OFF_WS + 2048, TB_PITCH = 160, OFF_SLOT = OFF_TB + 9600, OFF_QR = 95744;
__device__ __forceinline__ int crow(int r, int hi) { return (r & 3) + 8 * (r >> 2) + 4 * hi; }
constexpr int creg(int r) { return (r & 3) + 8 * (r >> 2); }
__device__ __forceinline__ int v_st(int k, int c) { const int kk = (k & ~0xC) | ((k & 4) << 1) | ((k & 8) >> 1); return ((kk >> 3) * 4 + (c >> 5)) * 512 + ((kk & 7) * 32 + (c & 31)) * 2; }
__device__ __forceinline__ int v_rd_base(int lane) { return ((lane & 3) << 3) | (((lane >> 2) & 3) << 6) | (((lane >> 4) & 1) << 5) | (((lane >> 5) & 1) << 8); }
constexpr int v_rd_off(int d0, int ks, int half) { return d0 * 512 + ks * 4096 + half * 2048; }
template <int OFF> __device__ __forceinline__ s16x4 tr_read(int vb) { s16x4 r; asm volatile("ds_read_b64_tr_b16 %0, %1 offset:%2" : "=&v"(r) : "v"(vb), "i"(OFF) : "memory"); return r; }
template <int D0> __device__ __forceinline__ void pv_one(f32x16& od, int vb, bf16x8 pa0, bf16x8 pa1, bf16x8 pa2, bf16x8 pa3) {
    const s16x4 l0 = tr_read<v_rd_off(D0, 0, 0)>(vb), h0 = tr_read<v_rd_off(D0, 0, 1)>(vb), l1 = tr_read<v_rd_off(D0, 1, 0)>(vb), h1 = tr_read<v_rd_off(D0, 1, 1)>(vb);
    const s16x4 l2 = tr_read<v_rd_off(D0, 2, 0)>(vb), h2 = tr_read<v_rd_off(D0, 2, 1)>(vb), l3 = tr_read<v_rd_off(D0, 3, 0)>(vb), h3 = tr_read<v_rd_off(D0, 3, 1)>(vb);
    asm volatile("s_waitcnt lgkmcnt(0)" ::: "memory"); AT_SBAR();
#define AT_PK(L, H) (bf16x8){L[0], L[1], L[2], L[3], H[0], H[1], H[2], H[3]}
    od = __builtin_amdgcn_mfma_f32_32x32x16_bf16(pa0, AT_PK(l0, h0), od, 0, 0, 0);
    od = __builtin_amdgcn_mfma_f32_32x32x16_bf16(pa1, AT_PK(l1, h1), od, 0, 0, 0);
    od = __builtin_amdgcn_mfma_f32_32x32x16_bf16(pa2, AT_PK(l2, h2), od, 0, 0, 0);
    od = __builtin_amdgcn_mfma_f32_32x32x16_bf16(pa3, AT_PK(l3, h3), od, 0, 0, 0);
#undef AT_PK
}
__device__ __forceinline__ void pv_d0(f32x16* o, int vb, bf16x8 pa0, bf16x8 pa1, bf16x8 pa2, bf16x8 pa3) {
    pv_one<0>(o[0], vb, pa0, pa1, pa2, pa3); pv_one<1>(o[1], vb, pa0, pa1, pa2, pa3); pv_one<2>(o[2], vb, pa0, pa1, pa2, pa3); pv_one<3>(o[3], vb, pa0, pa1, pa2, pa3);
}
__device__ __forceinline__ void partialSM(f32x16& p0, f32x16& p1, float& m_reg, float& mn, float& alpha) {
    float pmax = p0[0];
#pragma unroll
    for (int r = 1; r < 16; ++r) pmax = fmaxf(pmax, p0[r]);
#pragma unroll
    for (int r = 0; r < 16; ++r) pmax = fmaxf(pmax, p1[r]);
    { auto rr = __builtin_amdgcn_permlane32_swap(__float_as_uint(pmax), __float_as_uint(pmax), false, false); pmax = fmaxf(__uint_as_float(rr[0]), __uint_as_float(rr[1])); }
    if (__builtin_expect(__all(pmax - m_reg <= THR), 1)) { mn = m_reg; alpha = 1.f; }
    else { mn = fmaxf(m_reg, pmax); alpha = __builtin_amdgcn_exp2f(m_reg - mn); m_reg = mn; }
#pragma unroll
    for (int r = 0; r < 16; ++r) { p0[r] -= mn; p1[r] -= mn; }
#pragma unroll
    for (int r = 0; r < 16; ++r) p0[r] = __builtin_amdgcn_exp2f(p0[r]);
}
__device__ __forceinline__ void finishSM(f32x16& p0, f32x16& p1, float alpha, float& l_reg, bf16x8& pa0, bf16x8& pa1, bf16x8& pa2, bf16x8& pa3) {
#pragma unroll
    for (int r = 0; r < 16; ++r) p1[r] = __builtin_amdgcn_exp2f(p1[r]);
    float ps = 0;
#pragma unroll
    for (int r = 0; r < 16; ++r) ps += p0[r];
#pragma unroll
    for (int r = 0; r < 16; ++r) ps += p1[r];
    { auto rr = __builtin_amdgcn_permlane32_swap(__float_as_uint(ps), __float_as_uint(ps), false, false); ps = __uint_as_float(rr[0]) + __uint_as_float(rr[1]); }
    l_reg = l_reg * alpha + ps;
#define AT_PK4(P, BASE, OUT) do { unsigned a0 = cvt_pk_bf16(P[BASE + 0], P[BASE + 1]), a1 = cvt_pk_bf16(P[BASE + 2], P[BASE + 3]); \
        unsigned b0 = cvt_pk_bf16(P[BASE + 4], P[BASE + 5]), b1 = cvt_pk_bf16(P[BASE + 6], P[BASE + 7]); \
        auto r0 = __builtin_amdgcn_permlane32_swap(a0, b0, false, false); auto r1 = __builtin_amdgcn_permlane32_swap(a1, b1, false, false); \
        u32x4 w = {r0[0], r1[0], r0[1], r1[1]}; OUT = *reinterpret_cast<bf16x8*>(&w); } while (0)
    AT_PK4(p0, 0, pa0); AT_PK4(p0, 8, pa1); AT_PK4(p1, 0, pa2); AT_PK4(p1, 8, pa3);
#undef AT_PK4
}

template <int MODE> struct Cfg;
template <> struct Cfg<0> { static constexpr int DQK = 128, LDQ = NP, LDK = NP, LDV = NP; };
template <> struct Cfg<1> { static constexpr int DQK = 192, LDQ = 1152, LDK = 1152, LDV = 768; };
template <> struct Cfg<2> { static constexpr int DQK = 128, LDQ = NP, LDK = NP, LDV = NP; };

template <int MODE>
__device__ __forceinline__ void attn_unit(const bf16_t* __restrict__ Qb, const bf16_t* __restrict__ Kh, const bf16_t* __restrict__ Vh, bf16_t* __restrict__ Yb,
                                          int pos0, int h, const float* __restrict__ extra, char* lds, int wid_s) {
    constexpr int DQK = Cfg<MODE>::DQK, LDQ = Cfg<MODE>::LDQ, LDK = Cfg<MODE>::LDK, LDV = Cfg<MODE>::LDV, ND = DQK / 16, KPITCH = DQK * 2 + 16, SHM_K = 64 * KPITCH, SHM_V = 16384;
    int tid = wid_s * 64 + lane_id(); asm volatile("" : "+v"(tid));
    const int wid = wid_s, lane = tid & 63, r32 = lane & 31, hi = lane >> 5;
    char* V_lds = lds + OFF_V; char* K_lds = lds + OFF_K;
    float* wsw = (float*)(lds + OFF_WS) + wid * 64; float* li_l = wsw; float* al_l = wsw + 32;
    int klo, NT;
    if (MODE == 0) { klo = max(0, pos0 - 128); NT = (min(SEQ, pos0 + 384) - klo) >> 6; }
    else if (MODE == 1) { klo = 0; NT = SEQ / 64; }
    else { const int r0 = pos0 >> 6; const int lo = min(max(r0 - 4, 0), 24), hiR = min(max(r0 + 3 - 4, 0), 24) + 8; NT = hiR - lo; if (NT & 1) NT += 1; klo = lo * 64; }
    float slope2 = 0.f; int dbase0 = 0; int cs = 0; bool dummy = false; (void)dummy;
    const float* tbl = nullptr; int rq = 0, rsq = 0;
    if (MODE == 0) { slope2 = exp2f(-8.0f * (float)(h + 1) * (1.0f / 6.0f)) * LOG2E; dbase0 = klo + 4 * hi - (pos0 + wid * 32 + r32); }
    if (MODE == 2) {
        float* TB = (float*)(lds + OFF_TB);
        for (int i = tid; i < 15 * 31; i += 512) { const int a = i / 31, b = i - a * 31; TB[a * TB_PITCH + 64 + b] = extra[i] * LOG2E; }
        const int c = (wid & 1) * 32 + r32; rq = (pos0 >> 6) + (wid >> 1); rsq = min(max(rq - 4, 0), 24); cs = min(max(c - 8, 0), 48);
        tbl = TB + 64 + 15 - c + 4 * hi;
    }
    float m_reg = -1e30f, l_reg = 0; f32x16 o[4];
#pragma unroll
    for (int d = 0; d < 4; ++d)
#pragma unroll
        for (int r = 0; r < 16; ++r) o[d][r] = 0.f;
    constexpr int NPARK = (MODE == 2) ? 6 : 4, NQR = ND - NPARK, QRP = NPARK * 32 + 16;
    bf16x8 qr[NQR];
    char* QR = lds + OFF_QR + (wid * 32 + r32) * QRP + hi * 16;
    { const bf16_t* Qw = Qb + (size_t)(wid * 32 + r32) * LDQ + hi * 8;
#pragma unroll
      for (int d0 = 0; d0 < NQR; ++d0) qr[d0] = *(const bf16x8*)(Qw + d0 * 16);
#pragma unroll
      for (int d0 = 0; d0 < NPARK; ++d0) *(bf16x8*)(QR + d0 * 32) = *(const bf16x8*)(Qw + (NQR + d0) * 16); }
    const int sr = tid >> 4, sc = (tid & 15) * 8, vst0 = v_st(sr, sc), vst1 = v_st(32 + sr, sc);
    const int sr2 = tid >> 3, sc2 = 128 + (tid & 7) * 8;
    const int vb0 = (int)(uintptr_t)(LAS char*)V_lds + v_rd_base(lane);
    const char* kbase = K_lds + r32 * KPITCH + hi * 16;
    const bf16_t* Kg = Kh + (size_t)klo * LDK; const bf16_t* Vg = Vh + (size_t)klo * LDV;
    bf16x8 sAvv0, sAvv1, sAkk0, sAkk1, sAkk2, sBvv0, sBvv1, sBkk0, sBkk1, sBkk2;
#define AT_KSWZ(row, colB) ((row) * KPITCH + (colB))
#define AT_SLOAD(S, koff) do { S##vv0 = *(const bf16x8*)(Vg + (size_t)((koff) + sr) * LDV + sc); S##vv1 = *(const bf16x8*)(Vg + (size_t)((koff) + 32 + sr) * LDV + sc); \
        S##kk0 = *(const bf16x8*)(Kg + (size_t)((koff) + sr) * LDK + sc); S##kk1 = *(const bf16x8*)(Kg + (size_t)((koff) + 32 + sr) * LDK + sc); \
        if (DQK == 192) S##kk2 = *(const bf16x8*)(Kg + (size_t)((koff) + sr2) * LDK + sc2); } while (0)
#define AT_SWRITE(b, S) do { *(bf16x8*)(V_lds + (b) * SHM_V + vst0) = S##vv0; *(bf16x8*)(V_lds + (b) * SHM_V + vst1) = S##vv1; \
        *(bf16x8*)(K_lds + (b) * SHM_K + AT_KSWZ(sr, sc * 2)) = S##kk0; *(bf16x8*)(K_lds + (b) * SHM_K + AT_KSWZ(32 + sr, sc * 2)) = S##kk1; \
        if (DQK == 192) *(bf16x8*)(K_lds + (b) * SHM_K + AT_KSWZ(sr2, sc2 * 2)) = S##kk2; } while (0)
#define AT_SWAIT() do { if (DQK == 192) asm volatile("s_waitcnt vmcnt(5)" ::: "memory"); else asm volatile("s_waitcnt vmcnt(4)" ::: "memory"); } while (0)
#define AT_RESC(a) do { if (__any((a) < 1.f)) { if (hi == 0) al_l[r32] = (a); asm volatile("s_waitcnt lgkmcnt(0)" ::: "memory"); \
        _Pragma("unroll") for (int d = 0; d < 4; ++d) _Pragma("unroll") for (int r = 0; r < 16; ++r) o[d][r] *= al_l[crow(r, hi)]; } } while (0)
#define AT_QKT(P0, P1, b) do { const char* Ks_ = kbase + (b) * SHM_K; \
        _Pragma("unroll") for (int r = 0; r < 16; ++r) { P0[r] = 0.f; P1[r] = 0.f; } \
        _Pragma("unroll") for (int d0 = 0; d0 < ND; ++d0) { \
            const bf16x8 b0 = *(const bf16x8*)(Ks_ + d0 * 32), b1 = *(const bf16x8*)(Ks_ + 32 * KPITCH + d0 * 32); \
            const bf16x8 qf_ = d0 < NQR ? qr[d0 < NQR ? d0 : 0] : *(const bf16x8*)(QR + (d0 >= NQR ? d0 - NQR : 0) * 32); \
            P0 = __builtin_amdgcn_mfma_f32_32x32x16_bf16(b0, qf_, P0, 0, 0, 0); P1 = __builtin_amdgcn_mfma_f32_32x32x16_bf16(b1, qf_, P1, 0, 0, 0); } } while (0)
#define AT_MASK(P0, P1, j) do { \
        if (MODE == 0) { const int db = dbase0 + (j) * 64; \
            _Pragma("unroll") for (int r = 0; r < 16; ++r) { const int d0_ = db + creg(r), d1_ = d0_ + 32; const int a0_ = d0_ < 0 ? -d0_ : d0_, a1_ = d1_ < 0 ? -d1_ : d1_; \
                P0[r] = a0_ <= 128 ? P0[r] - slope2 * (float)a0_ : NEGINF; P1[r] = a1_ <= 128 ? P1[r] - slope2 * (float)a1_ : NEGINF; } } \
        if (MODE == 2) { const int kr_ = (klo >> 6) + (j); const bool tok_ = (kr_ >= rsq) && (kr_ < rsq + 8); const int di_ = min(max(kr_ - rq + 7, 0), 14); \
            const float* tb_ = tbl + di_ * TB_PITCH; const int kc0_ = 4 * hi - cs; \
            _Pragma("unroll") for (int r = 0; r < 16; ++r) { const unsigned u0_ = (unsigned)(kc0_ + creg(r)), u1_ = (unsigned)(kc0_ + creg(r) + 32); \
                P0[r] = (tok_ && u0_ < 16u) ? P0[r] + tb_[creg(r)] : NEGINF; P1[r] = (tok_ && u1_ < 16u) ? P1[r] + tb_[creg(r) + 32] : NEGINF; } } } while (0)
    f32x16 pA0, pA1, pB0, pB1; float mnA, mnB, alA, alB; bf16x8 pa0, pa1, pa2, pa3;
    __syncthreads();
    constexpr int SD = 1;
    int jlo = 0, jhi = NT;
    if (MODE == 0) { const int q0w = pos0 + wid_s * 32, t_ = q0w - 191 - klo; jlo = t_ <= 0 ? 0 : (t_ + 63) >> 6; jhi = min(NT, ((q0w + 159 - klo) >> 6) + 1); }
    if (MODE == 2) { const int rq_s = (pos0 >> 6) + (wid_s >> 1), rs_s = min(max(rq_s - 4, 0), 24); jlo = rs_s - (klo >> 6); jhi = jlo + 8; }
#define AT_NEED(j) ((MODE == 1) || ((j) >= jlo && (j) < jhi))
    AT_SLOAD(sA, 0); asm volatile("s_waitcnt vmcnt(0)" ::: "memory"); AT_SWRITE(0, sA); __syncthreads();
    if (AT_NEED(0)) { AT_QKT(pA0, pA1, 0); AT_MASK(pA0, pA1, 0); partialSM(pA0, pA1, m_reg, mnA, alA); }
    if (SD == 2) { AT_SLOAD(sB, KVBLK); if (2 < NT) AT_SLOAD(sA, 2 * KVBLK); AT_SWAIT(); AT_SWRITE(1, sB); }
    else { AT_SLOAD(sA, KVBLK); AT_SWRITE(1, sA); }
    __syncthreads();
    for (int j = 1; j + 1 < NT; j += 2) {
        const bool nP = AT_NEED(j - 1), nC = AT_NEED(j), nN = AT_NEED(j + 1);
        if (SD == 1) { AT_SLOAD(sA, (j + 1) * KVBLK); }
        AT_SBAR(); if (nC) { AT_QKT(pB0, pB1, 1); AT_MASK(pB0, pB1, j); }
        if (nP) finishSM(pA0, pA1, alA, l_reg, pa0, pa1, pa2, pa3);
        AT_SBAR();
        if (SD == 2) AT_SLOAD(sB, (j + 2) * KVBLK);
        AT_SBAR();
        if (nP) pv_d0(o, vb0, pa0, pa1, pa2, pa3);
        if (nC) partialSM(pB0, pB1, m_reg, mnB, alB);
        __syncthreads(); if (SD == 2) AT_SWAIT(); AT_SWRITE(0, sA);
        if (nC) AT_RESC(alB);
        __syncthreads();
        if (SD == 1) { AT_SLOAD(sA, (j + 2) * KVBLK); }
        AT_SBAR(); if (nN) { AT_QKT(pA0, pA1, 0); AT_MASK(pA0, pA1, j + 1); }
        if (nC) finishSM(pB0, pB1, alB, l_reg, pa0, pa1, pa2, pa3);
        AT_SBAR();
        if (SD == 2) { if (j + 3 < NT) AT_SLOAD(sA, (j + 3) * KVBLK); }
        AT_SBAR();
        if (nC) pv_d0(o, vb0 + SHM_V, pa0, pa1, pa2, pa3);
        if (nN) partialSM(pA0, pA1, m_reg, mnA, alA);
        __syncthreads(); if (SD == 2) { AT_SWAIT(); AT_SWRITE(1, sB); } else AT_SWRITE(1, sA);
        if (nN) AT_RESC(alA);
        __syncthreads();
    }
    {
        const bool nP = AT_NEED(NT - 2), nC = AT_NEED(NT - 1);
        AT_SBAR(); if (nC) { AT_QKT(pB0, pB1, 1); AT_MASK(pB0, pB1, NT - 1); }
        if (nP) finishSM(pA0, pA1, alA, l_reg, pa0, pa1, pa2, pa3);
        AT_SBAR();
        if (nP) pv_d0(o, vb0, pa0, pa1, pa2, pa3);
        if (nC) partialSM(pB0, pB1, m_reg, mnB, alB);
        __syncthreads();
        if (nC) { AT_RESC(alB); finishSM(pB0, pB1, alB, l_reg, pa0, pa1, pa2, pa3); }
        AT_SBAR();
        if (nC) pv_d0(o, vb0 + SHM_V, pa0, pa1, pa2, pa3);
    }
#undef AT_NEED
    float fin;
    if (MODE == 0) { const float sk = extra[0] * LOG2E, mf = fmaxf(m_reg, sk), a = __builtin_amdgcn_exp2f(m_reg - mf); fin = a * __builtin_amdgcn_rcpf(l_reg * a + __builtin_amdgcn_exp2f(sk - mf)); }
    else fin = __builtin_amdgcn_rcpf(l_reg);
    if (hi == 0) li_l[r32] = fin;
    asm volatile("s_waitcnt lgkmcnt(0)" ::: "memory");
    __syncthreads();
    bf16_t* Ot = (bf16_t*)lds + wid * (32 * 136);
#pragma unroll
    for (int r = 0; r < 16; ++r) { const int orow = crow(r, hi); const float f = li_l[orow];
#pragma unroll
        for (int d0 = 0; d0 < 4; ++d0) Ot[orow * 136 + d0 * 32 + r32] = (bf16_t)(cvt_pk_bf16(o[d0][r] * f, 0.f) & 0xffffu); }
    asm volatile("s_waitcnt lgkmcnt(0)" ::: "memory");
#pragma unroll
    for (int i = 0; i < 8; ++i) { const int idx = i * 64 + lane, row = idx >> 4, c8 = (idx & 15) * 8;
        const u32x4 ov = *(const u32x4*)(Ot + row * 136 + c8);
        bf16_t* yp = Yb + (size_t)(wid * 32 + row) * NP + c8; const u32x4 sg = *(const u32x4*)yp; u32x4 w;
        w.x = cvt_pk_bf16(bflo(ov.x) * bflo(sg.x), bfhi(ov.x) * bfhi(sg.x)); w.y = cvt_pk_bf16(bflo(ov.y) * bflo(sg.y), bfhi(ov.y) * bfhi(sg.y));
        w.z = cvt_pk_bf16(bflo(ov.z) * bflo(sg.z), bfhi(ov.z) * bfhi(sg.z)); w.w = cvt_pk_bf16(bflo(ov.w) * bflo(sg.w), bfhi(ov.w) * bfhi(sg.w));
        *(u32x4*)yp = w; }
#undef AT_KSWZ
#undef AT_SLOAD
#undef AT_SWRITE
#undef AT_SWAIT
#undef AT_RESC
#undef AT_QKT
#undef AT_MASK
}
}


constexpr int CVT_ITEMS = 1408 + 160;
__device__ __forceinline__ void cvt_item(const Params& p, unsigned char* wsl, int l, int r, float* ldsf, int wtid) {
    if (r < 768) cvt_tile<1>(p.w_in + (size_t)l * DM * INW, INW, DM, p.norm_in + l * DM, (bf16_t*)(wsl + OFF_WIN), ldsf, r >> 5, r & 31, wtid);
    else if (r < 816) cvt_tile<2>(p.b_w_uq + (size_t)l * 512 * 1152, 1152, 512, p.b_cq_norm + l * 512, (bf16_t*)(wsl + OFF_WUQ), ldsf, (r - 768) >> 3, (r - 768) & 7, wtid);
    else if (r < 864) cvt_tile<0>(p.b_w_ukv + (size_t)l * 512 * 1536, 1536, 512, p.b_ckv_norm + l * 512, (bf16_t*)(wsl + OFF_WUKV), ldsf, (r - 816) >> 3, (r - 816) & 7, wtid);
    else if (r < 1120) cvt_tile<0>(p.w_out + (size_t)l * DM * DM, DM, DM, nullptr, (bf16_t*)(wsl + OFF_WOUT), ldsf, (r - 864) >> 5, (r - 864) & 31, wtid);
    else if (r < 1376) cvt_tile<0>(p.w_gate + (size_t)l * DM * DM, DM, DM, p.ple_norm + l * DM, (bf16_t*)(wsl + OFF_WGATE), ldsf, (r - 1120) >> 5, (r - 1120) & 31, wtid);
    else if (r < 1408) cvt_tile<0>(p.w_proj + (size_t)l * 256 * DM, DM, 256, nullptr, (bf16_t*)(wsl + OFF_WPROJ), ldsf, (r - 1376) >> 2, (r - 1376) & 3, wtid);
    else { const int t0 = (r - 1408) * 256; bf16_t* PBl = (bf16_t*)(wsl + OFF_PB);
        const float* srcb = t0 < 8192 ? p.p_prompt + ((size_t)l * 8192 + t0) * 256 : p.p_sample + ((size_t)l * 32768 + (t0 - 8192)) * 256;
#pragma unroll 4
        for (int i = wtid; i < 256 * 256 / 8; i += 512) { const int e = i * 8; *(u32x4*)(PBl + (size_t)t0 * 256 + e) = pack8(*(const f32x4*)(srcb + e), *(const f32x4*)(srcb + e + 4)); } }
}

#define XB_TMO      128
#define XB_XCNT(j)  (256  + 64 * (j))
#define XB_XSUB(j)  (1280 + 64 * (j))
#define XB_XGEN(j)  (2304 + 64 * (j))
#define XB_TOP      3328
#define XB_TOPGEN   3392
#define XCD_BAR_WORDS 3456
#define XB_SPIN_CAP (1u << 18)
__device__ __forceinline__ unsigned xb_ld(unsigned* p)              { return __hip_atomic_load(p, __ATOMIC_RELAXED, __HIP_MEMORY_SCOPE_AGENT); }
__device__ __forceinline__ unsigned xb_add(unsigned* p, unsigned v) { return __hip_atomic_fetch_add(p, v, __ATOMIC_RELAXED, __HIP_MEMORY_SCOPE_AGENT); }
__device__ __forceinline__ unsigned xb_xcc_id() { return (unsigned)__builtin_amdgcn_s_getreg((3 << 11) | 20) & 0xFu; }
#define XB_SPIN(cond, bar) do { unsigned _sp = 0; while (cond) { __builtin_amdgcn_s_sleep(1); \
    if ((++_sp & 255u) == 0u) { if (xb_ld(&(bar)[XB_TMO])) break; if (_sp > XB_SPIN_CAP) { atomicAdd(&(bar)[XB_TMO], 1u); break; } } } } while (0)
struct XcdBarrier { unsigned* bar; unsigned x; volatile LAS unsigned* st; };
__device__ __forceinline__ void xcd_barrier_complete(unsigned* bar, unsigned x, unsigned& nloc, unsigned& nx) {
    const unsigned G = gridDim.x * gridDim.y * gridDim.z;
    unsigned sum, cnt, mine, sp = 0u;
    for (;;) {
        sum = 0u; cnt = 0u; mine = 0u;
#pragma unroll
        for (unsigned j = 0; j < 16; ++j) { const unsigned c = xb_ld(&bar[XB_XCNT(j)]); sum += c; cnt += (c > 0u) ? 1u : 0u; mine = (j == x) ? c : mine; }
        if (sum == G) break;
        __builtin_amdgcn_s_sleep(1);
        if ((++sp & 255u) == 0u) { if (xb_ld(&bar[XB_TMO])) break; if (sp > XB_SPIN_CAP) { atomicAdd(&bar[XB_TMO], 1u); break; } }
    }
    nloc = mine > 0u ? mine : 1u; nx = cnt > 0u ? cnt : 1u;
}
__device__ __forceinline__ void xcd_barrier(const XcdBarrier& b, bool leader_thread) {
    asm volatile("s_waitcnt vmcnt(0)" ::: "memory");
    __syncthreads();
    if (leader_thread) {
        unsigned* bar = b.bar;
        __builtin_amdgcn_s_waitcnt(0);
        unsigned nloc = b.st[0], nx = b.st[1];
        if (nloc == 0u) { xcd_barrier_complete(bar, b.x, nloc, nx); b.st[0] = nloc; b.st[1] = nx; }
        const unsigned old = xb_add(&bar[XB_XSUB(b.x)], 1u);
        const unsigned gen = old / nloc;
        if (old + 1u == (gen + 1u) * nloc) {
            __builtin_amdgcn_fence(__ATOMIC_RELEASE, "agent");
            asm volatile("s_waitcnt vmcnt(0)" ::: "memory");
            const unsigned og = xb_add(&bar[XB_TOP], 1u);
            const unsigned tg = og / nx;
            if (og + 1u == (tg + 1u) * nx) xb_add(&bar[XB_TOPGEN], 1u);
            else XB_SPIN(xb_ld(&bar[XB_TOPGEN]) == tg, bar);
            __builtin_amdgcn_fence(__ATOMIC_ACQUIRE, "agent");
            xb_add(&bar[XB_XGEN(b.x)], 1u);
            asm volatile("s_waitcnt vmcnt(0)" ::: "memory");
        } else {
            XB_SPIN(xb_ld(&bar[XB_XGEN(b.x)]) == gen, bar);
            __builtin_amdgcn_fence(__ATOMIC_ACQUIRE, "agent");
            asm volatile("s_waitcnt vmcnt(0)" ::: "memory");
        }
    }
    __syncthreads();
}

__global__ __launch_bounds__(512, 2) void hymba_fwd(Params p) {
    extern __shared__ __attribute__((aligned(16))) unsigned char shm[];
    cg::grid_group grid = cg::this_grid();
    LAS unsigned char* lds = (LAS unsigned char*)shm;
    LAS float* TABL = (LAS float*)(lds + LDS_STAGE);
    float* ldsf = (float*)shm;
    unsigned char* ws = p.ws;
    bf16_t* HBB = (bf16_t*)(ws + OFF_HBB); bf16_t* PROJ = (bf16_t*)(ws + OFF_PROJ);
    bf16_t* QB = (bf16_t*)(ws + OFF_QB); bf16_t* KB = (bf16_t*)(ws + OFF_KB); bf16_t* VB = (bf16_t*)(ws + OFF_VB); bf16_t* HBA = QB;
    float* SS = (float*)(ws + OFF_SS); float2* tab = (float2*)(ws + OFF_TAB); float* GT = (float*)(ws + OFF_GT); unsigned* CTR = (unsigned*)(ws + OFF_CTR);
#define SSP(kind, l) (SS + ((size_t)(kind) * 4 + (l)) * TTOT)
    const int wid_s = __builtin_amdgcn_readfirstlane((int)threadIdx.x >> 6);
    volatile LAS unsigned* xbst = (volatile LAS unsigned*)((LAS unsigned char*)shm + LDS_XB);
    if (threadIdx.x == 0) { xbst[0] = 0u; xbst[1] = 0u; xbst[2] = 0u; xbst[3] = 0u; }
    __syncthreads();
#define XBAR_NOW() ({ XcdBarrier b_; b_.bar = (unsigned*)(p.ws + OFF_BAR); b_.x = xb_xcc_id(); b_.st = (volatile LAS unsigned*)((LAS unsigned char*)shm + LDS_XB); b_; })
    const int tid = threadIdx.x, gthreads = gridDim.x * 512, gtid = blockIdx.x * 512 + tid;
#if PROBE_SEL
    unsigned long long t_acc = 0, t_mark = __builtin_amdgcn_s_memrealtime();
#define PROBE_MARK(cat) do { const unsigned long long n_ = __builtin_amdgcn_s_memrealtime(); if (PROBE_SEL == 8 || (cat) == PROBE_SEL) t_acc += n_ - t_mark; t_mark = n_; } while (0)
#define PROBE_TACC (&t_acc)
#else
#define PROBE_MARK(cat) do { } while (0)
#define PROBE_TACC nullptr
#endif

    for (int i = gtid; i < 5 * 4 * TTOT; i += gthreads) { const int kind = 1 + i / (4 * TTOT), rem = i % (4 * TTOT); SS[(size_t)kind * 4 * TTOT + rem] = 0.f; }
    for (int i = gtid; i < 3 * TTOT; i += gthreads) SS[TTOT + i] = 0.f;
    if (gtid < 32) CTR[gtid] = 0u;
    for (int i = gtid; i < XCD_BAR_WORDS; i += gthreads) ((unsigned*)(p.ws + OFF_BAR))[i] = 0u;
    if (gtid < 2048) { const int l = gtid >> 9, w = (gtid >> 7) & 3, d = gtid & 127; float v;
        if (w == 0) v = p.a_q_norm[l * 128 + d]; else if (w == 1) v = p.a_k_norm[l * 128 + d]; else if (w == 2) v = p.c_q_norm[l * 128 + d]; else v = p.c_k_norm[l * 128 + d];
        GT[gtid] = v; }
    for (int i = gtid; i < SEQ * 32; i += gthreads) { const int pos = i >> 5, j = i & 31; const double ang = (double)pos * pow(10000.0, -(double)j / 32.0); tab[i] = make_float2((float)cos(ang), (float)sin(ang)); }
    {
        const int gw = gtid >> 6, nw = gthreads >> 6, lane = tid & 63;
        for (int row = gw; row < TTOT; row += nw) {
            const float* src = row < 8192 ? p.x_prompt + (size_t)row * DM : p.x_sample + (size_t)(row - 8192) * DM; float s = 0.f;
#pragma unroll
            for (int i = 0; i < 4; ++i) { const int c = (i * 64 + lane) * 8; const f32x4 a = *(const f32x4*)(src + c), b = *(const f32x4*)(src + c + 4);
                s += sq4(a) + sq4(b); *(u32x4*)(HBB + (size_t)row * DM + c) = pack8(a, b); }
            s = wave_sum(s); if (lane == 0) SSP(0, 0)[row] = s;
        }
    }

    for (int l = 0; l < 4; ++l) {
        unsigned char* const wsl = ws + (size_t)(l & 1) * SZ_LAYER;
        if (l == 0) {
            int wtid = wid_s * 64 + lane_id(); asm volatile("" : "+v"(wtid));
            for (int r = blockIdx.x; r < CVT_ITEMS; r += gridDim.x) cvt_item(p, wsl, 0, r, ldsf, wtid);
            PROBE_MARK(1); grid.sync(); PROBE_MARK(7);
            if (wid_s == 0 && lane_id() == 0) (void)xb_add(&((unsigned*)(p.ws + OFF_BAR))[XB_XCNT(xb_xcc_id())], 1u);
        }
        {
            constexpr int r0 = 0, TC = TTOT;
            pg8::StaticOrder S;
            {
                pg8::Gemm g{HBB + (size_t)r0 * DM, (const bf16_t*)(wsl + OFF_WIN), DM, TC, NP, DM};
                EpiProj E{PROJ, SSP(0, l) + r0, SSP(3, l) + r0, SSP(5, l) + r0, GT + l * 512, p.b_k_norm + l * 192 + 128, tab, TABL};
                S.init(TC, NP, gridDim.x, blockIdx.x); pg8::gemm_phase(lds, g, S, E, wid_s, PROBE_TACC);
            }
            PROBE_MARK(2); xcd_barrier(XBAR_NOW(), wid_s == 0 && lane_id() == 0); PROBE_MARK(7);
            {
                pg8::Gemm g{PROJ + C_BCQ, (const bf16_t*)(wsl + OFF_WUQ), NP, TC, 1536, 512};
                EpiUQ E{QB, SSP(3, l) + r0, p.b_q_norm + l * 192, tab, TABL};
                S.init(TC, 1536, gridDim.x, blockIdx.x); pg8::gemm_phase(lds, g, S, E, wid_s, PROBE_TACC);
            }
            {
                pg8::Gemm g{PROJ + C_BCKV, (const bf16_t*)(wsl + OFF_WUKV), NP, TC, 1536, 512};
                EpiUKV E{KB, VB, PROJ, SSP(4, l) + r0, SSP(5, l) + r0, p.b_k_norm + l * 192, TABL};
                S.init(TC, 1536, gridDim.x, blockIdx.x); pg8::gemm_phase(lds, g, S, E, wid_s, PROBE_TACC);
            }
            PROBE_MARK(3); xcd_barrier(XBAR_NOW(), wid_s == 0 && lane_id() == 0); PROBE_MARK(7);
            {
                constexpr int QB_ITEMS = 120, QC_ITEMS = 80, QA_ITEMS = 120, QW_ITEMS = CVT_ITEMS / 8, Q_ITEMS = QB_ITEMS + QC_ITEMS + QA_ITEMS + QW_ITEMS;
                const int xme = (int)(xb_xcc_id() & 7u);
                LAS int* slot = (LAS int*)(lds + at::OFF_SLOT);
                for (int dx = 0; dx < 8; ++dx) {
                    const int xq = (xme + dx) & 7;
                    unsigned* ctr = CTR + l * 8 + xq;
                    for (;;) {
                        __syncthreads();
                        if (wid_s == 0 && lane_id() == 0) *slot = (int)atomicAdd(ctr, 1u);
                        __syncthreads();
                        const int k = *slot;
                        if (k >= Q_ITEMS) break;
                        if (k < QB_ITEMS) { const int s = xq + 8 * (k >> 3), sq = s / 6, hh = s - sq * 6, sb = sq * SEQ, t0 = sb + (k & 7) * 256;
                            at::attn_unit<1>(QB + (size_t)t0 * 1152 + hh * 192, KB + (size_t)sb * 1152 + hh * 192, VB + (size_t)sb * 768 + hh * 128, PROJ + (size_t)t0 * NP + C_Z + 768 + hh * 128,
                                             t0 & (SEQ - 1), hh, nullptr, (char*)shm, wid_s); }
                        else if (k < QB_ITEMS + QC_ITEMS) { const int k2 = k - QB_ITEMS, s = xq + 8 * (k2 >> 3), sq = s >> 2, hh = s & 3, sb = sq * SEQ, t0 = sb + (k2 & 7) * 256;
                            at::attn_unit<2>(PROJ + (size_t)t0 * NP + C_CQ + hh * 128, PROJ + (size_t)sb * NP + C_CK + hh * 128, PROJ + (size_t)sb * NP + C_CV + hh * 128, PROJ + (size_t)t0 * NP + C_Z + 1536 + hh * 128,
                                             t0 & (SEQ - 1), hh, p.c_rpb + ((size_t)l * 4 + hh) * 15 * 31, (char*)shm, wid_s); }
                        else if (k < QB_ITEMS + QC_ITEMS + QA_ITEMS) { const int k2 = k - QB_ITEMS - QC_ITEMS, g = xq + 8 * (k2 / 24), r = k2 % 24, sq = g >> 1, kvh = g & 1, hh = kvh * 3 + r % 3, sb = sq * SEQ, t0 = sb + (r / 3) * 256;
                            at::attn_unit<0>(PROJ + (size_t)t0 * NP + C_AQ + hh * 128, PROJ + (size_t)sb * NP + C_AK + kvh * 128, PROJ + (size_t)sb * NP + C_AV + kvh * 128, PROJ + (size_t)t0 * NP + C_Z + hh * 128,
                                             t0 & (SEQ - 1), hh, p.a_sink + l * 6 + hh, (char*)shm, wid_s); }
                        else if (l < 3) { int wtid = wid_s * 64 + lane_id(); asm volatile("" : "+v"(wtid)); cvt_item(p, ws + (size_t)((l + 1) & 1) * SZ_LAYER, l + 1, xq + 8 * (k - (QB_ITEMS + QC_ITEMS + QA_ITEMS)), ldsf, wtid); }
                    }
                }
            }
            PROBE_MARK(4); xcd_barrier(XBAR_NOW(), wid_s == 0 && lane_id() == 0); PROBE_MARK(7);
            for (int s2 = 0; s2 < 2; ++s2) {
                if ((s2 ^ (int)((blockIdx.x >> 3) & 1)) == 0) {
                    const float* hin = (l == 0) ? p.x_prompt : p.h; const long hdelta = (l == 0) ? (long)((p.x_sample - (size_t)8192 * DM) - p.x_prompt) : 0;
                    pg8::Gemm g{PROJ + C_Z, (const bf16_t*)(wsl + OFF_WOUT), NP, TC, DM, DM};
                    EpiOut E{hin, hdelta, p.h, HBA, SSP(1, l)};
                    S.init(TC, DM, gridDim.x, blockIdx.x); pg8::gemm_phase(lds, g, S, E, wid_s, PROBE_TACC);
                } else {
                    pg8::Gemm g{(const bf16_t*)(wsl + OFF_PB), (const bf16_t*)(wsl + OFF_WPROJ), 256, TC, DM, 256};
                    EpiPP E{PROJ, SSP(2, l) + r0, p.post_norm + l * DM};
                    S.init(TC, DM, gridDim.x, blockIdx.x); pg8::gemm_phase(lds, g, S, E, wid_s, PROBE_TACC);
                }
            }
            PROBE_MARK(5); xcd_barrier(XBAR_NOW(), wid_s == 0 && lane_id() == 0); PROBE_MARK(7);
            {
                pg8::Gemm g{HBA, (const bf16_t*)(wsl + OFF_WGATE), DM, TC, DM, DM};
                EpiGate E{p.h + (size_t)r0 * DM, HBB + (size_t)r0 * DM, PROJ, SSP(1, l) + r0, SSP(2, l) + r0, (l < 3) ? SSP(0, l + 1) + r0 : nullptr};
                S.init(TC, DM, gridDim.x, blockIdx.x); pg8::gemm_phase(lds, g, S, E, wid_s, PROBE_TACC);
            }
            PROBE_MARK(6); xcd_barrier(XBAR_NOW(), wid_s == 0 && lane_id() == 0); PROBE_MARK(7);
        }
    }
#if PROBE_SEL
    if (blockIdx.x == 0 && wid_s == 0 && lane_id() == 0) p.h[0] += (float)t_acc * (1e-5f * 4.0f);
#endif
}

extern "C" void kernel_launch(void* const* d_in, const int* in_sizes, int n_in, void* d_out, int out_size, void* d_ws, size_t ws_size, hipStream_t stream) {
    static int grid_blocks = 0;
    if (grid_blocks == 0) {
        if (n_in != 23 || ws_size < WS_END) { fprintf(stderr, "kernel_launch: need 23 inputs and %zu bytes of workspace (got %d, %zu)\n", (size_t)WS_END, n_in, ws_size); grid_blocks = -1; return; }
        int dev = 0, cus = 0, per_cu = 0;
        if (hipGetDevice(&dev) != hipSuccess || hipDeviceGetAttribute(&cus, hipDeviceAttributeMultiprocessorCount, dev) != hipSuccess) { grid_blocks = -1; return; }
        if (hipFuncSetAttribute((const void*)hymba_fwd, hipFuncAttributeMaxDynamicSharedMemorySize, LDS_BYTES) != hipSuccess) { fprintf(stderr, "kernel_launch: hipFuncSetAttribute failed\n"); grid_blocks = -1; return; }
        if (hipOccupancyMaxActiveBlocksPerMultiprocessor(&per_cu, (const void*)hymba_fwd, 512, LDS_BYTES) != hipSuccess || per_cu < 1) { fprintf(stderr, "kernel_launch: occupancy query failed (%d)\n", per_cu); (void)hipGetLastError(); per_cu = 1; }
        grid_blocks = cus * per_cu;
    }
    if (grid_blocks < 0) return;
    Params p{};
    const float** pf = (const float**)&p;
    for (int i = 0; i < 23; ++i) pf[i] = (const float*)d_in[i];
    p.h = (float*)d_out; p.ws = (unsigned char*)d_ws;
    void* args[] = {&p};
    hipError_t e = hipLaunchCooperativeKernel((const void*)hymba_fwd, dim3(grid_blocks), dim3(512), args, LDS_BYTES, stream);
    if (e != hipSuccess) fprintf(stderr, "cooperative launch failed: %s (grid %d)\n", hipGetErrorString(e), grid_blocks);
}
```

```cpp
#include <hip/hip_runtime.h>
#include <hip/hip_cooperative_groups.h>
#include <cstdio>
#include <math.h>
namespace cg = cooperative_groups;
#define PROBE_SEL 0

#define LAS __attribute__((address_space(3)))
typedef unsigned short bf16_t;
typedef short bf16x8 __attribute__((ext_vector_type(8)));
typedef float f32x4 __attribute__((ext_vector_type(4)));
typedef unsigned u32x4 __attribute__((ext_vector_type(4)));
typedef unsigned u32x2 __attribute__((ext_vector_type(2)));

constexpr int SEQ = 2048, DM = 2048, INW = 5952, TTOT = 40960, NP = 6144;
constexpr int O_AQ = 0, O_AK = 768, O_AV = 1024, O_AZ = 1280, O_BCQ = 2048, O_BCKV = 2560, O_BKR = 3072, O_BZ = 3136, O_CQ = 3904, O_CK = 4416, O_CV = 4928, O_CZ = 5440;
constexpr int C_AQ = 0, C_AK = 768, C_AV = 1024, C_BCQ = 1280, C_BCKV = 1792, C_CQ = 2304, C_CK = 2816, C_CV = 3328, C_Z = 3840, C_KR = 5888;
constexpr float LOG2E = 1.4426950408889634f;
constexpr float QS_A = 0.08838834764831845f * LOG2E;
constexpr float QS_B = 0.07216878364870323f * LOG2E;
constexpr size_t SZ_WIN = (size_t)NP * 2048 * 2, SZ_WU = (size_t)1536 * 512 * 2, SZ_WSQ = (size_t)2048 * 2048 * 2, SZ_WPROJ = (size_t)2048 * 256 * 2;
constexpr size_t OFF_WIN = 0, OFF_WUQ = OFF_WIN + SZ_WIN, OFF_WUKV = OFF_WUQ + SZ_WU, OFF_WOUT = OFF_WUKV + SZ_WU, OFF_WGATE = OFF_WOUT + SZ_WSQ,
                 OFF_WPROJ = OFF_WGATE + SZ_WSQ, OFF_PB = OFF_WPROJ + SZ_WPROJ, SZ_LAYER = OFF_PB + (size_t)TTOT * 256 * 2,
                 OFF_HBB = 2 * SZ_LAYER,
                 OFF_PROJ = OFF_HBB + (size_t)TTOT * DM * 2, OFF_QB = OFF_PROJ + (size_t)TTOT * NP * 2, OFF_KB = OFF_QB + (size_t)TTOT * 1152 * 2,
                 OFF_VB = OFF_KB + (size_t)TTOT * 1152 * 2, OFF_SS = OFF_VB + (size_t)TTOT * 768 * 2, OFF_TAB = OFF_SS + (size_t)6 * 4 * TTOT * 4,
                 OFF_GT = OFF_TAB + (size_t)SEQ * 32 * 8, OFF_CTR = OFF_GT + 4 * 4 * 128 * 4, OFF_BAR = OFF_CTR + 256, WS_END = OFF_BAR + 3456 * 4;
static_assert(WS_END <= (size_t)1 << 30, "workspace budget");
constexpr int LDS_STAGE = 131072, LDS_XB = 148992, LDS_BYTES = LDS_XB + 16;
constexpr unsigned long long STAGGER_TICKS = 2200;

struct Params {
    const float *x_prompt, *x_sample, *p_prompt, *p_sample, *norm_in, *w_in, *a_q_norm, *a_k_norm, *a_sink, *b_cq_norm, *b_ckv_norm, *b_w_uq, *b_w_ukv,
        *b_q_norm, *b_k_norm, *c_q_norm, *c_k_norm, *c_rpb, *w_out, *ple_norm, *w_gate, *w_proj, *post_norm;
    float* h;
    unsigned char* ws;
};

__device__ __forceinline__ unsigned cvt_pk_bf16(float lo, float hi) { unsigned r; asm volatile("v_cvt_pk_bf16_f32 %0, %1, %2" : "=v"(r) : "v"(lo), "v"(hi)); return r; }
__device__ __forceinline__ float bf2f(unsigned short b) { return __uint_as_float(((unsigned)b) << 16); }
__device__ __forceinline__ float bflo(unsigned w) { return __uint_as_float(w << 16); }
__device__ __forceinline__ float bfhi(unsigned w) { return __uint_as_float(w & 0xffff0000u); }
__device__ __forceinline__ int lane_id() { unsigned m = ~0u; asm volatile("" : "+s"(m)); return (int)__builtin_amdgcn_mbcnt_hi(m, __builtin_amdgcn_mbcnt_lo(m, 0u)); }
__device__ __forceinline__ float wave_sum(float v) {
#pragma unroll
    for (int o = 32; o >= 1; o >>= 1) v += __shfl_xor(v, o);
    return v;
}

namespace pg8 {
constexpr int BM = 256, BK = 64, HALF = 128, HTB = HALF * BK * 2, STAGE_BYTES = 8 * HTB, NXCD = 8, WGM = 8;
__device__ __forceinline__ int lds_byte(int r, int c) { const int st = (r >> 4) * 2 + (c >> 5), rr = r & 15, cc = c & 31, ob = rr * 64 + cc * 2; return st * 1024 + (ob ^ (((ob >> 9) & 1) << 5)); }
__device__ __forceinline__ void stage_rc(int b, int& R, int& C) { const int st = b / 1024, sb = b % 1024, swz = sb ^ (((sb >> 9) & 1) << 5); R = (st >> 1) * 16 + swz / 64; C = (st & 1) * 32 + (swz % 64) / 2; }
__device__ __forceinline__ int perm32(int rho) { const int n = rho >> 4, i = rho & 15; return 8 * (i >> 2) + 4 * n + (i & 3); }
struct Unit { int pm, pn; };
struct Gemm { const bf16_t* A; const bf16_t* Bt; int lda, M, N, K; };
struct StaticOrder {
    int nM, nN, nwg, G, c;
    __device__ void init(int M, int N, int G_, int c_) { nM = M / BM; nN = N / BM; nwg = nM * nN; G = G_; c = c_; }
    __device__ bool next(int i, Unit& u) const {
        const long L = (long)i * G + c; if (L >= nwg) return false;
        int wgid = (int)L; { const int q = nwg / NXCD, r = nwg % NXCD, xcd = wgid % NXCD, off = wgid / NXCD; wgid = (xcd < r ? xcd * (q + 1) : r * (q + 1) + (xcd - r) * q) + off; }
        const int nig = WGM * nN, gid = wgid / nig, fm = gid * WGM, gsz = (nM - fm) < WGM ? (nM - fm) : WGM;
        u.pm = fm + ((wgid % nig) % gsz); u.pn = (wgid % nig) / gsz; return true;
    }
};

template <class Epi>
__device__ __forceinline__ void gemm_phase(LAS unsigned char* lds, const Gemm g, const StaticOrder& S, const Epi& E, int wid_s, unsigned long long* tacc = nullptr) {
    int tid = wid_s * 64 + lane_id(); asm volatile("" : "+v"(tid));
    const int wid = __builtin_amdgcn_readfirstlane(tid >> 6), lane = tid & 63, wr = wid >> 2, wc = wid & 3, fr = lane & 15, fq = lane >> 4;
    int K = g.K; asm volatile("" : "+s"(K));
    const int nt = K / BK;
    unsigned voffA[2], voffB[2];
#pragma unroll
    for (int i = 0; i < 2; ++i) { int R, C; stage_rc(tid * 16 + i * 8192, R, C); const int Rb = Epi::PERM ? ((R & ~31) + perm32(R & 31)) : R;
        voffA[i] = (unsigned)(R * g.lda + C) * 2u; voffB[i] = (unsigned)(Rb * K + C) * 2u; }
    const size_t kstep = (size_t)(BK * 2);
    const size_t hstepA = (size_t)HALF * g.lda * 2, hstepB = (size_t)HALF * K * 2;
    const size_t tstepA = 2 * hstepA, tstepB = 2 * hstepB;
    const unsigned ldsw = (unsigned)wid * 1024u;
    const int aoff = lds_byte(wr * 64 + fr, fq * 8), boff = lds_byte(wc * 32 + fr, fq * 8);
#define PG8_SA(b, h) (((b) * 2 + (h)) * HTB)
#define PG8_SB(b, h) ((4 + (b) * 2 + (h)) * HTB)
#define PG8_STAGE(bufoff, gbase, voff) do { _Pragma("unroll") for (int _i = 0; _i < 2; ++_i) \
        __builtin_amdgcn_global_load_lds((const unsigned*)((const char*)(gbase) + (voff)[_i]), (LAS unsigned*)(lds + (bufoff) + ldsw + _i * 8192), 16, 0, 0); } while (0)
#define PG8_LDA(dst, b, h) do { _Pragma("unroll") for (int m = 0; m < 4; ++m) _Pragma("unroll") for (int k = 0; k < 2; ++k) dst[m][k] = *(const LAS bf16x8*)(lds + PG8_SA(b, h) + aoff + m * 2048 + k * 1024); } while (0)
#define PG8_LDB(dst, b, h) do { _Pragma("unroll") for (int n = 0; n < 2; ++n) _Pragma("unroll") for (int k = 0; k < 2; ++k) dst[n][k] = *(const LAS bf16x8*)(lds + PG8_SB(b, h) + boff + n * 2048 + k * 1024); } while (0)
#define PG8_MMA(ai, bj, At, Bt) do { __builtin_amdgcn_s_setprio(1); _Pragma("unroll") for (int m = 0; m < 4; ++m) _Pragma("unroll") for (int n = 0; n < 2; ++n) _Pragma("unroll") for (int k = 0; k < 2; ++k) \
        acc[ai][bj][m][n] = __builtin_amdgcn_mfma_f32_16x16x32_bf16(Bt[n][k], At[m][k], acc[ai][bj][m][n], 0, 0, 0); __builtin_amdgcn_s_setprio(0); } while (0)
#define PG8_WAIT_V(n) asm volatile("s_waitcnt vmcnt(" #n ")" ::: "memory")
#define PG8_WAIT_L(n) asm volatile("s_waitcnt lgkmcnt(" #n ")" ::: "memory")
#define PG8_BAR __builtin_amdgcn_s_barrier()
#define PG8_SCHED __builtin_amdgcn_sched_barrier(0)
    Unit cur, nxt; int ui = 0;
    if (!S.next(0, cur)) return;
    f32x4 acc[2][2][4][2];
#pragma unroll
    for (int a = 0; a < 2; ++a)
#pragma unroll
        for (int b = 0; b < 2; ++b)
#pragma unroll
            for (int m = 0; m < 4; ++m)
#pragma unroll
                for (int n = 0; n < 2; ++n) acc[a][b][m][n] = (f32x4){0.f, 0.f, 0.f, 0.f};
    bf16x8 At[4][2], B0[2][2], B1[2][2];
    const char* cA = (const char*)g.A + (size_t)cur.pm * tstepA; const char* cB = (const char*)g.Bt + (size_t)cur.pn * tstepB;
    PG8_STAGE(PG8_SB(0, 0), cB, voffB); PG8_STAGE(PG8_SA(0, 0), cA, voffA); PG8_STAGE(PG8_SB(0, 1), cB + hstepB, voffB); PG8_STAGE(PG8_SA(0, 1), cA + hstepA, voffA);
    if (wr == 1) PG8_BAR;
    PG8_WAIT_V(4); PG8_BAR;
    PG8_STAGE(PG8_SB(1, 0), cB + kstep, voffB); PG8_STAGE(PG8_SA(1, 0), cA + kstep, voffA); PG8_STAGE(PG8_SB(1, 1), cB + hstepB + kstep, voffB);
    PG8_WAIT_V(6); PG8_BAR;
    for (;;) {
        const bool has_next = S.next(ui + 1, nxt);
        const char* nA = has_next ? (const char*)g.A + (size_t)nxt.pm * tstepA : cA; const char* nB = has_next ? (const char*)g.Bt + (size_t)nxt.pn * tstepB : cB;
#if PROBE_SEL >= 9
        const unsigned long long k0_ = __builtin_amdgcn_s_memrealtime();
#endif
        for (int t = 0; t < nt; t += 2) {
            const bool last = (t == nt - 2);
            const char* a1 = cA + (size_t)(t + 1) * kstep;
            const char* a2 = last ? nA : cA + (size_t)(t + 2) * kstep; const char* b2 = last ? nB : cB + (size_t)(t + 2) * kstep;
            const char* a3 = a2 + kstep; const char* b3 = b2 + kstep;
            PG8_LDB(B0, 0, 0); PG8_SCHED; PG8_LDA(At, 0, 0); PG8_STAGE(PG8_SA(1, 1), a1 + hstepA, voffA);
            PG8_WAIT_L(8); PG8_BAR; PG8_WAIT_L(0); PG8_MMA(0, 0, At, B0); PG8_BAR; PG8_SCHED;
            PG8_LDB(B1, 0, 1); PG8_STAGE(PG8_SB(0, 0), b2, voffB);
            PG8_BAR; PG8_WAIT_L(0); PG8_MMA(0, 1, At, B1); PG8_BAR;
            PG8_LDA(At, 0, 1); PG8_STAGE(PG8_SA(0, 0), a2, voffA);
            PG8_BAR; PG8_WAIT_L(0); PG8_MMA(1, 0, At, B0); PG8_BAR; PG8_SCHED;
            PG8_STAGE(PG8_SB(0, 1), b2 + hstepB, voffB);
            PG8_WAIT_V(6); PG8_BAR; PG8_MMA(1, 1, At, B1); PG8_BAR;
            PG8_LDB(B0, 1, 0); PG8_SCHED; PG8_LDA(At, 1, 0); PG8_STAGE(PG8_SA(0, 1), a2 + hstepA, voffA);
            PG8_WAIT_L(8); PG8_BAR; PG8_WAIT_L(0); PG8_MMA(0, 0, At, B0); PG8_BAR; PG8_SCHED;
            PG8_LDB(B1, 1, 1); PG8_STAGE(PG8_SB(1, 0), b3, voffB);
            PG8_BAR; PG8_WAIT_L(0); PG8_MMA(0, 1, At, B1); PG8_BAR;
            PG8_LDA(At, 1, 1); PG8_STAGE(PG8_SA(1, 0), a3, voffA);
            PG8_BAR; PG8_WAIT_L(0); PG8_MMA(1, 0, At, B0); PG8_BAR; PG8_SCHED;
            PG8_STAGE(PG8_SB(1, 1), b3 + hstepB, voffB);
            PG8_WAIT_V(6); PG8_BAR; PG8_MMA(1, 1, At, B1); PG8_BAR;
        }
#if PROBE_SEL >= 9
        const unsigned long long e0_ = __builtin_amdgcn_s_memrealtime();
        if (Epi::PROBE_ID + 100 == PROBE_SEL) *tacc += e0_ - k0_;
#endif
        E(acc, cur, wr, wc, fr, fq);
#if PROBE_SEL >= 9
        if (Epi::PROBE_ID == PROBE_SEL) *tacc += __builtin_amdgcn_s_memrealtime() - e0_;
#endif
        if (!has_next) break;
#pragma unroll
        for (int a = 0; a < 2; ++a)
#pragma unroll
            for (int b = 0; b < 2; ++b)
#pragma unroll
                for (int m = 0; m < 4; ++m)
#pragma unroll
                    for (int n = 0; n < 2; ++n) acc[a][b][m][n] = (f32x4){0.f, 0.f, 0.f, 0.f};
        cur = nxt; cA = nA; cB = nB; ++ui;
    }
    PG8_WAIT_V(0);
    if (wr == 0) PG8_BAR;
    PG8_BAR;
#undef PG8_SA
#undef PG8_SB
#undef PG8_STAGE
#undef PG8_LDA
#undef PG8_LDB
#undef PG8_MMA
#undef PG8_WAIT_V
#undef PG8_WAIT_L
#undef PG8_BAR
#undef PG8_SCHED
}
}
using pg8::Unit;
typedef f32x4 AccT[2][2][4][2];

#define EPI_BAR() do { asm volatile("s_waitcnt lgkmcnt(0)" ::: "memory"); __builtin_amdgcn_s_barrier(); asm volatile("" ::: "memory"); } while (0)
__device__ __forceinline__ float sq4(const f32x4 v) { return (v[0] * v[0] + v[1] * v[1]) + (v[2] * v[2] + v[3] * v[3]); }
__device__ __forceinline__ float red_fq(float s) { s += __shfl_xor(s, 16); s += __shfl_xor(s, 32); return s; }
__device__ __forceinline__ u32x4 pack8(const f32x4 a, const f32x4 b) { u32x4 w; w.x = cvt_pk_bf16(a[0], a[1]); w.y = cvt_pk_bf16(a[2], a[3]); w.z = cvt_pk_bf16(b[0], b[1]); w.w = cvt_pk_bf16(b[2], b[3]); return w; }

struct EpiProj {
    static constexpr int PROBE_ID = 10;
    static constexpr bool PERM = true;
    bf16_t* PROJ; const float* ssh; float *ss_cq, *ss_kr;
    const float *gt, *g_kr; const float2* tab; LAS float* TABL;
    __device__ __forceinline__ void operator()(AccT& acc, const Unit& u, int wr, int wc, int fr, int fq) const {
        { int ln_ = lane_id(); asm volatile("" : "+v"(ln_)); fr = ln_ & 15; fq = ln_ >> 4; }
        const int lrow0 = wr * 64 + fr, row0 = u.pm * 256 + lrow0, pn = u.pn;
        float rs[2][4];
#pragma unroll
        for (int ai = 0; ai < 2; ++ai)
#pragma unroll
            for (int m = 0; m < 4; ++m) rs[ai][m] = __builtin_amdgcn_rsqf(ssh[row0 + ai * 128 + m * 16] * (1.0f / 2048.0f) + 1e-6f);
        bf16_t* const outp = PROJ + (size_t)row0 * NP + pn * 256 + wc * 32 + 8 * fq;
        const bool is_norm = (pn <= 3) || (pn >= 9 && pn <= 12);
        if (is_norm) {
            const float* g = gt + ((pn <= 2) ? 0 : (pn == 3) ? 128 : (pn <= 10) ? 256 : 384);
            const float qs = (pn <= 2 || pn == 9 || pn == 10) ? QS_A : 1.0f;
            const f32x4 g0r = *(const f32x4*)(g + 32 * wc + 8 * fq), g1r = *(const f32x4*)(g + 32 * wc + 8 * fq + 4);
#pragma unroll
            for (int ai = 0; ai < 2; ++ai)
#pragma unroll
                for (int m = 0; m < 4; ++m)
#pragma unroll
                    for (int bj = 0; bj < 2; ++bj) { float s = red_fq(sq4(acc[ai][bj][m][0]) + sq4(acc[ai][bj][m][1]));
                        if (fq == 0) TABL[((lrow0 + ai * 128 + m * 16) * 2 + bj) * 4 + wc] = s; asm volatile("" ::: "memory"); }
            EPI_BAR();
            const f32x4 g0 = g0r * qs, g1 = g1r * qs;
#pragma unroll
            for (int ai = 0; ai < 2; ++ai)
#pragma unroll
                for (int m = 0; m < 4; ++m)
#pragma unroll
                    for (int bj = 0; bj < 2; ++bj) { const f32x4 t = *(const LAS f32x4*)&TABL[((lrow0 + ai * 128 + m * 16) * 2 + bj) * 4];
                        const float r2 = rs[ai][m] * rs[ai][m];
                        const float rn = rs[ai][m] * __builtin_amdgcn_rsqf(((t[0] + t[1]) + (t[2] + t[3])) * r2 * (1.0f / 128.0f) + 1e-6f);
                        *(u32x4*)(outp + (size_t)(ai * 128 + m * 16) * NP + bj * 128) = pack8(acc[ai][bj][m][0] * rn * g0, acc[ai][bj][m][1] * rn * g1);
                        asm volatile("" ::: "memory"); }
        } else if (pn >= 5 && pn <= 8) {
            float* ss = ss_cq + ((pn <= 6) ? 0 : 4 * TTOT);
#pragma unroll
            for (int ai = 0; ai < 2; ++ai)
#pragma unroll
                for (int m = 0; m < 4; ++m) { const float r = rs[ai][m];
                    float s = red_fq((sq4(acc[ai][0][m][0]) + sq4(acc[ai][0][m][1])) + (sq4(acc[ai][1][m][0]) + sq4(acc[ai][1][m][1]))) * (r * r);
                    if (fq == 0) unsafeAtomicAdd(ss + row0 + ai * 128 + m * 16, s);
#pragma unroll
                    for (int bj = 0; bj < 2; ++bj) *(u32x4*)(outp + (size_t)(ai * 128 + m * 16) * NP + bj * 128) = pack8(acc[ai][bj][m][0] * r, acc[ai][bj][m][1] * r);
                    asm volatile("" ::: "memory"); }
        } else if (pn >= 15 && pn <= 22) {
#pragma unroll
            for (int ai = 0; ai < 2; ++ai)
#pragma unroll
                for (int m = 0; m < 4; ++m) { const float r = rs[ai][m];
#pragma unroll
                    for (int bj = 0; bj < 2; ++bj) { f32x4 o0, o1;
#pragma unroll
                        for (int j = 0; j < 4; ++j) { const float v0 = acc[ai][bj][m][0][j] * r, v1 = acc[ai][bj][m][1][j] * r;
                            o0[j] = v0 * __builtin_amdgcn_rcpf(1.0f + __expf(-v0)); o1[j] = v1 * __builtin_amdgcn_rcpf(1.0f + __expf(-v1)); }
                        *(u32x4*)(outp + (size_t)(ai * 128 + m * 16) * NP + bj * 128) = pack8(o0, o1); }
                    asm volatile("" ::: "memory"); }
        } else if (pn == 23) {
            if (wc < 2) {
                const int gI = wc * 4 + fq;
                const f32x4 gk1 = *(const f32x4*)(g_kr + 4 * gI), gk2 = *(const f32x4*)(g_kr + 32 + 4 * gI);
#pragma unroll
                for (int ai = 0; ai < 2; ++ai)
#pragma unroll
                    for (int m = 0; m < 4; ++m) { const int row = row0 + ai * 128 + m * 16; const float r = rs[ai][m];
                        float s = red_fq(sq4(acc[ai][0][m][0]) + sq4(acc[ai][0][m][1])) * (r * r);
                        if (fq == 0) unsafeAtomicAdd(ss_kr + row, s);
                        const f32x4 x1 = acc[ai][0][m][0] * gk1 * r, x2 = acc[ai][0][m][1] * gk2 * r; f32x4 o1, o2;
                        const float2* tp = tab + (row & (SEQ - 1)) * 32 + 4 * gI;
#pragma unroll
                        for (int j = 0; j < 4; ++j) { const float2 cs = tp[j]; o1[j] = x1[j] * cs.x - x2[j] * cs.y; o2[j] = x1[j] * cs.y + x2[j] * cs.x; }
                        *(u32x4*)(PROJ + (size_t)row * NP + C_KR + 8 * gI) = pack8(o1, o2); asm volatile("" ::: "memory"); }
            }
        } else {
#pragma unroll
            for (int ai = 0; ai < 2; ++ai)
#pragma unroll
                for (int m = 0; m < 4; ++m) { const float r = rs[ai][m];
#pragma unroll
                    for (int bj = 0; bj < 2; ++bj) *(u32x4*)(outp + (size_t)(ai * 128 + m * 16) * NP + bj * 128) = pack8(acc[ai][bj][m][0] * r, acc[ai][bj][m][1] * r);
                    asm volatile("" ::: "memory"); }
        }
    }
};

struct EpiUQ {
    static constexpr int PROBE_ID = 12;
    static constexpr bool PERM = true;
    bf16_t* QB; const float* ss_cq; const float* gq; const float2* tab; LAS float* TABL;
    __device__ __forceinline__ void operator()(AccT& acc, const Unit& u, int wr, int wc, int fr, int fq) const {
        { int ln_ = lane_id(); asm volatile("" : "+v"(ln_)); fr = ln_ & 15; fq = ln_ >> 4; }
        const int lrow0 = wr * 64 + fr, row0 = u.pm * 256 + lrow0, h = u.pn;
        float rs[2][4];
#pragma unroll
        for (int ai = 0; ai < 2; ++ai)
#pragma unroll
            for (int m = 0; m < 4; ++m) rs[ai][m] = ss_cq[row0 + ai * 128 + m * 16];
        const int gI = (wc & 1) * 4 + fq;
        const f32x4 g00 = *(const f32x4*)(gq + 32 * wc + 8 * fq), g01 = *(const f32x4*)(gq + 32 * wc + 8 * fq + 4);
        const f32x4 g10 = *(const f32x4*)(gq + 128 + 4 * gI), g11 = *(const f32x4*)(gq + 160 + 4 * gI);
#pragma unroll
        for (int ai = 0; ai < 2; ++ai)
#pragma unroll
            for (int m = 0; m < 4; ++m) { const float r = __builtin_amdgcn_rsqf(rs[ai][m] * (1.0f / 512.0f) + 1e-6f); rs[ai][m] = r;
#pragma unroll
                for (int bj = 0; bj < 2; ++bj) { float s = red_fq(sq4(acc[ai][bj][m][0]) + sq4(acc[ai][bj][m][1])) * (r * r);
                    if (fq == 0) TABL[((lrow0 + ai * 128 + m * 16) * 2 + bj) * 4 + wc] = s; } }
        EPI_BAR();
#pragma unroll
        for (int ai = 0; ai < 2; ++ai) {
            float2 cs[4][4];
            if (wc < 2) {
#pragma unroll
                for (int m = 0; m < 4; ++m) { const float2* tp = tab + ((u.pm * 256 + lrow0 + ai * 128 + m * 16) & (SEQ - 1)) * 32 + 4 * gI;
#pragma unroll
                    for (int j = 0; j < 4; ++j) cs[m][j] = tp[j]; }
            }
#pragma unroll
            for (int m = 0; m < 4; ++m) { const int lrow = lrow0 + ai * 128 + m * 16, row = u.pm * 256 + lrow;
                const f32x4 t0 = *(const LAS f32x4*)&TABL[lrow * 8], t1 = *(const LAS f32x4*)&TABL[lrow * 8 + 4];
                const float rq = rs[ai][m] * QS_B * __builtin_amdgcn_rsqf((((t0[0] + t0[1]) + (t0[2] + t0[3])) + ((t1[0] + t1[1]) + (t1[2] + t1[3]))) * (1.0f / 192.0f) + 1e-6f);
                bf16_t* rowp = QB + (size_t)row * 1152 + h * 192 + 32 * wc + 8 * fq;
                *(u32x4*)rowp = pack8(acc[ai][0][m][0] * rq * g00, acc[ai][0][m][1] * rq * g01);
                if (wc < 2) {
                    const f32x4 x1 = acc[ai][1][m][0] * rq * g10, x2 = acc[ai][1][m][1] * rq * g11; f32x4 o1, o2;
#pragma unroll
                    for (int j = 0; j < 4; ++j) { o1[j] = x1[j] * cs[m][j].x - x2[j] * cs[m][j].y; o2[j] = x1[j] * cs[m][j].y + x2[j] * cs[m][j].x; }
                    *(u32x4*)(rowp + 128) = pack8(o1, o2);
                } }
            asm volatile("" ::: "memory");
        }
    }
};

struct EpiUKV {
    static constexpr int PROBE_ID = 13;
    static constexpr bool PERM = true;
    bf16_t *KB, *VB; const bf16_t* PROJ; const float *ss_ckv, *ss_kr; const float* gk; LAS float* TABL;
    __device__ __forceinline__ void operator()(AccT& acc, const Unit& u, int wr, int wc, int fr, int fq) const {
        { int ln_ = lane_id(); asm volatile("" : "+v"(ln_)); fr = ln_ & 15; fq = ln_ >> 4; }
        const int lrow0 = wr * 64 + fr, row0 = u.pm * 256 + lrow0, h = u.pn;
        const int i4 = (wc * 4 + fq) * 4;
        float rs[2][4], skr[2][4]; u32x2 rr[2][4];
        const f32x4 g0 = *(const f32x4*)(gk + 32 * wc + 8 * fq), g1 = *(const f32x4*)(gk + 32 * wc + 8 * fq + 4);
#pragma unroll
        for (int ai = 0; ai < 2; ++ai)
#pragma unroll
            for (int m = 0; m < 4; ++m) { const int row = row0 + ai * 128 + m * 16; rs[ai][m] = ss_ckv[row]; skr[ai][m] = ss_kr[row]; rr[ai][m] = *(const u32x2*)(PROJ + (size_t)row * NP + C_KR + i4); }
#pragma unroll
        for (int ai = 0; ai < 2; ++ai)
#pragma unroll
            for (int m = 0; m < 4; ++m) { const float r = __builtin_amdgcn_rsqf(rs[ai][m] * (1.0f / 512.0f) + 1e-6f); rs[ai][m] = r;
                float s = red_fq(sq4(acc[ai][0][m][0]) + sq4(acc[ai][0][m][1])) * (r * r);
                if (fq == 0) TABL[(lrow0 + ai * 128 + m * 16) * 4 + wc] = s; }
        EPI_BAR();
#pragma unroll
        for (int ai = 0; ai < 2; ++ai)
#pragma unroll
            for (int m = 0; m < 4; ++m) { const int lrow = lrow0 + ai * 128 + m * 16, row = u.pm * 256 + lrow; const float r = rs[ai][m];
                const f32x4 t = *(const LAS f32x4*)&TABL[lrow * 4];
                const float rk = __builtin_amdgcn_rsqf((((t[0] + t[1]) + (t[2] + t[3])) + skr[ai][m]) * (1.0f / 192.0f) + 1e-6f);
                bf16_t* kp = KB + (size_t)row * 1152 + h * 192;
                *(u32x4*)(kp + 32 * wc + 8 * fq) = pack8(acc[ai][0][m][0] * (r * rk) * g0, acc[ai][0][m][1] * (r * rk) * g1);
                *(u32x4*)(VB + (size_t)row * 768 + h * 128 + 32 * wc + 8 * fq) = pack8(acc[ai][1][m][0] * r, acc[ai][1][m][1] * r);
                const u32x2 q = rr[ai][m]; u32x2 o; o.x = cvt_pk_bf16(bflo(q.x) * rk, bfhi(q.x) * rk); o.y = cvt_pk_bf16(bflo(q.y) * rk, bfhi(q.y) * rk);
                *(u32x2*)(kp + 128 + i4) = o; }
    }
};

struct EpiOut {
    static constexpr int PROBE_ID = 11;
    static constexpr bool PERM = true;
    const float* hin; long hdelta; float* hout; bf16_t* hbA; float* ss_h2;
    __device__ __forceinline__ void operator()(AccT& acc, const Unit& u, int wr, int wc, int fr, int fq) const {
        { int ln_ = lane_id(); asm volatile("" : "+v"(ln_)); fr = ln_ & 15; fq = ln_ >> 4; }
        const int row0 = u.pm * 256 + wr * 64 + fr, col0 = u.pn * 256 + wc * 32 + 8 * fq;
#pragma unroll
        for (int ai = 0; ai < 2; ++ai)
#pragma unroll
            for (int mp = 0; mp < 2; ++mp) {
                f32x4 hv[2][2][2];
#pragma unroll
                for (int mm = 0; mm < 2; ++mm)
#pragma unroll
                    for (int bj = 0; bj < 2; ++bj)
#pragma unroll
                        for (int n = 0; n < 2; ++n) hv[mm][bj][n] = *(const f32x4*)(hin + (u.pm >= 32 ? hdelta : 0) + (size_t)(row0 + ai * 128 + (mp * 2 + mm) * 16) * DM + col0 + bj * 128 + n * 4);
#pragma unroll
                for (int mm = 0; mm < 2; ++mm) { const int m = mp * 2 + mm, row = row0 + ai * 128 + m * 16; const size_t off = (size_t)row * DM + col0; float s = 0.f;
#pragma unroll
                    for (int bj = 0; bj < 2; ++bj) { const f32x4 o0 = hv[mm][bj][0] + acc[ai][bj][m][0], o1 = hv[mm][bj][1] + acc[ai][bj][m][1];
                            *(f32x4*)(hout + off + bj * 128) = o0; *(f32x4*)(hout + off + bj * 128 + 4) = o1;
                            *(u32x4*)(hbA + off + bj * 128) = pack8(o0, o1); s += sq4(o0) + sq4(o1); }
                    s = red_fq(s); if (fq == 0) unsafeAtomicAdd(ss_h2 + row, s); }
            }
    }
};
struct EpiPP {
    static constexpr int PROBE_ID = 14;
    static constexpr bool PERM = true;
    bf16_t* PROJ; float* ss_pp; const float* g_post;
    __device__ __forceinline__ void operator()(AccT& acc, const Unit& u, int wr, int wc, int fr, int fq) const {
        { int ln_ = lane_id(); asm volatile("" : "+v"(ln_)); fr = ln_ & 15; fq = ln_ >> 4; }
        const int row0 = u.pm * 256 + wr * 64 + fr, colb = u.pn * 256 + wc * 32 + 8 * fq;
        f32x4 g[2][2];
#pragma unroll
        for (int bj = 0; bj < 2; ++bj) { g[bj][0] = *(const f32x4*)(g_post + colb + bj * 128); g[bj][1] = *(const f32x4*)(g_post + colb + bj * 128 + 4); }
#pragma unroll
        for (int ai = 0; ai < 2; ++ai)
#pragma unroll
            for (int m = 0; m < 4; ++m) { const int row = row0 + ai * 128 + m * 16; bf16_t* rowp = PROJ + (size_t)row * NP + colb; float s = 0.f;
#pragma unroll
                for (int bj = 0; bj < 2; ++bj) { *(u32x4*)(rowp + bj * 128) = pack8(acc[ai][bj][m][0] * g[bj][0], acc[ai][bj][m][1] * g[bj][1]); s += sq4(acc[ai][bj][m][0]) + sq4(acc[ai][bj][m][1]); }
                s = red_fq(s); if (fq == 0) unsafeAtomicAdd(ss_pp + row, s); }
    }
};
struct EpiGate {
    static constexpr int PROBE_ID = 9;
    static constexpr bool PERM = true;
    float* h; bf16_t* hbB; const bf16_t* PROJ; const float *ss_h2, *ss_pp; float* ss_next;
    __device__ __forceinline__ void operator()(AccT& acc, const Unit& u, int wr, int wc, int fr, int fq) const {
        { int ln_ = lane_id(); asm volatile("" : "+v"(ln_)); fr = ln_ & 15; fq = ln_ >> 4; }
        const int row0 = u.pm * 256 + wr * 64 + fr, col0 = u.pn * 256 + wc * 32 + 8 * fq;
        float rs2[2][4], rpp[2][4];
#pragma unroll
        for (int ai = 0; ai < 2; ++ai)
#pragma unroll
            for (int m = 0; m < 4; ++m) { rs2[ai][m] = ss_h2[row0 + ai * 128 + m * 16]; rpp[ai][m] = ss_pp[row0 + ai * 128 + m * 16]; }
#pragma unroll
        for (int ai = 0; ai < 2; ++ai)
#pragma unroll
            for (int mp = 0; mp < 2; ++mp) {
                f32x4 hv[2][2][2]; u32x2 pw[2][2][2];
#pragma unroll
                for (int mm = 0; mm < 2; ++mm)
#pragma unroll
                    for (int bj = 0; bj < 2; ++bj)
#pragma unroll
                        for (int n = 0; n < 2; ++n) { const int row = row0 + ai * 128 + (mp * 2 + mm) * 16, c = col0 + bj * 128 + n * 4;
                            hv[mm][bj][n] = *(const f32x4*)(h + (size_t)row * DM + c); if (n == 0) { const u32x4 q_ = *(const u32x4*)(PROJ + (size_t)row * NP + c); pw[mm][bj][0] = (u32x2){q_.x, q_.y}; pw[mm][bj][1] = (u32x2){q_.z, q_.w}; } }
#pragma unroll
                for (int mm = 0; mm < 2; ++mm) { const int m = mp * 2 + mm, row = row0 + ai * 128 + m * 16; const size_t off = (size_t)row * DM + col0;
                    const float r2 = __builtin_amdgcn_rsqf(rs2[ai][m] * (1.0f / 2048.0f) + 1e-6f), rp = __builtin_amdgcn_rsqf(rpp[ai][m] * (1.0f / 2048.0f) + 1e-6f); float s = 0.f;
#pragma unroll
                    for (int bj = 0; bj < 2; ++bj) { f32x4 oo[2];
#pragma unroll
                        for (int n = 0; n < 2; ++n) { const u32x2 pq = pw[mm][bj][n]; const f32x4 pp = {bflo(pq.x), bfhi(pq.x), bflo(pq.y), bfhi(pq.y)};
#pragma unroll
                            for (int j = 0; j < 4; ++j) { const float gate = __builtin_amdgcn_rcpf(1.0f + __expf(-r2 * acc[ai][bj][m][n][j])); oo[n][j] = hv[mm][bj][n][j] + gate * (pp[j] * rp); } }
                        *(f32x4*)(h + off + bj * 128) = oo[0]; *(f32x4*)(h + off + bj * 128 + 4) = oo[1];
                        *(u32x4*)(hbB + off + bj * 128) = pack8(oo[0], oo[1]); s += sq4(oo[0]) + sq4(oo[1]); }
                    if (ss_next) { s = red_fq(s); if (fq == 0) unsafeAtomicAdd(ss_next + row, s); } }
            }
    }
};

template <int MODE> __device__ __forceinline__ int srccol(int n) {
    if (MODE == 0) return n;
    if (MODE == 1) {
        if (n < 768) return O_AQ + n;
        if (n < 1024) return O_AK + (n - 768);
        if (n < 1280) return O_AV + (n - 1024);
        if (n < 1792) return O_BCQ + (n - 1280);
        if (n < 2304) return O_BCKV + (n - 1792);
        if (n < 2816) return O_CQ + (n - 2304);
        if (n < 3328) return O_CK + (n - 2816);
        if (n < 3840) return O_CV + (n - 3328);
        if (n < 4608) return O_AZ + (n - 3840);
        if (n < 5376) return O_BZ + (n - 4608);
        if (n < 5888) return O_CZ + (n - 5376);
        if (n < 5952) { const int i = n - 5888, g = i >> 3, e = i & 7; return O_BKR + (e < 4 ? 4 * g + e : 32 + 4 * g + (e - 4)); }
        return -1;
    }
    const int hh = n >> 8, c = n & 255;
    if (c < 128) return hh * 192 + c;
    if (c < 192) { const int i = c - 128, g = i >> 3, e = i & 7; return hh * 192 + 128 + (e < 4 ? 4 * g + e : 32 + 4 * g + (e - 4)); }
    return -1;
}
template <int MODE> __device__ __forceinline__ void cvt_tile(const float* src, int ldsrc, int K, const float* gain, bf16_t* dst, float* tile, int tn, int tk, int tid) {
    const int n0 = tn * 256, k0 = tk * 64;
#pragma unroll
    for (int i = 0; i < 8; ++i) { const int idx = tid + i * 512, kk = idx >> 6, ng = (idx & 63) * 4; const int sc = srccol<MODE>(n0 + ng);
        f32x4 v = {0.f, 0.f, 0.f, 0.f}; if (sc >= 0) v = *(const f32x4*)(src + (size_t)(k0 + kk) * ldsrc + sc); if (gain) v *= gain[k0 + kk];
        float* tp = tile + kk * 257 + ng; tp[0] = v[0]; tp[1] = v[1]; tp[2] = v[2]; tp[3] = v[3]; }
    __syncthreads();
#pragma unroll
    for (int i = 0; i < 16; ++i) { const int idx = tid + i * 512, nn = idx >> 5, kp = (idx & 31) * 2;
        *(unsigned*)(dst + (size_t)(n0 + nn) * K + k0 + kp) = cvt_pk_bf16(tile[kp * 257 + nn], tile[(kp + 1) * 257 + nn]); }
    __syncthreads();
}

namespace at {
typedef float f32x16 __attribute__((ext_vector_type(16)));
typedef short s16x4 __attribute__((ext_vector_type(4)));
#define AT_SBAR() __builtin_amdgcn_sched_barrier(0)
constexpr int KVBLK = 64;
constexpr float THR = 8.f, NEGINF = -__builtin_huge_valf();
constexpr int OFF_V = 0, OFF_K = 32768, OFF_WS = 32768 + 51200, OFF_TB = OFF_WS + 2048, TB_PITCH = 160, OFF_SLOT = OFF_TB + 9600, OFF_QR = 95744;
__device__ __forceinline__ int crow(int r, int hi) { return (r & 3) + 8 * (r >> 2) + 4 * hi; }
constexpr int creg(int r) { return (r & 3) + 8 * (r >> 2); }
__device__ __forceinline__ int v_st(int k, int c) { const int kk = (k & ~0xC) | ((k & 4) << 1) | ((k & 8) >> 1); return ((kk >> 3) * 4 + (c >> 5)) * 512 + ((kk & 7) * 32 + (c & 31)) * 2; }
__device__ __forceinline__ int v_rd_base(int lane) { return ((lane & 3) << 3) | (((lane >> 2) & 3) << 6) | (((lane >> 4) & 1) << 5) | (((lane >> 5) & 1) << 8); }
constexpr int v_rd_off(int d0, int ks, int half) { return d0 * 512 + ks * 4096 + half * 2048; }
template <int OFF> __device__ __forceinline__ s16x4 tr_read(int vb) { s16x4 r; asm volatile("ds_read_b64_tr_b16 %0, %1 offset:%2" : "=&v"(r) : "v"(vb), "i"(OFF) : "memory"); return r; }
template <int D0> __device__ __forceinline__ void pv_one(f32x16& od, int vb, bf16x8 pa0, bf16x8 pa1, bf16x8 pa2, bf16x8 pa3) {
    const s16x4 l0 = tr_read<v_rd_off(D0, 0, 0)>(vb), h0 = tr_read<v_rd_off(D0, 0, 1)>(vb), l1 = tr_read<v_rd_off(D0, 1, 0)>(vb), h1 = tr_read<v_rd_off(D0, 1, 1)>(vb);
    const s16x4 l2 = tr_read<v_rd_off(D0, 2, 0)>(vb), h2 = tr_read<v_rd_off(D0, 2, 1)>(vb), l3 = tr_read<v_rd_off(D0, 3, 0)>(vb), h3 = tr_read<v_rd_off(D0, 3, 1)>(vb);
    asm volatile("s_waitcnt lgkmcnt(0)" ::: "memory"); AT_SBAR();
#define AT_PK(L, H) (bf16x8){L[0], L[1], L[2], L[3], H[0], H[1], H[2], H[3]}
    od = __builtin_amdgcn_mfma_f32_32x32x16_bf16(pa0, AT_PK(l0, h0), od, 0, 0, 0);
    od = __builtin_amdgcn_mfma_f32_32x32x16_bf16(pa1, AT_PK(l1, h1), od, 0, 0, 0);
    od = __builtin_amdgcn_mfma_f32_32x32x16_bf16(pa2, AT_PK(l2, h2), od, 0, 0, 0);
    od = __builtin_amdgcn_mfma_f32_32x32x16_bf16(pa3, AT_PK(l3, h3), od, 0, 0, 0);
#undef AT_PK
}
__device__ __forceinline__ void pv_d0(f32x16* o, int vb, bf16x8 pa0, bf16x8 pa1, bf16x8 pa2, bf16x8 pa3) {
    pv_one<0>(o[0], vb, pa0, pa1, pa2, pa3); pv_one<1>(o[1], vb, pa0, pa1, pa2, pa3); pv_one<2>(o[2], vb, pa0, pa1, pa2, pa3); pv_one<3>(o[3], vb, pa0, pa1, pa2, pa3);
}
__device__ __forceinline__ void partialSM(f32x16& p0, f32x16& p1, float& m_reg, float& mn, float& alpha) {
    float pmax = p0[0];
#pragma unroll
    for (int r = 1; r < 16; ++r) pmax = fmaxf(pmax, p0[r]);
#pragma unroll
    for (int r = 0; r < 16; ++r) pmax = fmaxf(pmax, p1[r]);
    { auto rr = __builtin_amdgcn_permlane32_swap(__float_as_uint(pmax), __float_as_uint(pmax), false, false); pmax = fmaxf(__uint_as_float(rr[0]), __uint_as_float(rr[1])); }
    if (__builtin_expect(__all(pmax - m_reg <= THR), 1)) { mn = m_reg; alpha = 1.f; }
    else { mn = fmaxf(m_reg, pmax); alpha = __builtin_amdgcn_exp2f(m_reg - mn); m_reg = mn; }
#pragma unroll
    for (int r = 0; r < 16; ++r) { p0[r] -= mn; p1[r] -= mn; }
#pragma unroll
    for (int r = 0; r < 16; ++r) p0[r] = __builtin_amdgcn_exp2f(p0[r]);
}
__device__ __forceinline__ void finishSM(f32x16& p0, f32x16& p1, float alpha, float& l_reg, bf16x8& pa0, bf16x8& pa1, bf16x8& pa2, bf16x8& pa3) {
#pragma unroll
    for (int r = 0; r < 16; ++r) p1[r] = __builtin_amdgcn_exp2f(p1[r]);
    float ps = 0;
#pragma unroll
    for (int r = 0; r < 16; ++r) ps += p0[r];
#pragma unroll
    for (int r = 0; r < 16; ++r) ps += p1[r];
    { auto rr = __builtin_amdgcn_permlane32_swap(__float_as_uint(ps), __float_as_uint(ps), false, false); ps = __uint_as_float(rr[0]) + __uint_as_float(rr[1]); }
    l_reg = l_reg * alpha + ps;
#define AT_PK4(P, BASE, OUT) do { unsigned a0 = cvt_pk_bf16(P[BASE + 0], P[BASE + 1]), a1 = cvt_pk_bf16(P[BASE + 2], P[BASE + 3]); \
        unsigned b0 = cvt_pk_bf16(P[BASE + 4], P[BASE + 5]), b1 = cvt_pk_bf16(P[BASE + 6], P[BASE + 7]); \
        auto r0 = __builtin_amdgcn_permlane32_swap(a0, b0, false, false); auto r1 = __builtin_amdgcn_permlane32_swap(a1, b1, false, false); \
        u32x4 w = {r0[0], r1[0], r0[1], r1[1]}; OUT = *reinterpret_cast<bf16x8*>(&w); } while (0)
    AT_PK4(p0, 0, pa0); AT_PK4(p0, 8, pa1); AT_PK4(p1, 0, pa2); AT_PK4(p1, 8, pa3);
#undef AT_PK4
}

template <int MODE> struct Cfg;
template <> struct Cfg<0> { static constexpr int DQK = 128, LDQ = NP, LDK = NP, LDV = NP; };
template <> struct Cfg<1> { static constexpr int DQK = 192, LDQ = 1152, LDK = 1152, LDV = 768; };
template <> struct Cfg<2> { static constexpr int DQK = 128, LDQ = NP, LDK = NP, LDV = NP; };

template <int MODE>
__device__ __forceinline__ void attn_unit(const bf16_t* __restrict__ Qb, const bf16_t* __restrict__ Kh, const bf16_t* __restrict__ Vh, bf16_t* __restrict__ Yb,
                                          int pos0, int h, const float* __restrict__ extra, char* lds, int wid_s) {
    constexpr int DQK = Cfg<MODE>::DQK, LDQ = Cfg<MODE>::LDQ, LDK = Cfg<MODE>::LDK, LDV = Cfg<MODE>::LDV, ND = DQK / 16, KPITCH = DQK * 2 + 16, SHM_K = 64 * KPITCH, SHM_V = 16384;
    int tid = wid_s * 64 + lane_id(); asm volatile("" : "+v"(tid));
    const int wid = wid_s, lane = tid & 63, r32 = lane & 31, hi = lane >> 5;
    char* V_lds = lds + OFF_V; char* K_lds = lds + OFF_K;
    float* wsw = (float*)(lds + OFF_WS) + wid * 64; float* li_l = wsw; float* al_l = wsw + 32;
    int klo, NT;
    if (MODE == 0) { klo = max(0, pos0 - 128); NT = (min(SEQ, pos0 + 384) - klo) >> 6; }
    else if (MODE == 1) { klo = 0; NT = SEQ / 64; }
    else { const int r0 = pos0 >> 6; const int lo = min(max(r0 - 4, 0), 24), hiR = min(max(r0 + 3 - 4, 0), 24) + 8; NT = hiR - lo; if (NT & 1) NT += 1; klo = lo * 64; }
    float slope2 = 0.f; int dbase0 = 0; int cs = 0; bool dummy = false; (void)dummy;
    const float* tbl = nullptr; int rq = 0, rsq = 0;
    if (MODE == 0) { slope2 = exp2f(-8.0f * (float)(h + 1) * (1.0f / 6.0f)) * LOG2E; dbase0 = klo + 4 * hi - (pos0 + wid * 32 + r32); }
    if (MODE == 2) {
        float* TB = (float*)(lds + OFF_TB);
        for (int i = tid; i < 15 * 31; i += 512) { const int a = i / 31, b = i - a * 31; TB[a * TB_PITCH + 64 + b] = extra[i] * LOG2E; }
        const int c = (wid & 1) * 32 + r32; rq = (pos0 >> 6) + (wid >> 1); rsq = min(max(rq - 4, 0), 24); cs = min(max(c - 8, 0), 48);
        tbl = TB + 64 + 15 - c + 4 * hi;
    }
    float m_reg = -1e30f, l_reg = 0; f32x16 o[4];
#pragma unroll
    for (int d = 0; d < 4; ++d)
#pragma unroll
        for (int r = 0; r < 16; ++r) o[d][r] = 0.f;
    constexpr int NPARK = (MODE == 2) ? 6 : 4, NQR = ND - NPARK, QRP = NPARK * 32 + 16;
    bf16x8 qr[NQR];
    char* QR = lds + OFF_QR + (wid * 32 + r32) * QRP + hi * 16;
    { const bf16_t* Qw = Qb + (size_t)(wid * 32 + r32) * LDQ + hi * 8;
#pragma unroll
      for (int d0 = 0; d0 < NQR; ++d0) qr[d0] = *(const bf16x8*)(Qw + d0 * 16);
#pragma unroll
      for (int d0 = 0; d0 < NPARK; ++d0) *(bf16x8*)(QR + d0 * 32) = *(const bf16x8*)(Qw + (NQR + d0) * 16); }
    const int sr = tid >> 4, sc = (tid & 15) * 8, vst0 = v_st(sr, sc), vst1 = v_st(32 + sr, sc);
    const int sr2 = tid >> 3, sc2 = 128 + (tid & 7) * 8;
    const int vb0 = (int)(uintptr_t)(LAS char*)V_lds + v_rd_base(lane);
    const char* kbase = K_lds + r32 * KPITCH + hi * 16;
    const bf16_t* Kg = Kh + (size_t)klo * LDK; const bf16_t* Vg = Vh + (size_t)klo * LDV;
    bf16x8 sAvv0, sAvv1, sAkk0, sAkk1, sAkk2, sBvv0, sBvv1, sBkk0, sBkk1, sBkk2;
#define AT_KSWZ(row, colB) ((row) * KPITCH + (colB))
#define AT_SLOAD(S, koff) do { S##vv0 = *(const bf16x8*)(Vg + (size_t)((koff) + sr) * LDV + sc); S##vv1 = *(const bf16x8*)(Vg + (size_t)((koff) + 32 + sr) * LDV + sc); \
        S##kk0 = *(const bf16x8*)(Kg + (size_t)((koff) + sr) * LDK + sc); S##kk1 = *(const bf16x8*)(Kg + (size_t)((koff) + 32 + sr) * LDK + sc); \
        if (DQK == 192) S##kk2 = *(const bf16x8*)(Kg + (size_t)((koff) + sr2) * LDK + sc2); } while (0)
#define AT_SWRITE(b, S) do { *(bf16x8*)(V_lds + (b) * SHM_V + vst0) = S##vv0; *(bf16x8*)(V_lds + (b) * SHM_V + vst1) = S##vv1; \
        *(bf16x8*)(K_lds + (b) * SHM_K + AT_KSWZ(sr, sc * 2)) = S##kk0; *(bf16x8*)(K_lds + (b) * SHM_K + AT_KSWZ(32 + sr, sc * 2)) = S##kk1; \
        if (DQK == 192) *(bf16x8*)(K_lds + (b) * SHM_K + AT_KSWZ(sr2, sc2 * 2)) = S##kk2; } while (0)
#define AT_SWAIT() do { if (DQK == 192) asm volatile("s_waitcnt vmcnt(5)" ::: "memory"); else asm volatile("s_waitcnt vmcnt(4)" ::: "memory"); } while (0)
#define AT_RESC(a) do { if (__any((a) < 1.f)) { if (hi == 0) al_l[r32] = (a); asm volatile("s_waitcnt lgkmcnt(0)" ::: "memory"); \
        _Pragma("unroll") for (int d = 0; d < 4; ++d) _Pragma("unroll") for (int r = 0; r < 16; ++r) o[d][r] *= al_l[crow(r, hi)]; } } while (0)
#define AT_QKT(P0, P1, b) do { const char* Ks_ = kbase + (b) * SHM_K; \
        _Pragma("unroll") for (int r = 0; r < 16; ++r) { P0[r] = 0.f; P1[r] = 0.f; } \
        _Pragma("unroll") for (int d0 = 0; d0 < ND; ++d0) { \
            const bf16x8 b0 = *(const bf16x8*)(Ks_ + d0 * 32), b1 = *(const bf16x8*)(Ks_ + 32 * KPITCH + d0 * 32); \
            const bf16x8 qf_ = d0 < NQR ? qr[d0 < NQR ? d0 : 0] : *(const bf16x8*)(QR + (d0 >= NQR ? d0 - NQR : 0) * 32); \
            P0 = __builtin_amdgcn_mfma_f32_32x32x16_bf16(b0, qf_, P0, 0, 0, 0); P1 = __builtin_amdgcn_mfma_f32_32x32x16_bf16(b1, qf_, P1, 0, 0, 0); } } while (0)
#define AT_MASK(P0, P1, j) do { \
        if (MODE == 0) { const int db = dbase0 + (j) * 64; \
            _Pragma("unroll") for (int r = 0; r < 16; ++r) { const int d0_ = db + creg(r), d1_ = d0_ + 32; const int a0_ = d0_ < 0 ? -d0_ : d0_, a1_ = d1_ < 0 ? -d1_ : d1_; \
                P0[r] = a0_ <= 128 ? P0[r] - slope2 * (float)a0_ : NEGINF; P1[r] = a1_ <= 128 ? P1[r] - slope2 * (float)a1_ : NEGINF; } } \
        if (MODE == 2) { const int kr_ = (klo >> 6) + (j); const bool tok_ = (kr_ >= rsq) && (kr_ < rsq + 8); const int di_ = min(max(kr_ - rq + 7, 0), 14); \
            const float* tb_ = tbl + di_ * TB_PITCH; const int kc0_ = 4 * hi - cs; \
            _Pragma("unroll") for (int r = 0; r < 16; ++r) { const unsigned u0_ = (unsigned)(kc0_ + creg(r)), u1_ = (unsigned)(kc0_ + creg(r) + 32); \
                P0[r] = (tok_ && u0_ < 16u) ? P0[r] + tb_[creg(r)] : NEGINF; P1[r] = (tok_ && u1_ < 16u) ? P1[r] + tb_[creg(r) + 32] : NEGINF; } } } while (0)
    f32x16 pA0, pA1, pB0, pB1; float mnA, mnB, alA, alB; bf16x8 pa0, pa1, pa2, pa3;
    __syncthreads();
    constexpr int SD = 1;
    int jlo = 0, jhi = NT;
    if (MODE == 0) { const int q0w = pos0 + wid_s * 32, t_ = q0w - 191 - klo; jlo = t_ <= 0 ? 0 : (t_ + 63) >> 6; jhi = min(NT, ((q0w + 159 - klo) >> 6) + 1); }
    if (MODE == 2) { const int rq_s = (pos0 >> 6) + (wid_s >> 1), rs_s = min(max(rq_s - 4, 0), 24); jlo = rs_s - (klo >> 6); jhi = jlo + 8; }
#define AT_NEED(j) ((MODE == 1) || ((j) >= jlo && (j) < jhi))
    AT_SLOAD(sA, 0); asm volatile("s_waitcnt vmcnt(0)" ::: "memory"); AT_SWRITE(0, sA); __syncthreads();
    if (AT_NEED(0)) { AT_QKT(pA0, pA1, 0); AT_MASK(pA0, pA1, 0); partialSM(pA0, pA1, m_reg, mnA, alA); }
    if (SD == 2) { AT_SLOAD(sB, KVBLK); if (2 < NT) AT_SLOAD(sA, 2 * KVBLK); AT_SWAIT(); AT_SWRITE(1, sB); }
    else { AT_SLOAD(sA, KVBLK); AT_SWRITE(1, sA); }
    __syncthreads();
    for (int j = 1; j + 1 < NT; j += 2) {
        const bool nP = AT_NEED(j - 1), nC = AT_NEED(j), nN = AT_NEED(j + 1);
        if (SD == 1) { AT_SLOAD(sA, (j + 1) * KVBLK); }
        AT_SBAR(); if (nC) { AT_QKT(pB0, pB1, 1); AT_MASK(pB0, pB1, j); }
        if (nP) finishSM(pA0, pA1, alA, l_reg, pa0, pa1, pa2, pa3);
        AT_SBAR();
        if (SD == 2) AT_SLOAD(sB, (j + 2) * KVBLK);
        AT_SBAR();
        if (nP) pv_d0(o, vb0, pa0, pa1, pa2, pa3);
        if (nC) partialSM(pB0, pB1, m_reg, mnB, alB);
        __syncthreads(); if (SD == 2) AT_SWAIT(); AT_SWRITE(0, sA);
        if (nC) AT_RESC(alB);
        __syncthreads();
        if (SD == 1) { AT_SLOAD(sA, (j + 2) * KVBLK); }
        AT_SBAR(); if (nN) { AT_QKT(pA0, pA1, 0); AT_MASK(pA0, pA1, j + 1); }
        if (nC) finishSM(pB0, pB1, alB, l_reg, pa0, pa1, pa2, pa3);
        AT_SBAR();
        if (SD == 2) { if (j + 3 < NT) AT_SLOAD(sA, (j + 3) * KVBLK); }
        AT_SBAR();
        if (nC) pv_d0(o, vb0 + SHM_V, pa0, pa1, pa2, pa3);
        if (nN) partialSM(pA0, pA1, m_reg, mnA, alA);
        __syncthreads(); if (SD == 2) { AT_SWAIT(); AT_SWRITE(1, sB); } else AT_SWRITE(1, sA);
        if (nN) AT_RESC(alA);
        __syncthreads();
    }
    {
        const bool nP = AT_NEED(NT - 2), nC = AT_NEED(NT - 1);
        AT_SBAR(); if (nC) { AT_QKT(pB0, pB1, 1); AT_MASK(pB0, pB1, NT - 1); }
        if (nP) finishSM(pA0, pA1, alA, l_reg, pa0, pa1, pa2, pa3);
        AT_SBAR();
        if (nP) pv_d0(o, vb0, pa0, pa1, pa2, pa3);
        if (nC) partialSM(pB0, pB1, m_reg, mnB, alB);
        __syncthreads();
        if (nC) { AT_RESC(alB); finishSM(pB0, pB1, alB, l_reg, pa0, pa1, pa2, pa3); }
        AT_SBAR();
        if (nC) pv_d0(o, vb0 + SHM_V, pa0, pa1, pa2, pa3);
    }
#undef AT_NEED
    float fin;
    if (MODE == 0) { const float sk = extra[0] * LOG2E, mf = fmaxf(m_reg, sk), a = __builtin_amdgcn_exp2f(m_reg - mf); fin = a * __builtin_amdgcn_rcpf(l_reg * a + __builtin_amdgcn_exp2f(sk - mf)); }
    else fin = __builtin_amdgcn_rcpf(l_reg);
    if (hi == 0) li_l[r32] = fin;
    asm volatile("s_waitcnt lgkmcnt(0)" ::: "memory");
    __syncthreads();
    bf16_t* Ot = (bf16_t*)lds + wid * (32 * 136);
#pragma unroll
    for (int r = 0; r < 16; ++r) { const int orow = crow(r, hi); const float f = li_l[orow];
#pragma unroll
        for (int d0 = 0; d0 < 4; ++d0) Ot[orow * 136 + d0 * 32 + r32] = (bf16_t)(cvt_pk_bf16(o[d0][r] * f, 0.f) & 0xffffu); }
    asm volatile("s_waitcnt lgkmcnt(0)" ::: "memory");
#pragma unroll
    for (int i = 0; i < 8; ++i) { const int idx = i * 64 + lane, row = idx >> 4, c8 = (idx & 15) * 8;
        const u32x4 ov = *(const u32x4*)(Ot + row * 136 + c8);
        bf16_t* yp = Yb + (size_t)(wid * 32 + row) * NP + c8; const u32x4 sg = *(const u32x4*)yp; u32x4 w;
        w.x = cvt_pk_bf16(bflo(ov.x) * bflo(sg.x), bfhi(ov.x) * bfhi(sg.x)); w.y = cvt_pk_bf16(bflo(ov.y) * bflo(sg.y), bfhi(ov.y) * bfhi(sg.y));
        w.z = cvt_pk_bf16(bflo(ov.z) * bflo(sg.z), bfhi(ov.z) * bfhi(sg.z)); w.w = cvt_pk_bf16(bflo(ov.w) * bflo(sg.w), bfhi(ov.w) * bfhi(sg.w));
        *(u32x4*)yp = w; }
#undef AT_KSWZ
#undef AT_SLOAD
#undef AT_SWRITE
#undef AT_SWAIT
#undef AT_RESC
#undef AT_QKT
#undef AT_MASK
}
}


constexpr int CVT_ITEMS = 1408 + 160;
__device__ __forceinline__ void cvt_item(const Params& p, unsigned char* wsl, int l, int r, float* ldsf, int wtid) {
    if (r < 768) cvt_tile<1>(p.w_in + (size_t)l * DM * INW, INW, DM, p.norm_in + l * DM, (bf16_t*)(wsl + OFF_WIN), ldsf, r >> 5, r & 31, wtid);
    else if (r < 816) cvt_tile<2>(p.b_w_uq + (size_t)l * 512 * 1152, 1152, 512, p.b_cq_norm + l * 512, (bf16_t*)(wsl + OFF_WUQ), ldsf, (r - 768) >> 3, (r - 768) & 7, wtid);
    else if (r < 864) cvt_tile<0>(p.b_w_ukv + (size_t)l * 512 * 1536, 1536, 512, p.b_ckv_norm + l * 512, (bf16_t*)(wsl + OFF_WUKV), ldsf, (r - 816) >> 3, (r - 816) & 7, wtid);
    else if (r < 1120) cvt_tile<0>(p.w_out + (size_t)l * DM * DM, DM, DM, nullptr, (bf16_t*)(wsl + OFF_WOUT), ldsf, (r - 864) >> 5, (r - 864) & 31, wtid);
    else if (r < 1376) cvt_tile<0>(p.w_gate + (size_t)l * DM * DM, DM, DM, p.ple_norm + l * DM, (bf16_t*)(wsl + OFF_WGATE), ldsf, (r - 1120) >> 5, (r - 1120) & 31, wtid);
    else if (r < 1408) cvt_tile<0>(p.w_proj + (size_t)l * 256 * DM, DM, 256, nullptr, (bf16_t*)(wsl + OFF_WPROJ), ldsf, (r - 1376) >> 2, (r - 1376) & 3, wtid);
    else { const int t0 = (r - 1408) * 256; bf16_t* PBl = (bf16_t*)(wsl + OFF_PB);
        const float* srcb = t0 < 8192 ? p.p_prompt + ((size_t)l * 8192 + t0) * 256 : p.p_sample + ((size_t)l * 32768 + (t0 - 8192)) * 256;
#pragma unroll 4
        for (int i = wtid; i < 256 * 256 / 8; i += 512) { const int e = i * 8; *(u32x4*)(PBl + (size_t)t0 * 256 + e) = pack8(*(const f32x4*)(srcb + e), *(const f32x4*)(srcb + e + 4)); } }
}

#define XB_TMO      128
#define XB_XCNT(j)  (256  + 64 * (j))
#define XB_XSUB(j)  (1280 + 64 * (j))
#define XB_XGEN(j)  (2304 + 64 * (j))
#define XB_TOP      3328
#define XB_TOPGEN   3392
#define XCD_BAR_WORDS 3456
#define XB_SPIN_CAP (1u << 18)
__device__ __forceinline__ unsigned xb_ld(unsigned* p)              { return __hip_atomic_load(p, __ATOMIC_RELAXED, __HIP_MEMORY_SCOPE_AGENT); }
__device__ __forceinline__ unsigned xb_add(unsigned* p, unsigned v) { return __hip_atomic_fetch_add(p, v, __ATOMIC_RELAXED, __HIP_MEMORY_SCOPE_AGENT); }
__device__ __forceinline__ unsigned xb_xcc_id() { return (unsigned)__builtin_amdgcn_s_getreg((3 << 11) | 20) & 0xFu; }
#define XB_SPIN(cond, bar) do { unsigned _sp = 0; while (cond) { __builtin_amdgcn_s_sleep(1); \
    if ((++_sp & 255u) == 0u) { if (xb_ld(&(bar)[XB_TMO])) break; if (_sp > XB_SPIN_CAP) { atomicAdd(&(bar)[XB_TMO], 1u); break; } } } } while (0)
struct XcdBarrier { unsigned* bar; unsigned x; volatile LAS unsigned* st; };
__device__ __forceinline__ void xcd_barrier_complete(unsigned* bar, unsigned x, unsigned& nloc, unsigned& nx) {
    const unsigned G = gridDim.x * gridDim.y * gridDim.z;
    unsigned sum, cnt, mine, sp = 0u;
    for (;;) {
        sum = 0u; cnt = 0u; mine = 0u;
#pragma unroll
        for (unsigned j = 0; j < 16; ++j) { const unsigned c = xb_ld(&bar[XB_XCNT(j)]); sum += c; cnt += (c > 0u) ? 1u : 0u; mine = (j == x) ? c : mine; }
        if (sum == G) break;
        __builtin_amdgcn_s_sleep(1);
        if ((++sp & 255u) == 0u) { if (xb_ld(&bar[XB_TMO])) break; if (sp > XB_SPIN_CAP) { atomicAdd(&bar[XB_TMO], 1u); break; } }
    }
    nloc = mine > 0u ? mine : 1u; nx = cnt > 0u ? cnt : 1u;
}
__device__ __forceinline__ void xcd_barrier(const XcdBarrier& b, bool leader_thread) {
    asm volatile("s_waitcnt vmcnt(0)" ::: "memory");
    __syncthreads();
    if (leader_thread) {
        unsigned* bar = b.bar;
        __builtin_amdgcn_s_waitcnt(0);
        unsigned nloc = b.st[0], nx = b.st[1];
        if (nloc == 0u) { xcd_barrier_complete(bar, b.x, nloc, nx); b.st[0] = nloc; b.st[1] = nx; }
        const unsigned old = xb_add(&bar[XB_XSUB(b.x)], 1u);
        const unsigned gen = old / nloc;
        if (old + 1u == (gen + 1u) * nloc) {
            __builtin_amdgcn_fence(__ATOMIC_RELEASE, "agent");
            asm volatile("s_waitcnt vmcnt(0)" ::: "memory");
            const unsigned og = xb_add(&bar[XB_TOP], 1u);
            const unsigned tg = og / nx;
            if (og + 1u == (tg + 1u) * nx) xb_add(&bar[XB_TOPGEN], 1u);
            else XB_SPIN(xb_ld(&bar[XB_TOPGEN]) == tg, bar);
            __builtin_amdgcn_fence(__ATOMIC_ACQUIRE, "agent");
            xb_add(&bar[XB_XGEN(b.x)], 1u);
            asm volatile("s_waitcnt vmcnt(0)" ::: "memory");
        } else {
            XB_SPIN(xb_ld(&bar[XB_XGEN(b.x)]) == gen, bar);
            __builtin_amdgcn_fence(__ATOMIC_ACQUIRE, "agent");
            asm volatile("s_waitcnt vmcnt(0)" ::: "memory");
        }
    }
    __syncthreads();
}

__global__ __launch_bounds__(512, 2) void hymba_fwd(Params p) {
    extern __shared__ __attribute__((aligned(16))) unsigned char shm[];
    cg::grid_group grid = cg::this_grid();
    LAS unsigned char* lds = (LAS unsigned char*)shm;
    LAS float* TABL = (LAS float*)(lds + LDS_STAGE);
    float* ldsf = (float*)shm;
    unsigned char* ws = p.ws;
    bf16_t* HBB = (bf16_t*)(ws + OFF_HBB); bf16_t* PROJ = (bf16_t*)(ws + OFF_PROJ);
    bf16_t* QB = (bf16_t*)(ws + OFF_QB); bf16_t* KB = (bf16_t*)(ws + OFF_KB); bf16_t* VB = (bf16_t*)(ws + OFF_VB); bf16_t* HBA = QB;
    float* SS = (float*)(ws + OFF_SS); float2* tab = (float2*)(ws + OFF_TAB); float* GT = (float*)(ws + OFF_GT); unsigned* CTR = (unsigned*)(ws + OFF_CTR);
#define SSP(kind, l) (SS + ((size_t)(kind) * 4 + (l)) * TTOT)
    const int wid_s = __builtin_amdgcn_readfirstlane((int)threadIdx.x >> 6);
    volatile LAS unsigned* xbst = (volatile LAS unsigned*)((LAS unsigned char*)shm + LDS_XB);
    if (threadIdx.x == 0) { xbst[0] = 0u; xbst[1] = 0u; xbst[2] = 0u; xbst[3] = 0u; }
    __syncthreads();
#define XBAR_NOW() ({ XcdBarrier b_; b_.bar = (unsigned*)(p.ws + OFF_BAR); b_.x = xb_xcc_id(); b_.st = (volatile LAS unsigned*)((LAS unsigned char*)shm + LDS_XB); b_; })
    const int tid = threadIdx.x, gthreads = gridDim.x * 512, gtid = blockIdx.x * 512 + tid;
#if PROBE_SEL
    unsigned long long t_acc = 0, t_mark = __builtin_amdgcn_s_memrealtime();
#define PROBE_MARK(cat) do { const unsigned long long n_ = __builtin_amdgcn_s_memrealtime(); if (PROBE_SEL == 8 || (cat) == PROBE_SEL) t_acc += n_ - t_mark; t_mark = n_; } while (0)
#define PROBE_TACC (&t_acc)
#else
#define PROBE_MARK(cat) do { } while (0)
#define PROBE_TACC nullptr
#endif

    for (int i = gtid; i < 5 * 4 * TTOT; i += gthreads) { const int kind = 1 + i / (4 * TTOT), rem = i % (4 * TTOT); SS[(size_t)kind * 4 * TTOT + rem] = 0.f; }
    for (int i = gtid; i < 3 * TTOT; i += gthreads) SS[TTOT + i] = 0.f;
    if (gtid < 32) CTR[gtid] = 0u;
    for (int i = gtid; i < XCD_BAR_WORDS; i += gthreads) ((unsigned*)(p.ws + OFF_BAR))[i] = 0u;
    if (gtid < 2048) { const int l = gtid >> 9, w = (gtid >> 7) & 3, d = gtid & 127; float v;
        if (w == 0) v = p.a_q_norm[l * 128 + d]; else if (w == 1) v = p.a_k_norm[l * 128 + d]; else if (w == 2) v = p.c_q_norm[l * 128 + d]; else v = p.c_k_norm[l * 128 + d];
        GT[gtid] = v; }
    for (int i = gtid; i < SEQ * 32; i += gthreads) { const int pos = i >> 5, j = i & 31; const double ang = (double)pos * pow(10000.0, -(double)j / 32.0); tab[i] = make_float2((float)cos(ang), (float)sin(ang)); }
    {
        const int gw = gtid >> 6, nw = gthreads >> 6, lane = tid & 63;
        for (int row = gw; row < TTOT; row += nw) {
            const float* src = row < 8192 ? p.x_prompt + (size_t)row * DM : p.x_sample + (size_t)(row - 8192) * DM; float s = 0.f;
#pragma unroll
            for (int i = 0; i < 4; ++i) { const int c = (i * 64 + lane) * 8; const f32x4 a = *(const f32x4*)(src + c), b = *(const f32x4*)(src + c + 4);
                s += sq4(a) + sq4(b); *(u32x4*)(HBB + (size_t)row * DM + c) = pack8(a, b); }
            s = wave_sum(s); if (lane == 0) SSP(0, 0)[row] = s;
        }
    }

    for (int l = 0; l < 4; ++l) {
        unsigned char* const wsl = ws + (size_t)(l & 1) * SZ_LAYER;
        if (l == 0) {
            int wtid = wid_s * 64 + lane_id(); asm volatile("" : "+v"(wtid));
            for (int r = blockIdx.x; r < CVT_ITEMS; r += gridDim.x) cvt_item(p, wsl, 0, r, ldsf, wtid);
            PROBE_MARK(1); grid.sync(); PROBE_MARK(7);
            if (wid_s == 0 && lane_id() == 0) (void)xb_add(&((unsigned*)(p.ws + OFF_BAR))[XB_XCNT(xb_xcc_id())], 1u);
        }
        {
            constexpr int r0 = 0, TC = TTOT;
            pg8::StaticOrder S;
            {
                pg8::Gemm g{HBB + (size_t)r0 * DM, (const bf16_t*)(wsl + OFF_WIN), DM, TC, NP, DM};
                EpiProj E{PROJ, SSP(0, l) + r0, SSP(3, l) + r0, SSP(5, l) + r0, GT + l * 512, p.b_k_norm + l * 192 + 128, tab, TABL};
                S.init(TC, NP, gridDim.x, blockIdx.x); pg8::gemm_phase(lds, g, S, E, wid_s, PROBE_TACC);
            }
            PROBE_MARK(2); xcd_barrier(XBAR_NOW(), wid_s == 0 && lane_id() == 0); PROBE_MARK(7);
            {
                pg8::Gemm g{PROJ + C_BCQ, (const bf16_t*)(wsl + OFF_WUQ), NP, TC, 1536, 512};
                EpiUQ E{QB, SSP(3, l) + r0, p.b_q_norm + l * 192, tab, TABL};
                S.init(TC, 1536, gridDim.x, blockIdx.x); pg8::gemm_phase(lds, g, S, E, wid_s, PROBE_TACC);
            }
            {
                pg8::Gemm g{PROJ + C_BCKV, (const bf16_t*)(wsl + OFF_WUKV), NP, TC, 1536, 512};
                EpiUKV E{KB, VB, PROJ, SSP(4, l) + r0, SSP(5, l) + r0, p.b_k_norm + l * 192, TABL};
                S.init(TC, 1536, gridDim.x, blockIdx.x); pg8::gemm_phase(lds, g, S, E, wid_s, PROBE_TACC);
            }
            PROBE_MARK(3); xcd_barrier(XBAR_NOW(), wid_s == 0 && lane_id() == 0); PROBE_MARK(7);
            {
                constexpr int QB_ITEMS = 120, QC_ITEMS = 80, QA_ITEMS = 120, QW_ITEMS = CVT_ITEMS / 8, Q_ITEMS = QB_ITEMS + QC_ITEMS + QA_ITEMS + QW_ITEMS;
                const int xme = (int)(xb_xcc_id() & 7u);
                LAS int* slot = (LAS int*)(lds + at::OFF_SLOT);
                for (int dx = 0; dx < 8; ++dx) {
                    const int xq = (xme + dx) & 7;
                    unsigned* ctr = CTR + l * 8 + xq;
                    for (;;) {
                        __syncthreads();
                        if (wid_s == 0 && lane_id() == 0) *slot = (int)atomicAdd(ctr, 1u);
                        __syncthreads();
                        const int k = *slot;
                        if (k >= Q_ITEMS) break;
                        if (k < QB_ITEMS) { const int s = xq + 8 * (k >> 3), sq = s / 6, hh = s - sq * 6, sb = sq * SEQ, t0 = sb + (k & 7) * 256;
                            at::attn_unit<1>(QB + (size_t)t0 * 1152 + hh * 192, KB + (size_t)sb * 1152 + hh * 192, VB + (size_t)sb * 768 + hh * 128, PROJ + (size_t)t0 * NP + C_Z + 768 + hh * 128,
                                             t0 & (SEQ - 1), hh, nullptr, (char*)shm, wid_s); }
                        else if (k < QB_ITEMS + QC_ITEMS) { const int k2 = k - QB_ITEMS, s = xq + 8 * (k2 >> 3), sq = s >> 2, hh = s & 3, sb = sq * SEQ, t0 = sb + (k2 & 7) * 256;
                            at::attn_unit<2>(PROJ + (size_t)t0 * NP + C_CQ + hh * 128, PROJ + (size_t)sb * NP + C_CK + hh * 128, PROJ + (size_t)sb * NP + C_CV + hh * 128, PROJ + (size_t)t0 * NP + C_Z + 1536 + hh * 128,
                                             t0 & (SEQ - 1), hh, p.c_rpb + ((size_t)l * 4 + hh) * 15 * 31, (char*)shm, wid_s); }
                        else if (k < QB_ITEMS + QC_ITEMS + QA_ITEMS) { const int k2 = k - QB_ITEMS - QC_ITEMS, g = xq + 8 * (k2 / 24), r = k2 % 24, sq = g >> 1, kvh = g & 1, hh = kvh * 3 + r % 3, sb = sq * SEQ, t0 = sb + (r / 3) * 256;
                            at::attn_unit<0>(PROJ + (size_t)t0 * NP + C_AQ + hh * 128, PROJ + (size_t)sb * NP + C_AK + kvh * 128, PROJ + (size_t)sb * NP + C_AV + kvh * 128, PROJ + (size_t)t0 * NP + C_Z + hh * 128,
                                             t0 & (SEQ - 1), hh, p.a_sink + l * 6 + hh, (char*)shm, wid_s); }
                        else if (l < 3) { int wtid = wid_s * 64 + lane_id(); asm volatile("" : "+v"(wtid)); cvt_item(p, ws + (size_t)((l + 1) & 1) * SZ_LAYER, l + 1, xq + 8 * (k - (QB_ITEMS + QC_ITEMS + QA_ITEMS)), ldsf, wtid); }
                    }
                }
            }
            PROBE_MARK(4); xcd_barrier(XBAR_NOW(), wid_s == 0 && lane_id() == 0); PROBE_MARK(7);
            for (int s2 = 0; s2 < 2; ++s2) {
                if ((s2 ^ (int)((blockIdx.x >> 3) & 1)) == 0) {
                    const float* hin = (l == 0) ? p.x_prompt : p.h; const long hdelta = (l == 0) ? (long)((p.x_sample - (size_t)8192 * DM) - p.x_prompt) : 0;
                    pg8::Gemm g{PROJ + C_Z, (const bf16_t*)(wsl + OFF_WOUT), NP, TC, DM, DM};
                    EpiOut E{hin, hdelta, p.h, HBA, SSP(1, l)};
                    S.init(TC, DM, gridDim.x, blockIdx.x); pg8::gemm_phase(lds, g, S, E, wid_s, PROBE_TACC);
                } else {
                    pg8::Gemm g{(const bf16_t*)(wsl + OFF_PB), (const bf16_t*)(wsl + OFF_WPROJ), 256, TC, DM, 256};
                    EpiPP E{PROJ, SSP(2, l) + r0, p.post_norm + l * DM};
                    S.init(TC, DM, gridDim.x, blockIdx.x); pg8::gemm_phase(lds, g, S, E, wid_s, PROBE_TACC);
                }
            }
            PROBE_MARK(5); xcd_barrier(XBAR_NOW(), wid_s == 0 && lane_id() == 0); PROBE_MARK(7);
            {
                pg8::Gemm g{HBA, (const bf16_t*)(wsl + OFF_WGATE), DM, TC, DM, DM};
                EpiGate E{p.h + (size_t)r0 * DM, HBB + (size_t)r0 * DM, PROJ, SSP(1, l) + r0, SSP(2, l) + r0, (l < 3) ? SSP(0, l + 1) + r0 : nullptr};
                S.init(TC, DM, gridDim.x, blockIdx.x); pg8::gemm_phase(lds, g, S, E, wid_s, PROBE_TACC);
            }
            PROBE_MARK(6); xcd_barrier(XBAR_NOW(), wid_s == 0 && lane_id() == 0); PROBE_MARK(7);
        }
    }
#if PROBE_SEL
    if (blockIdx.x == 0 && wid_s == 0 && lane_id() == 0) p.h[0] += (float)t_acc * (1e-5f * 4.0f);
#endif
}

extern "C" void kernel_launch(void* const* d_in, const int* in_sizes, int n_in, void* d_out, int out_size, void* d_ws, size_t ws_size, hipStream_t stream) {
    static int grid_blocks = 0;
    if (grid_blocks == 0) {
        if (n_in != 23 || ws_size < WS_END) { fprintf(stderr, "kernel_launch: need 23 inputs and %zu bytes of workspace (got %d, %zu)\n", (size_t)WS_END, n_in, ws_size); grid_blocks = -1; return; }
        int dev = 0, cus = 0, per_cu = 0;
        if (hipGetDevice(&dev) != hipSuccess || hipDeviceGetAttribute(&cus, hipDeviceAttributeMultiprocessorCount, dev) != hipSuccess) { grid_blocks = -1; return; }
        if (hipFuncSetAttribute((const void*)hymba_fwd, hipFuncAttributeMaxDynamicSharedMemorySize, LDS_BYTES) != hipSuccess) { fprintf(stderr, "kernel_launch: hipFuncSetAttribute failed\n"); grid_blocks = -1; return; }
        if (hipOccupancyMaxActiveBlocksPerMultiprocessor(&per_cu, (const void*)hymba_fwd, 512, LDS_BYTES) != hipSuccess || per_cu < 1) { fprintf(stderr, "kernel_launch: occupancy query failed (%d)\n", per_cu); (void)hipGetLastError(); per_cu = 1; }
        grid_blocks = cus * per_cu;
    }
    if (grid_blocks < 0) return;
    Params p{};
    const float** pf = (const float**)&p;
    for (int i = 0; i < 23; ++i) pf[i] = (const float*)d_in[i];
    p.h = (float*)d_out; p.ws = (unsigned char*)d_ws;
    void* args[] = {&p};
    hipError_t e = hipLaunchCooperativeKernel((const void*)hymba_fwd, dim3(grid_blocks), dim3(512), args, LDS_BYTES, stream);
    if (e != hipSuccess) fprintf(stderr, "cooperative launch failed: %s (grid %d)\n", hipGetErrorString(e), grid_blocks);
}
```
